# Optimizing an MI355X kernel written in HIP

```python
import math
import jax
import jax.numpy as jnp
from jax import lax
import numpy as np

D_MODEL = 1024
BATCH = 2
SEQ = 8192
DEPTH = 1

N_MEM = 256
EPS = 1e-6
NEG_INF = -1e30
Q_BLOCK = 128

MLA_HEADS = 8
MLA_NOPE = 64
MLA_ROPE = 32
MLA_V = 64
MLA_Q_RANK = 256
MLA_KV_RANK = 128
ROPE_THETA = 10000.0

NSA_HEADS = 8
NSA_KV_GROUPS = 2
NSA_HD = 64
CMP_LEN = 32
CMP_STRIDE = 16
CMP_HIDDEN = 128
SLC_LEN = 64
SLC_TOPK = 16
WIN = 512
FORCE_SCORE = 1e9

REL_BUCKETS = 32
REL_MAX_EXACT = 16
REL_MAX_DIST = 512

MEM_HEADS = 4
MEM_HD = 64

N_EXPERTS = 32
TOP_K = 4
D_FF = 1024
SWIGLU_LIMIT = 7.0
SWIGLU_ALPHA = 1.702
MOE_BLOCK = 128

D_MIX = MLA_HEADS * MLA_V + NSA_HEADS * NSA_HD
IN_SPLIT_SIZES = (MLA_Q_RANK, MLA_KV_RANK, MLA_ROPE, NSA_HEADS * NSA_HD) + (NSA_KV_GROUPS * NSA_HD,) * 6 + (3 * NSA_HEADS,)
IN_COLS = sum(IN_SPLIT_SIZES)

kernel_name = "hymba_mla_nsa_t5bias_memxattn_gptoss_moe"


def rms_norm(x, g):
    xf = x.astype(jnp.float32)
    y = xf * lax.rsqrt(jnp.mean(xf * xf, axis=-1, keepdims=True) + EPS)
    return (y * g.astype(jnp.float32)).astype(x.dtype)


def masked_softmax(logits, mask):
    logits = jnp.where(mask, logits.astype(jnp.float32), NEG_INF)
    m = jnp.max(logits, axis=-1, keepdims=True)
    e = jnp.exp(logits - m) * mask
    return e / jnp.maximum(jnp.sum(e, axis=-1, keepdims=True), 1e-30)


def rope(x, pos):
    half = x.shape[-1] // 2
    inv = ROPE_THETA ** (-jnp.arange(half, dtype=jnp.float32) / half)
    ang = pos.astype(jnp.float32)[:, None] * inv
    cos, sin = jnp.cos(ang)[:, None, :], jnp.sin(ang)[:, None, :]
    x1 = x[..., :half].astype(jnp.float32)
    x2 = x[..., half:].astype(jnp.float32)
    return jnp.concatenate([x1 * cos - x2 * sin, x2 * cos + x1 * sin], axis=-1).astype(x.dtype)


def rel_bucket(dist):
    n = jnp.maximum(dist, 0)
    nf = jnp.maximum(n, 1).astype(jnp.float32)
    large = REL_MAX_EXACT + (jnp.log(nf / REL_MAX_EXACT) / math.log(REL_MAX_DIST / REL_MAX_EXACT)
                             * (REL_BUCKETS - REL_MAX_EXACT)).astype(jnp.int32)
    large = jnp.minimum(large, REL_BUCKETS - 1)
    return jnp.where(n < REL_MAX_EXACT, n, large)


def causal_block_attention(q, k, v, scale):
    B, S, H, _ = q.shape
    nb = S // Q_BLOCK
    qb = q.reshape(B, nb, Q_BLOCK, H, q.shape[-1]).swapaxes(0, 1)
    kpos = jnp.arange(S)

    def one_block(args):
        qi, i = args
        qpos = i * Q_BLOCK + jnp.arange(Q_BLOCK)
        s = jnp.einsum('bqhd,bkhd->bhqk', qi, k).astype(jnp.float32) * scale
        p = masked_softmax(s, kpos[None, :] <= qpos[:, None])
        return jnp.einsum('bhqk,bkhd->bqhd', p.astype(v.dtype), v)

    out = lax.map(one_block, (qb, jnp.arange(nb)))
    return out.swapaxes(0, 1).reshape(B, S, H, v.shape[-1])


def mla_mixer(cq, ckv, krope, g_cq, w_uq, g_ckv, w_ukv, g_q, g_k):
    B, S, _ = cq.shape
    H = MLA_HEADS
    q = (rms_norm(cq, g_cq) @ w_uq).reshape(B, S, H, MLA_NOPE + MLA_ROPE)
    kv = (rms_norm(ckv, g_ckv) @ w_ukv).reshape(B, S, H, MLA_NOPE + MLA_V)
    k_nope, v = kv[..., :MLA_NOPE], kv[..., MLA_NOPE:]
    k = jnp.concatenate([k_nope, jnp.broadcast_to(krope[:, :, None, :], (B, S, H, MLA_ROPE))], axis=-1)
    q = rms_norm(q, g_q)
    k = rms_norm(k, g_k)
    pos = jnp.arange(S)
    q = jnp.concatenate([q[..., :MLA_NOPE], rope(q[..., MLA_NOPE:], pos)], axis=-1)
    k = jnp.concatenate([k[..., :MLA_NOPE], rope(k[..., MLA_NOPE:], pos)], axis=-1)
    o = causal_block_attention(q, k, v, (MLA_NOPE + MLA_ROPE) ** -0.5)
    return o.reshape(B, S, H * MLA_V)


def compress_blocks(t, cmp_idx, pos_emb, w1, w2):
    blk = t[:, cmp_idx] + pos_emb[None, None, :, None, :]
    hid = jax.nn.gelu(jnp.einsum('bnlgd,ldf->bngf', blk, w1))
    return jnp.einsum('bngf,fd->bngd', hid, w2)


def nsa_mixer(q, kc, vc, ks, vs, kw, vw, gate_logits, cmp_k_pos, cmp_k_w1, cmp_k_w2,
              cmp_v_pos, cmp_v_w1, cmp_v_w2, g_q, g_k, rel_table):
    B, S = q.shape[:2]
    G, HPG, D = NSA_KV_GROUPS, NSA_HEADS // NSA_KV_GROUPS, NSA_HD
    n_cmp = (S - CMP_LEN) // CMP_STRIDE + 1
    n_slc = S // SLC_LEN
    n_sel = min(SLC_TOPK, n_slc)
    nb = S // Q_BLOCK
    scale = D ** -0.5

    q = rms_norm(q.reshape(B, S, G, HPG, D), g_q)
    kc, vc, ks, vs, kw, vw = (t.reshape(B, S, G, D) for t in (kc, vc, ks, vs, kw, vw))

    cmp_idx = jnp.arange(n_cmp)[:, None] * CMP_STRIDE + jnp.arange(CMP_LEN)[None, :]
    k_cmp = rms_norm(compress_blocks(kc, cmp_idx, cmp_k_pos, cmp_k_w1, cmp_k_w2), g_k)
    v_cmp = compress_blocks(vc, cmp_idx, cmp_v_pos, cmp_v_w1, cmp_v_w2)
    cmp_start, cmp_end = cmp_idx[:, 0], cmp_idx[:, -1]
    slc_start = jnp.arange(n_slc) * SLC_LEN
    overlap = ((cmp_start[:, None] < slc_start[None, :] + SLC_LEN)
               & (cmp_end[:, None] >= slc_start[None, :])).astype(jnp.float32)

    k_blk = rms_norm(ks, g_k).transpose(0, 2, 1, 3).reshape(B, G, n_slc, SLC_LEN, D)
    v_blk = vs.transpose(0, 2, 1, 3).reshape(B, G, n_slc, SLC_LEN, D)

    pad = ((0, 0), (WIN, 0), (0, 0), (0, 0))
    k_pad = jnp.pad(rms_norm(kw, g_k), pad)
    v_pad = jnp.pad(vw, pad)

    tbl_gh = rel_table.reshape(REL_BUCKETS, G, HPG)
    tbl_g = tbl_gh.transpose(1, 0, 2)
    b_idx = jnp.arange(B)[:, None, None, None]
    g_idx = jnp.arange(G)[None, :, None, None]

    def bias_gh(dist):
        return jnp.moveaxis(tbl_gh[rel_bucket(dist)], (-2, -1), (0, 1)).astype(jnp.float32)

    qb = q.reshape(B, nb, Q_BLOCK, G, HPG, D).swapaxes(0, 1)
    gb = jax.nn.sigmoid(gate_logits.astype(jnp.float32)).reshape(B, nb, Q_BLOCK, G, HPG, 3).swapaxes(0, 1)

    def one_block(args):
        qi, gi, i = args
        q0 = i * Q_BLOCK
        qpos = q0 + jnp.arange(Q_BLOCK)

        s = jnp.einsum('bqghd,bngd->bghqn', qi, k_cmp).astype(jnp.float32) * scale
        s = s + bias_gh(qpos[:, None] - cmp_end[None, :])
        p_cmp = masked_softmax(s, cmp_end[None, :] <= qpos[:, None])
        o_cmp = jnp.einsum('bghqn,bngd->bqghd', p_cmp.astype(v_cmp.dtype), v_cmp)

        imp = jnp.einsum('bghqn,nj->bgqj', p_cmp, overlap)
        j = jnp.arange(n_slc)[None, :]
        cur = (qpos // SLC_LEN)[:, None]
        forced = (j == 0) | (j == cur) | (j == cur - 1)
        imp = jnp.where(forced, FORCE_SCORE, imp)
        imp = jnp.where(slc_start[None, :] <= qpos[:, None], imp, NEG_INF)
        _, sel = lax.top_k(imp, n_sel)
        k_sel = k_blk[b_idx, g_idx, sel].reshape(B, G, Q_BLOCK, n_sel * SLC_LEN, D)
        v_sel = v_blk[b_idx, g_idx, sel].reshape(B, G, Q_BLOCK, n_sel * SLC_LEN, D)
        tok = (sel[..., None] * SLC_LEN + jnp.arange(SLC_LEN)).reshape(B, G, Q_BLOCK, n_sel * SLC_LEN)
        bucket = rel_bucket(qpos[None, None, :, None] - tok)
        bias_sel = jnp.moveaxis(tbl_g[g_idx, bucket], -1, 2).astype(jnp.float32)
        s = jnp.einsum('bqghd,bgqnd->bghqn', qi, k_sel).astype(jnp.float32) * scale + bias_sel
        p = masked_softmax(s, (tok <= qpos[None, None, :, None])[:, :, None])
        o_slc = jnp.einsum('bghqn,bgqnd->bqghd', p.astype(v_sel.dtype), v_sel)

        kwin = lax.dynamic_slice_in_dim(k_pad, q0, WIN + Q_BLOCK, axis=1)
        vwin = lax.dynamic_slice_in_dim(v_pad, q0, WIN + Q_BLOCK, axis=1)
        kpos = q0 - WIN + jnp.arange(WIN + Q_BLOCK)
        dist = qpos[:, None] - kpos[None, :]
        s = jnp.einsum('bqghd,bkgd->bghqk', qi, kwin).astype(jnp.float32) * scale + bias_gh(dist)
        p = masked_softmax(s, (dist >= 0) & (dist < WIN) & (kpos[None, :] >= 0))
        o_win = jnp.einsum('bghqk,bkgd->bqghd', p.astype(vwin.dtype), vwin)

        out = gi[..., 0:1] * o_cmp + gi[..., 1:2] * o_slc + gi[..., 2:3] * o_win
        return out.astype(q.dtype).reshape(B, Q_BLOCK, G * HPG * D)

    out = lax.map(one_block, (qb, gb, jnp.arange(nb)))
    return out.swapaxes(0, 1).reshape(B, S, NSA_HEADS * D)


def memory_cross_attention(h, mem_n, w_mq, w_mkv, g_mq, g_mk, w_mo):
    B, S, _ = h.shape
    M = mem_n.shape[1]
    q = rms_norm((h @ w_mq).reshape(B, S, MEM_HEADS, MEM_HD), g_mq)
    kv = (mem_n @ w_mkv).reshape(B, M, 2, MEM_HEADS, MEM_HD)
    k = rms_norm(kv[:, :, 0], g_mk)
    v = kv[:, :, 1]
    s = jnp.einsum('bqhd,bkhd->bhqk', q, k).astype(jnp.float32) * MEM_HD ** -0.5
    p = jax.nn.softmax(s, axis=-1)
    o = jnp.einsum('bhqk,bkhd->bqhd', p.astype(v.dtype), v).reshape(B, S, MEM_HEADS * MEM_HD)
    return o @ w_mo


def moe_ffn(h, router_w, router_b, w_gate_up, b_gate_up, w_down, b_down):
    B, S, D = h.shape
    N = B * S
    NK = N * TOP_K
    t = h.reshape(N, D)
    logits = (t @ router_w + router_b).astype(jnp.float32)
    top_logit, top_idx = lax.top_k(logits, TOP_K)
    gates = jax.nn.softmax(top_logit, axis=-1)
    flat_e = top_idx.reshape(NK)
    flat_tok = jnp.arange(NK, dtype=jnp.int32) // TOP_K
    order = jnp.argsort(flat_e)
    se, stok, sgate = flat_e[order], flat_tok[order], gates.reshape(NK)[order]
    counts = jnp.bincount(flat_e, length=N_EXPERTS)
    start = jnp.cumsum(counts) - counts
    padded = (counts + MOE_BLOCK - 1) // MOE_BLOCK * MOE_BLOCK
    pad_end = jnp.cumsum(padded)
    pad_start = pad_end - padded
    dest = pad_start[se] + jnp.arange(NK) - start[se]
    P = ((NK + MOE_BLOCK - 1) // MOE_BLOCK + N_EXPERTS) * MOE_BLOCK
    buf_tok = jnp.zeros((P,), jnp.int32).at[dest].set(stok)
    buf_gate = jnp.zeros((P,), jnp.float32).at[dest].set(sgate)
    n_blk = P // MOE_BLOCK
    blk_e = jnp.minimum(jnp.searchsorted(pad_end, jnp.arange(n_blk) * MOE_BLOCK, side='right'), N_EXPERTS - 1)

    def expert_block(args):
        tok, e = args
        gu = t[tok] @ w_gate_up[e] + b_gate_up[e]
        gate = jnp.minimum(gu[:, 0::2], SWIGLU_LIMIT)
        up = jnp.clip(gu[:, 1::2], -SWIGLU_LIMIT, SWIGLU_LIMIT)
        act = (up + 1.0) * gate * jax.nn.sigmoid(SWIGLU_ALPHA * gate)
        return act @ w_down[e] + b_down[e]

    ys = lax.map(expert_block, (buf_tok.reshape(n_blk, MOE_BLOCK), blk_e)).reshape(P, D)
    out = jax.ops.segment_sum(ys * buf_gate[:, None].astype(ys.dtype), buf_tok, num_segments=N)
    return out.reshape(B, S, D)


def setup_inputs(seed: int = 0) -> dict:
    key = jax.random.key(seed)
    keys = iter(jax.random.split(key, 64))

    def nrm(shape, scale):
        return jax.random.normal(next(keys), shape, jnp.float32) * scale

    def gain(*shape):
        return 1.0 + nrm(shape, 0.05)

    L = DEPTH
    return {
        "x": nrm((BATCH, SEQ, D_MODEL), 1.0),
        "mem": nrm((BATCH, N_MEM, D_MODEL), 1.0),
        "g_attn_norm": gain(L, D_MODEL),
        "w_in": nrm((L, D_MODEL, IN_COLS), D_MODEL ** -0.5),
        "g_cq": gain(L, MLA_Q_RANK),
        "w_uq": nrm((L, MLA_Q_RANK, MLA_HEADS * (MLA_NOPE + MLA_ROPE)), MLA_Q_RANK ** -0.5),
        "g_ckv": gain(L, MLA_KV_RANK),
        "w_ukv": nrm((L, MLA_KV_RANK, MLA_HEADS * (MLA_NOPE + MLA_V)), MLA_KV_RANK ** -0.5),
        "g_q_mla": gain(L, MLA_NOPE + MLA_ROPE),
        "g_k_mla": gain(L, MLA_NOPE + MLA_ROPE),
        "cmp_k_pos": nrm((L, CMP_LEN, NSA_HD), 0.1),
        "cmp_k_w1": nrm((L, CMP_LEN, NSA_HD, CMP_HIDDEN), (CMP_LEN * NSA_HD) ** -0.5),
        "cmp_k_w2": nrm((L, CMP_HIDDEN, NSA_HD), CMP_HIDDEN ** -0.5),
        "cmp_v_pos": nrm((L, CMP_LEN, NSA_HD), 0.1),
        "cmp_v_w1": nrm((L, CMP_LEN, NSA_HD, CMP_HIDDEN), (CMP_LEN * NSA_HD) ** -0.5),
        "cmp_v_w2": nrm((L, CMP_HIDDEN, NSA_HD), CMP_HIDDEN ** -0.5),
        "g_q_nsa": gain(L, NSA_HD),
        "g_k_nsa": gain(L, NSA_HD),
        "rel_table": nrm((REL_BUCKETS, NSA_HEADS), 0.5),
        "g_out_mla": gain(L, MLA_HEADS * MLA_V),
        "g_out_nsa": gain(L, NSA_HEADS * NSA_HD),
        "w_out": nrm((L, D_MIX, D_MODEL), D_MIX ** -0.5),
        "g_mem_norm": gain(L, D_MODEL),
        "g_mem_src": gain(L, D_MODEL),
        "w_mq": nrm((L, D_MODEL, MEM_HEADS * MEM_HD), D_MODEL ** -0.5),
        "w_mkv": nrm((L, D_MODEL, 2 * MEM_HEADS * MEM_HD), D_MODEL ** -0.5),
        "g_mq": gain(L, MEM_HD),
        "g_mk": gain(L, MEM_HD),
        "w_mo": nrm((L, MEM_HEADS * MEM_HD, D_MODEL), (MEM_HEADS * MEM_HD) ** -0.5),
        "g_moe_norm": gain(L, D_MODEL),
        "router_w": nrm((L, D_MODEL, N_EXPERTS), D_MODEL ** -0.5),
        "router_b": nrm((L, N_EXPERTS), 0.01),
        "w_gate_up": nrm((L, N_EXPERTS, D_MODEL, 2 * D_FF), D_MODEL ** -0.5),
        "b_gate_up": nrm((L, N_EXPERTS, 2 * D_FF), 0.01),
        "w_down": nrm((L, N_EXPERTS, D_FF, D_MODEL), D_FF ** -0.5),
        "b_down": nrm((L, N_EXPERTS, D_MODEL), 0.01),
    }


def reference(x, mem, g_attn_norm, w_in, g_cq, w_uq, g_ckv, w_ukv, g_q_mla, g_k_mla,
              cmp_k_pos, cmp_k_w1, cmp_k_w2, cmp_v_pos, cmp_v_w1, cmp_v_w2, g_q_nsa, g_k_nsa,
              rel_table, g_out_mla, g_out_nsa, w_out, g_mem_norm, g_mem_src, w_mq, w_mkv,
              g_mq, g_mk, w_mo, g_moe_norm, router_w, router_b, w_gate_up, b_gate_up,
              w_down, b_down):
    split_points = np.cumsum(IN_SPLIT_SIZES)[:-1].tolist()
    for l in range(DEPTH):
        h = rms_norm(x, g_attn_norm[l])
        parts = jnp.split(h @ w_in[l], split_points, axis=-1)
        cq, ckv, krope, q_nsa = parts[0], parts[1], parts[2], parts[3]
        kc, vc, ks, vs, kw, vw = parts[4], parts[5], parts[6], parts[7], parts[8], parts[9]
        gate_logits = parts[10]
        y_mla = mla_mixer(cq, ckv, krope, g_cq[l], w_uq[l], g_ckv[l], w_ukv[l], g_q_mla[l], g_k_mla[l])
        y_nsa = nsa_mixer(q_nsa, kc, vc, ks, vs, kw, vw, gate_logits, cmp_k_pos[l], cmp_k_w1[l],
                          cmp_k_w2[l], cmp_v_pos[l], cmp_v_w1[l], cmp_v_w2[l], g_q_nsa[l], g_k_nsa[l],
                          rel_table)
        mix = jnp.concatenate([rms_norm(y_mla, g_out_mla[l]), rms_norm(y_nsa, g_out_nsa[l])], axis=-1)
        x = x + mix @ w_out[l]
        x = x + memory_cross_attention(rms_norm(x, g_mem_norm[l]), rms_norm(mem, g_mem_src[l]),
                                       w_mq[l], w_mkv[l], g_mq[l], g_mk[l], w_mo[l])
        x = x + moe_ffn(rms_norm(x, g_moe_norm[l]), router_w[l], router_b[l], w_gate_up[l],
                        b_gate_up[l], w_down[l], b_down[l])
    return x
```

```cpp
#include <hip/hip_runtime.h>
#include <cstdint>
#include <cstdio>

#define GAS __attribute__((address_space(1)))
#define LAS __attribute__((address_space(3)))
typedef unsigned short bf16;
typedef short bf16x8 __attribute__((ext_vector_type(8)));
typedef short s16x4 __attribute__((ext_vector_type(4)));
typedef float f32x4 __attribute__((ext_vector_type(4)));
typedef float f32x16 __attribute__((ext_vector_type(16)));
typedef unsigned u32x4 __attribute__((ext_vector_type(4)));
typedef unsigned u32x2 __attribute__((ext_vector_type(2)));
typedef float f32x2_t __attribute__((ext_vector_type(2)));
typedef __bf16 bf16x2_t __attribute__((ext_vector_type(2)));

constexpr int NB = 2, S = 8192, D = 1024, NTOK = NB * S;
constexpr int NINP = 1792;
constexpr int C_CQ = 0, C_CKV = 256, C_KR = 384, C_QN = 416, C_KC = 928, C_VC = 1056, C_KS = 1184, C_VS = 1312, C_KW = 1440, C_VW = 1568, C_GT = 1696;
constexpr float EPS = 1e-6f;
constexpr float LOG2E = 1.4426950408889634f;
constexpr int NEXP = 32, MROWS = 65536 + 32 * 256;

constexpr size_t MiB = 1u << 20;
constexpr size_t al256(size_t x) { return (x + 255) & ~(size_t)255; }
constexpr size_t WS_CTL = 0, CTL_BYTES = 1 * MiB;
constexpr size_t WS_CONST = 1 * MiB;
constexpr size_t WS_WIN = 2 * MiB;
constexpr size_t WS_WUQ = WS_WIN + al256((size_t)NINP * 1024 * 2);
constexpr size_t WS_WUKV = WS_WUQ + al256((size_t)768 * 256 * 2);
constexpr size_t WS_WOUT = WS_WUKV + al256((size_t)1024 * 256 * 2);
constexpr size_t WS_WMQ = WS_WOUT + al256((size_t)1024 * 1024 * 2);
constexpr size_t WS_WMO = WS_WMQ + al256((size_t)256 * 1024 * 2);
constexpr size_t WS_WGU = 16 * MiB;
constexpr size_t WS_WD = WS_WGU + 128 * MiB;
constexpr size_t WS_XB = WS_WD + 64 * MiB;
constexpr size_t WS_PB = WS_XB + 32 * MiB;
constexpr size_t WS_QRAW = WS_PB + 56 * MiB;
constexpr size_t WS_KVRAW = WS_QRAW + 24 * MiB;
constexpr size_t WS_QM = WS_KVRAW + 32 * MiB;
constexpr size_t WS_KM = WS_QM + 24 * MiB;
constexpr size_t WS_VM = WS_KM + 24 * MiB;
constexpr size_t WS_QN = WS_VM + 16 * MiB;
constexpr size_t WS_KS = WS_QN + 16 * MiB;
constexpr size_t WS_VS = WS_KS + 4 * MiB;
constexpr size_t WS_KW = WS_VS + 4 * MiB;
constexpr size_t WS_VW = WS_KW + 4 * MiB;
constexpr size_t WS_KCMP = WS_VW + 4 * MiB;
constexpr size_t WS_VCMP = WS_KCMP + 1 * MiB;
constexpr size_t WS_KMEM = WS_VCMP + 1 * MiB;
constexpr size_t WS_VMEM = WS_KMEM + 1 * MiB;
constexpr size_t WS_QBM = WS_VMEM + 1 * MiB;
constexpr size_t WS_QBN = WS_QBM + 1 * MiB;
constexpr size_t WS_RS = WS_QBN + 1 * MiB;
constexpr size_t WS_GATE = WS_RS + 1 * MiB;
constexpr size_t WS_ASG = WS_GATE + 2 * MiB;
constexpr size_t WS_Y = WS_ASG + 1 * MiB;
constexpr size_t WS_QMEM = WS_Y + 32 * MiB;
constexpr size_t WS_OMEM = WS_QMEM + 8 * MiB;
constexpr size_t WS_A1 = WS_OMEM + 8 * MiB;
constexpr size_t WS_ACT = WS_A1 + 144 * MiB;
constexpr size_t WS_END = WS_ACT + 144 * MiB;
constexpr int CW_BAR = 4096;
constexpr int CW_CNT = 16384;
constexpr int CF_KBM = 0, CF_KBN = 1, CF_KBMEM = 2, CF_MAXB2 = 8  , CF_BIAS2 = 64  , CF_LUT = 512  , CF_CPOSK = 1024  , CF_CPOSV = 1152  ;

constexpr int RING_BYTES = 131072;
constexpr int LDSCTL_OFF = RING_BYTES;
constexpr int LDSX_OFF = RING_BYTES + 512;
constexpr int LDS_BYTES = 147456;

__device__ __forceinline__ float bf2f(unsigned v) { return __uint_as_float(v << 16); }
__device__ __forceinline__ unsigned cvtpk(float lo, float hi) { f32x2_t v = {lo, hi}; bf16x2_t b = __builtin_convertvector(v, bf16x2_t); return __builtin_bit_cast(unsigned, b); }
__device__ __forceinline__ float wave_sum(float v) {
#pragma unroll
    for (int o = 1; o < 64; o <<= 1) v += __shfl_xor(v, o);
    return v;
}
__device__ __forceinline__ float wave_max(float v) {
#pragma unroll
    for (int o = 1; o < 64; o <<= 1) v = fmaxf(v, __shfl_xor(v, o));
    return v;
}
__device__ __forceinline__ float grp8_sum(float v) { v += __shfl_xor(v, 1); v += __shfl_xor(v, 2); v += __shfl_xor(v, 4); return v; }
#define LDS_WAIT() asm volatile("s_waitcnt lgkmcnt(0)" ::: "memory")
#define VM_WAIT() asm volatile("s_waitcnt vmcnt(0)" ::: "memory")

namespace pg8 {
constexpr int BM = 256, BK = 64, HALF = 128, HTB = HALF * BK * 2, STAGE_BYTES = 8 * HTB, NXCD = 8, WGM = 8;
__host__ __device__ __forceinline__ int lds_byte(int r, int c) { const int st = (r >> 4) * 2 + (c >> 5), rr = r & 15, cc = c & 31, ob = rr * 64 + cc * 2; return st * 1024 + (ob ^ (((ob >> 9) & 1) << 5)); }
__host__ __device__ __forceinline__ void stage_rc(int b, int& R, int& C) { const int st = b / 1024, sb = b % 1024, swz = sb ^ (((sb >> 9) & 1) << 5); R = (st >> 1) * 16 + swz / 64; C = (st & 1) * 32 + (swz % 64) / 2; }
__host__ __device__ __forceinline__ int perm32(int rho) { const int n = rho >> 4, i = rho & 15; return 8 * (i >> 2) + 4 * n + (i & 3); }
struct Unit { int pm, pn, aux; };
struct Gemm { const bf16* A; const bf16* Bt; int lda, ldb, K; };
struct StaticOrder {
    int nM, nN, nwg, G, c;
    __device__ void init(int M, int N, int G_, int c_) { nM = M / BM; nN = N / BM; nwg = nM * nN; G = G_; c = c_; }
    __device__ bool next(int i, Unit& u) const {
        const long L = (long)i * G + c; if (L >= nwg) return false;
        int wgid = (int)L; { const int q = nwg / NXCD, r = nwg % NXCD, xcd = wgid % NXCD, off = wgid / NXCD; wgid = (xcd < r ? xcd * (q + 1) : r * (q + 1) + (xcd - r) * q) + off; }
        const int nig = WGM * nN, gid = wgid / nig, fm = gid * WGM, gsz = (nM - fm) < WGM ? (nM - fm) : WGM;
        u.pm = fm + ((wgid % nig) % gsz); u.pn = (wgid % nig) / gsz; u.aux = 0; return true;
    }
};
struct MoeOrder {
    int ntn, xl, cl, nl; int mt[4], tp[4];
    __device__ bool next(int i, Unit& u) const {
        int L = i * nl + cl;
#pragma unroll
        for (int s = 0; s < 4; ++s) { const int nu = mt[s] * ntn; if (L < nu) { const int e = xl + 8 * s; u.pm = tp[s] + L % mt[s]; u.pn = e * ntn + L / mt[s]; u.aux = e; return true; } L -= nu; }
        return false;
    }
};
template <class Epi, class Sched>
__device__ __forceinline__ void gemm_phase(LAS unsigned char* lds, const Gemm g, const Sched& S, const Epi& E) {
    int tid_ = threadIdx.x; asm volatile("" : "+v"(tid_));
    const int tid = tid_, wid = __builtin_amdgcn_readfirstlane(tid >> 6), lane = tid & 63, wr = wid >> 2, wc = wid & 3, fr = lane & 15, fq = lane >> 4;
    const int K = g.K, nt = K / BK;
    unsigned voffA[2], voffB[2];
#pragma unroll
    for (int i = 0; i < 2; ++i) { int R, C; stage_rc(tid * 16 + i * 8192, R, C); const int Rb = Epi::PERM ? ((R & ~31) + perm32(R & 31)) : R;
        voffA[i] = (unsigned)(R * g.lda + C) * 2u; voffB[i] = (unsigned)(Rb * g.ldb + C) * 2u; }
    const size_t kstep = (size_t)(BK * 2);
    const size_t hstepA = (size_t)HALF * g.lda * 2, hstepB = (size_t)HALF * g.ldb * 2;
    const size_t tstepA = 2 * hstepA, tstepB = 2 * hstepB;
    const unsigned ldsw = (unsigned)wid * 1024u;
    const int aoff = lds_byte(wr * 64 + fr, fq * 8), boff = lds_byte(wc * 32 + fr, fq * 8);
#define PG8_SA(b, h) (((b) * 2 + (h)) * HTB)
#define PG8_SB(b, h) ((4 + (b) * 2 + (h)) * HTB)
#define PG8_STAGE(bufoff, gbase, voff) do { _Pragma("unroll") for (int _i = 0; _i < 2; ++_i) \
        __builtin_amdgcn_global_load_lds((const unsigned*)((const char*)(gbase) + (voff)[_i]), (LAS unsigned*)(lds + (bufoff) + ldsw + _i * 8192), 16, 0, 0); } while (0)
#define PG8_LDA(dst, b, h) do { _Pragma("unroll") for (int m = 0; m < 4; ++m) _Pragma("unroll") for (int k = 0; k < 2; ++k) dst[m][k] = *(const LAS bf16x8*)(lds + PG8_SA(b, h) + aoff + m * 2048 + k * 1024); } while (0)
#define PG8_LDB(dst, b, h) do { _Pragma("unroll") for (int n = 0; n < 2; ++n) _Pragma("unroll") for (int k = 0; k < 2; ++k) dst[n][k] = *(const LAS bf16x8*)(lds + PG8_SB(b, h) + boff + n * 2048 + k * 1024); } while (0)
#define PG8_MMA(ai, bj, At, Bt) do { __builtin_amdgcn_s_setprio(1); _Pragma("unroll") for (int m = 0; m < 4; ++m) _Pragma("unroll") for (int n = 0; n < 2; ++n) _Pragma("unroll") for (int k = 0; k < 2; ++k) \
        acc[ai][bj][m][n] = __builtin_amdgcn_mfma_f32_16x16x32_bf16(Bt[n][k], At[m][k], acc[ai][bj][m][n], 0, 0, 0); __builtin_amdgcn_s_setprio(0); } while (0)
#define PG8_WAIT_V(n) asm volatile("s_waitcnt vmcnt(" #n ")" ::: "memory")
#define PG8_WAIT_L(n) asm volatile("s_waitcnt lgkmcnt(" #n ")" ::: "memory")
#define PG8_BAR __builtin_amdgcn_s_barrier()
#define PG8_SCHED __builtin_amdgcn_sched_barrier(0)
    Unit cur, nxt; int ui = 0;
    if (!S.next(0, cur)) return;
    f32x4 acc[2][2][4][2];
#pragma unroll
    for (int a = 0; a < 2; ++a)
#pragma unroll
        for (int b = 0; b < 2; ++b)
#pragma unroll
            for (int m = 0; m < 4; ++m)
#pragma unroll
                for (int n = 0; n < 2; ++n) acc[a][b][m][n] = (f32x4){0.f, 0.f, 0.f, 0.f};
    bf16x8 At[4][2], B0[2][2], B1[2][2];
    const char* cA = (const char*)g.A + (size_t)cur.pm * tstepA; const char* cB = (const char*)g.Bt + (size_t)cur.pn * tstepB;
    PG8_STAGE(PG8_SB(0, 0), cB, voffB); PG8_STAGE(PG8_SB(0, 1), cB + hstepB, voffB); PG8_STAGE(PG8_SA(0, 0), cA, voffA); PG8_STAGE(PG8_SA(0, 1), cA + hstepA, voffA);
    if (wr == 1) PG8_BAR;
    PG8_WAIT_V(2); PG8_BAR;
    PG8_STAGE(PG8_SB(1, 0), cB + kstep, voffB); PG8_STAGE(PG8_SA(1, 0), cA + kstep, voffA); PG8_STAGE(PG8_SB(1, 1), cB + hstepB + kstep, voffB);
    PG8_WAIT_V(6); PG8_BAR;
    for (;;) {
        const bool has_next = S.next(ui + 1, nxt);
        const char* nA = has_next ? (const char*)g.A + (size_t)nxt.pm * tstepA : cA; const char* nB = has_next ? (const char*)g.Bt + (size_t)nxt.pn * tstepB : cB;
#pragma unroll 1
        for (int t = 0; t < nt; t += 2) {
            const bool last = (t == nt - 2);
            const char* a1 = cA + (size_t)(t + 1) * kstep;
            const char* a2 = last ? nA : cA + (size_t)(t + 2) * kstep; const char* b2 = last ? nB : cB + (size_t)(t + 2) * kstep;
            const char* a3 = a2 + kstep; const char* b3 = b2 + kstep;
            PG8_LDB(B0, 0, 0); PG8_LDB(B1, 0, 1); PG8_SCHED; PG8_LDA(At, 0, 0); PG8_STAGE(PG8_SA(1, 1), a1 + hstepA, voffA);
            PG8_WAIT_V(8); PG8_WAIT_L(0); PG8_BAR; PG8_MMA(0, 0, At, B0); PG8_MMA(0, 1, At, B1); PG8_BAR; PG8_SCHED;
            PG8_LDA(At, 0, 1); PG8_STAGE(PG8_SB(0, 0), b2, voffB); PG8_STAGE(PG8_SB(0, 1), b2 + hstepB, voffB); PG8_STAGE(PG8_SA(0, 0), a2, voffA);
            PG8_WAIT_V(8); PG8_WAIT_L(0); PG8_BAR; PG8_MMA(1, 0, At, B0); PG8_MMA(1, 1, At, B1); PG8_BAR; PG8_SCHED;
            PG8_LDB(B0, 1, 0); PG8_LDB(B1, 1, 1); PG8_SCHED; PG8_LDA(At, 1, 0); PG8_STAGE(PG8_SA(0, 1), a2 + hstepA, voffA);
            PG8_WAIT_V(8); PG8_WAIT_L(0); PG8_BAR; PG8_MMA(0, 0, At, B0); PG8_MMA(0, 1, At, B1); PG8_BAR; PG8_SCHED;
            PG8_LDA(At, 1, 1); PG8_STAGE(PG8_SB(1, 0), b3, voffB); PG8_STAGE(PG8_SB(1, 1), b3 + hstepB, voffB); PG8_STAGE(PG8_SA(1, 0), a3, voffA);
            PG8_WAIT_V(8); PG8_WAIT_L(0); PG8_BAR; PG8_MMA(1, 0, At, B0); PG8_MMA(1, 1, At, B1); PG8_BAR; PG8_SCHED;
        }
        if (wr == 0) PG8_BAR;
        E(acc, cur, wr, wc, fr, fq);
        if (!has_next) break;
#pragma unroll
        for (int a = 0; a < 2; ++a)
#pragma unroll
            for (int b = 0; b < 2; ++b)
#pragma unroll
                for (int m = 0; m < 4; ++m)
#pragma unroll
                    for (int n = 0; n < 2; ++n) acc[a][b][m][n] = (f32x4){0.f, 0.f, 0.f, 0.f};
        cur = nxt; cA = nA; cB = nB; ++ui;
        if (wr == 1) PG8_BAR;
    }
    PG8_WAIT_V(0);
    PG8_BAR;
#undef PG8_SA
#undef PG8_SB
#undef PG8_STAGE
#undef PG8_LDA
#undef PG8_LDB
#undef PG8_MMA
#undef PG8_WAIT_V
#undef PG8_WAIT_L
#undef PG8_BAR
#undef PG8_SCHED
}
struct EpiScaleBf16 {
    static constexpr bool PERM = true;
    bf16* O; int ldc; const float* rs; int rs_stride;
    __device__ __forceinline__ void operator()(const f32x4 (&acc)[2][2][4][2], const Unit& u, int wr, int wc, int fr, int fq) const {
        const int row0 = u.pm * BM + wr * 64 + fr, col0 = u.pn * BM + wc * 32 + 8 * fq;
#pragma unroll
        for (int ai = 0; ai < 2; ++ai)
#pragma unroll
            for (int m = 0; m < 4; ++m) { const int row = row0 + ai * HALF + m * 16; const float sc = rs[(size_t)row * rs_stride]; bf16* rowp = O + (size_t)row * ldc + col0;
#pragma unroll
                for (int bj = 0; bj < 2; ++bj) { const f32x4 v0 = acc[ai][bj][m][0] * sc, v1 = acc[ai][bj][m][1] * sc;
                    u32x4 w; w.x = cvtpk(v0[0], v0[1]); w.y = cvtpk(v0[2], v0[3]); w.z = cvtpk(v1[0], v1[1]); w.w = cvtpk(v1[2], v1[3]);
                    *(u32x4*)(rowp + bj * HALF) = w; } }
    }
};
struct EpiResF32 {
    static constexpr bool PERM = false;
    const float* base; float* out; int ldc;
    __device__ __forceinline__ void operator()(const f32x4 (&acc)[2][2][4][2], const Unit& u, int wr, int wc, int fr, int fq) const {
        const int row0 = u.pm * BM + wr * 64 + fr, col0 = u.pn * BM + wc * 32 + 4 * fq;
#pragma unroll
        for (int ai = 0; ai < 2; ++ai)
#pragma unroll
            for (int m = 0; m < 4; ++m) { const size_t off = (size_t)(row0 + ai * HALF + m * 16) * ldc + col0;
#pragma unroll
                for (int bj = 0; bj < 2; ++bj)
#pragma unroll
                    for (int n = 0; n < 2; ++n) { const f32x4 bs = *(const f32x4*)(base + off + bj * HALF + n * 16); *(f32x4*)(out + off + bj * HALF + n * 16) = bs + acc[ai][bj][m][n]; } }
    }
};
struct EpiSwiglu {
    static constexpr bool PERM = true;
    bf16* act; const float* bgu;
    __device__ __forceinline__ void operator()(const f32x4 (&acc)[2][2][4][2], const Unit& u, int wr, int wc, int fr, int fq) const {
        const int e = u.aux, pnl = u.pn - e * 8;
        const int row0 = u.pm * BM + wr * 64 + fr, a0 = pnl * 128 + wc * 32 + 8 * fq;
        float bg[8], bu[8];
#pragma unroll
        for (int j = 0; j < 8; ++j) { const f32x2_t b2 = *(const f32x2_t*)(bgu + (size_t)e * 2048 + 2 * (a0 + j)); bg[j] = b2.x; bu[j] = b2.y; }
#pragma unroll
        for (int ai = 0; ai < 2; ++ai)
#pragma unroll
            for (int m = 0; m < 4; ++m) { const int row = row0 + ai * HALF + m * 16; float o[8];
#pragma unroll
                for (int j = 0; j < 8; ++j) { float gt = acc[ai][0][m][j >> 2][j & 3] + bg[j], up = acc[ai][1][m][j >> 2][j & 3] + bu[j];
                    gt = fminf(gt, 7.0f); up = fminf(fmaxf(up, -7.0f), 7.0f);
                    const float sg = __builtin_amdgcn_rcpf(1.0f + __builtin_amdgcn_exp2f(-1.702f * LOG2E * gt));
                    o[j] = (up + 1.0f) * gt * sg; }
                u32x4 w; w.x = cvtpk(o[0], o[1]); w.y = cvtpk(o[2], o[3]); w.z = cvtpk(o[4], o[5]); w.w = cvtpk(o[6], o[7]);
                *(u32x4*)(act + (size_t)row * 1024 + a0) = w; }
    }
};
struct EpiDown {
    static constexpr bool PERM = true;
    bf16* Y; const float* bd;
    __device__ __forceinline__ void operator()(const f32x4 (&acc)[2][2][4][2], const Unit& u, int wr, int wc, int fr, int fq) const {
        const int e = u.aux, pnl = u.pn - e * 4;
        const int row0 = u.pm * BM + wr * 64 + fr, c0 = pnl * BM + wc * 32 + 8 * fq;
#pragma unroll
        for (int bj = 0; bj < 2; ++bj) { const f32x4 b0 = *(const f32x4*)(bd + (size_t)e * 1024 + c0 + bj * HALF), b1 = *(const f32x4*)(bd + (size_t)e * 1024 + c0 + bj * HALF + 4);
#pragma unroll
            for (int ai = 0; ai < 2; ++ai)
#pragma unroll
                for (int m = 0; m < 4; ++m) { const int row = row0 + ai * HALF + m * 16; const f32x4 v0 = acc[ai][bj][m][0] + b0, v1 = acc[ai][bj][m][1] + b1;
                    u32x4 w; w.x = cvtpk(v0[0], v0[1]); w.y = cvtpk(v0[2], v0[3]); w.z = cvtpk(v1[0], v1[1]); w.w = cvtpk(v1[2], v1[3]);
                    *(u32x4*)(Y + (size_t)row * 1024 + c0 + bj * HALF) = w; } }
    }
};
}

#define XB_TMO      128
#define XB_XCNT(j)  (256  + 64 * (j))
#define XB_XSUB(j)  (1280 + 64 * (j))
#define XB_XGEN(j)  (2304 + 64 * (j))
#define XB_TOP      3328
#define XB_TOPGEN   3392
#define XCD_BAR_WORDS 3456
#define XB_SPIN_CAP (1u << 18)
__device__ __forceinline__ unsigned xb_ld(unsigned* p)              { return __hip_atomic_load(p, __ATOMIC_RELAXED, __HIP_MEMORY_SCOPE_AGENT); }
__device__ __forceinline__ unsigned xb_add(unsigned* p, unsigned v) { return __hip_atomic_fetch_add(p, v, __ATOMIC_RELAXED, __HIP_MEMORY_SCOPE_AGENT); }
__device__ __forceinline__ unsigned xb_xcc_id() { return (unsigned)__builtin_amdgcn_s_getreg((3 << 11) | 20) & 0xFu; }
#define XB_SPIN(cond, bar) do { unsigned _sp = 0; while (cond) { __builtin_amdgcn_s_sleep(1); \
    if ((++_sp & 255u) == 0u) { if (xb_ld(&(bar)[XB_TMO])) break; if (_sp > XB_SPIN_CAP) { atomicAdd(&(bar)[XB_TMO], 1u); break; } } } } while (0)
struct XcdBarrier { unsigned* bar; unsigned x; volatile LAS unsigned* st; };
__device__ __forceinline__ XcdBarrier xcd_barrier_post(unsigned* bar, volatile LAS unsigned* st) {
    XcdBarrier b; b.bar = bar; b.x = xb_xcc_id(); b.st = st;
    if (threadIdx.x == 0) (void)xb_add(&bar[XB_XCNT(b.x)], 1u);
    return b;
}
__device__ __forceinline__ void xcd_barrier_complete(unsigned* bar, unsigned x, unsigned& nloc, unsigned& nx) {
    const unsigned G = gridDim.x * gridDim.y * gridDim.z;
    unsigned sum, cnt, mine, sp = 0u;
    for (;;) {
        sum = 0u; cnt = 0u; mine = 0u;
#pragma unroll
        for (unsigned j = 0; j < 16; ++j) { const unsigned c = xb_ld(&bar[XB_XCNT(j)]); sum += c; cnt += (c > 0u) ? 1u : 0u; mine = (j == x) ? c : mine; }
        if (sum == G) break;
        __builtin_amdgcn_s_sleep(1);
        if ((++sp & 255u) == 0u) { if (xb_ld(&bar[XB_TMO])) break; if (sp > XB_SPIN_CAP) { atomicAdd(&bar[XB_TMO], 1u); break; } }
    }
    nloc = mine > 0u ? mine : 1u; nx = cnt > 0u ? cnt : 1u;
}
__device__ __forceinline__ void xcd_barrier(const XcdBarrier& b) {
    asm volatile("s_waitcnt vmcnt(0)" ::: "memory");
    __syncthreads();
    if (threadIdx.x == 0) {
        unsigned* bar = b.bar;
        __builtin_amdgcn_s_waitcnt(0);
        unsigned nloc = b.st[0], nx = b.st[1];
        if (nloc == 0u) { xcd_barrier_complete(bar, b.x, nloc, nx); b.st[0] = nloc; b.st[1] = nx; }
        const unsigned old = xb_add(&bar[XB_XSUB(b.x)], 1u);
        const unsigned gen = old / nloc;
        if (old + 1u == (gen + 1u) * nloc) {
            __builtin_amdgcn_fence(__ATOMIC_RELEASE, "agent");
            asm volatile("s_waitcnt vmcnt(0)" ::: "memory");
            const unsigned og = xb_add(&bar[XB_TOP], 1u);
            const unsigned tg = og / nx;
            if (og + 1u == (tg + 1u) * nx) xb_add(&bar[XB_TOPGEN], 1u);
            else XB_SPIN(xb_ld(&bar[XB_TOPGEN]) == tg, bar);
            __builtin_amdgcn_fence(__ATOMIC_ACQUIRE, "agent");
            xb_add(&bar[XB_XGEN(b.x)], 1u);
            asm volatile("s_waitcnt vmcnt(0)" ::: "memory");
        } else {
            XB_SPIN(xb_ld(&bar[XB_XGEN(b.x)]) == gen, bar);
            __builtin_amdgcn_fence(__ATOMIC_ACQUIRE, "agent");
            asm volatile("s_waitcnt vmcnt(0)" ::: "memory");
        }
    }
    __syncthreads();
}

struct Args { const float* in[36]; float* out; unsigned char* ws; };
struct Frame {
    LAS unsigned char* lds; int tid, lane, wave, G, bid, gw, ngw;
    const float* const* in; float* out; unsigned char* ws;
};
#define WSP(T, off) ((T*)(F.ws + (off)))

template <class CM>
__device__ __forceinline__ void tr_item(const float* W, int ldw, int kvalid, const float* gain, const float* gain2, int gsplit, bf16* WT, int ldd, int k0, int n0, CM cm, LAS float* scr, int lane) {
    const int nn = n0 + (lane & 31); const int sc = cm(nn);
#pragma unroll 8
    for (int i = 0; i < 32; ++i) { const int kk = 2 * i + (lane >> 5), k = k0 + kk; float v = 0.f;
        if (sc >= 0 && k < kvalid) { v = W[(size_t)k * ldw + sc]; if (gain) v *= (k < gsplit ? gain[k] : gain2[k - gsplit]); }
        scr[kk * 33 + (lane & 31)] = v; }
    LDS_WAIT(); asm volatile("" ::: "memory");
    const int c = lane & 7;
#pragma unroll
    for (int j = 0; j < 4; ++j) { const int n = (lane >> 3) + 8 * j; const LAS float* s = scr + (8 * c) * 33 + n;
        u32x4 o; o.x = cvtpk(s[0 * 33], s[1 * 33]); o.y = cvtpk(s[2 * 33], s[3 * 33]); o.z = cvtpk(s[4 * 33], s[5 * 33]); o.w = cvtpk(s[6 * 33], s[7 * 33]);
        *(u32x4*)(WT + (size_t)(n0 + n) * ldd + k0 + 8 * c) = o; }
    LDS_WAIT(); asm volatile("" ::: "memory");
}
struct CmId { int nvalid; __device__ int operator()(int n) const { return n < nvalid ? n : -1; } };
struct CmGu { __device__ int operator()(int n) const { const int a = 128 * (n >> 8) + (n & 127); return 2 * a + ((n >> 7) & 1); } };

__device__ __forceinline__ void p0_prologue(Frame& F) {
    LAS float* scr = (LAS float*)(F.lds + F.wave * 16384);
    const float* const* in = F.in;
    constexpr int I0 = 16 * 56, I1 = 4 * 24, I2 = 4 * 32, I3 = 16 * 32, I4 = 16 * 8, I5 = 4 * 32, I6 = 32 * 16 * 64, I7 = 32 * 16 * 32;
    constexpr int NITEMS = I0 + I1 + I2 + I3 + I4 + I5 + I6 + I7;
    for (int it = F.gw; it < NITEMS; it += F.ngw) {
        int r = it;
        if (r < I0) { const int kb = r / 56, nb = r % 56; tr_item(in[3], 1720, 1024, in[2], in[2], 1 << 30, WSP(bf16, WS_WIN), 1024, 64 * kb, 32 * nb, CmId{1720}, scr, F.lane); continue; } r -= I0;
        if (r < I1) { const int kb = r / 24, nb = r % 24; tr_item(in[5], 768, 256, in[4], in[4], 1 << 30, WSP(bf16, WS_WUQ), 256, 64 * kb, 32 * nb, CmId{768}, scr, F.lane); continue; } r -= I1;
        if (r < I2) { const int kb = r / 32, nb = r % 32; tr_item(in[7], 1024, 128, in[6], in[6], 1 << 30, WSP(bf16, WS_WUKV), 256, 64 * kb, 32 * nb, CmId{1024}, scr, F.lane); continue; } r -= I2;
        if (r < I3) { const int kb = r / 32, nb = r % 32; tr_item(in[21], 1024, 1024, in[19], in[20], 512, WSP(bf16, WS_WOUT), 1024, 64 * kb, 32 * nb, CmId{1024}, scr, F.lane); continue; } r -= I3;
        if (r < I4) { const int kb = r / 8, nb = r % 8; tr_item(in[24], 256, 1024, in[22], in[22], 1 << 30, WSP(bf16, WS_WMQ), 1024, 64 * kb, 32 * nb, CmId{256}, scr, F.lane); continue; } r -= I4;
        if (r < I5) { const int kb = r / 32, nb = r % 32; tr_item(in[28], 1024, 256, (const float*)nullptr, (const float*)nullptr, 0, WSP(bf16, WS_WMO), 256, 64 * kb, 32 * nb, CmId{1024}, scr, F.lane); continue; } r -= I5;
        if (r < I6) { const int e = r / 1024, q = r % 1024, kb = q / 64, nb = q % 64;
            tr_item(in[32] + (size_t)e * 1024 * 2048, 2048, 1024, in[29], in[29], 1 << 30, WSP(bf16, WS_WGU) + (size_t)e * 2048 * 1024, 1024, 64 * kb, 32 * nb, CmGu{}, scr, F.lane); continue; } r -= I6;
        { const int e = r / 512, q = r % 512, kb = q / 32, nb = q % 32;
            tr_item(in[34] + (size_t)e * 1024 * 1024, 1024, 1024, (const float*)nullptr, (const float*)nullptr, 0, WSP(bf16, WS_WD) + (size_t)e * 1024 * 1024, 1024, 64 * kb, 32 * nb, CmId{1024}, scr, F.lane); }
    }
    { float* RS = WSP(float, WS_RS); bf16* XB = WSP(bf16, WS_XB);
      for (int m = F.gw; m < NTOK; m += F.ngw) {
        const f32x4* xr = (const f32x4*)(in[0] + (size_t)m * D) + F.lane; f32x4 v[4]; float s = 0.f;
#pragma unroll
        for (int j = 0; j < 4; ++j) { v[j] = xr[64 * j]; s += (v[j].x * v[j].x + v[j].y * v[j].y) + (v[j].z * v[j].z + v[j].w * v[j].w); }
        s = wave_sum(s); if (F.lane == 0) RS[m * 4 + 0] = 1.0f / sqrtf(s * (1.0f / D) + EPS);
        u32x2* o8 = (u32x2*)(XB + (size_t)m * D) + F.lane;
#pragma unroll
        for (int j = 0; j < 4; ++j) { u32x2 w; w.x = cvtpk(v[j].x, v[j].y); w.y = cvtpk(v[j].z, v[j].w); o8[64 * j] = w; }
      } }
    float* CF = WSP(float, WS_CONST);
    if (F.bid == 0 && F.wave == 1) {
        const int l = F.lane;
        float m1 = 0.f; for (int i = l; i < 96; i += 64) m1 = fmaxf(m1, fabsf(in[9][i])); m1 = wave_max(m1);
        float m2 = wave_max(fabsf(in[17][l])); float m3 = wave_max(fabsf(in[27][l]));
        if (l == 0) { CF[CF_KBM] = sqrtf(96.f) * m1; CF[CF_KBN] = 8.f * m2; CF[CF_KBMEM] = 8.f * m3; }
        if (l < 8) { float mb = -1e30f; for (int b = 0; b < 32; ++b) mb = fmaxf(mb, in[18][b * 8 + l]); CF[CF_MAXB2 + l] = mb * LOG2E; }
        for (int i = l; i < 256; i += 64) CF[CF_BIAS2 + i] = in[18][i] * LOG2E;
        for (int n = l; n < 512; n += 64) { int bk; if (n < 16) bk = n; else { bk = 16 + (int)(logf((float)n / 16.0f) / logf(32.0f) * 16.0f); bk = bk < 31 ? bk : 31; } CF[CF_LUT + n] = (float)bk; }
    }
    if ((F.bid == 1 || F.bid == 2) && F.wave == 1) {
        const float* pos = in[F.bid == 1 ? 10 : 13]; const float* w1 = in[F.bid == 1 ? 11 : 14]; float a0 = 0.f, a1 = 0.f;
        for (int k = 0; k < 2048; ++k) { const float p = pos[k]; a0 += p * w1[(size_t)k * 128 + F.lane]; a1 += p * w1[(size_t)k * 128 + 64 + F.lane]; }
        CF[(F.bid == 1 ? CF_CPOSK : CF_CPOSV) + F.lane] = a0; CF[(F.bid == 1 ? CF_CPOSK : CF_CPOSV) + 64 + F.lane] = a1;
    }
    if (F.wave == 0 && F.bid < 256) {
        LAS float* xs = (LAS float*)(F.lds + LDSX_OFF);
        const float* gs = in[23];
#pragma unroll
        for (int rr = 0; rr < 2; ++rr) { const float* mr = in[1] + (size_t)(2 * F.bid + rr) * D; float v[16]; float s = 0.f;
#pragma unroll
            for (int i = 0; i < 16; ++i) { v[i] = mr[F.lane + 64 * i]; s += v[i] * v[i]; }
            s = wave_sum(s); const float rinv = 1.0f / sqrtf(s * (1.0f / D) + EPS);
#pragma unroll
            for (int i = 0; i < 16; ++i) xs[rr * 1024 + F.lane + 64 * i] = v[i] * rinv * gs[F.lane + 64 * i]; }
        LDS_WAIT(); asm volatile("" ::: "memory");
        float acc[2][8];
#pragma unroll
        for (int rr = 0; rr < 2; ++rr)
#pragma unroll
            for (int j = 0; j < 8; ++j) acc[rr][j] = 0.f;
        const float* w = in[25];
        for (int k = 0; k < 1024; ++k) { const float x0 = xs[k], x1 = xs[1024 + k];
#pragma unroll
            for (int j = 0; j < 8; ++j) { const float wv = w[(size_t)k * 512 + F.lane + 64 * j]; acc[0][j] += x0 * wv; acc[1][j] += x1 * wv; } }
        const float gk = in[27][F.lane];
#pragma unroll
        for (int rr = 0; rr < 2; ++rr) { const int row = 2 * F.bid + rr, b = row >> 8, mi = row & 255;
#pragma unroll
            for (int j = 0; j < 4; ++j) { const float s = wave_sum(acc[rr][j] * acc[rr][j]); const float kn = acc[rr][j] * (1.0f / sqrtf(s * (1.0f / 64) + EPS)) * gk;
                WSP(bf16, WS_KMEM)[(((size_t)b * 4 + j) * 256 + mi) * 64 + F.lane] = (bf16)(cvtpk(kn, 0.f) & 0xffff);
                WSP(bf16, WS_VMEM)[(((size_t)b * 4 + j) * 256 + mi) * 64 + F.lane] = (bf16)(cvtpk(acc[rr][4 + j], 0.f) & 0xffff); } }
    }
}

__device__ __forceinline__ void unpack8(const u32x4 w, float (&v)[8]) {
    v[0] = bf2f(w.x & 0xffff); v[1] = bf2f(w.x >> 16); v[2] = bf2f(w.y & 0xffff); v[3] = bf2f(w.y >> 16);
    v[4] = bf2f(w.z & 0xffff); v[5] = bf2f(w.z >> 16); v[6] = bf2f(w.w & 0xffff); v[7] = bf2f(w.w >> 16);
}
__device__ __forceinline__ u32x4 pack8f(const float (&v)[8]) { u32x4 w; w.x = cvtpk(v[0], v[1]); w.y = cvtpk(v[2], v[3]); w.z = cvtpk(v[4], v[5]); w.w = cvtpk(v[6], v[7]); return w; }

__device__ __forceinline__ void tp_a(Frame& F) {
    const float* CF = WSP(float, WS_CONST); const float kbn = CF[CF_KBN];
    const bf16* PB = WSP(bf16, WS_PB); float* RS = WSP(float, WS_RS);
    const int l = F.lane;
    const float* gq = F.in[16]; const float* gk = F.in[17];
    float gqv[8], gkv[8];
#pragma unroll
    for (int j = 0; j < 8; ++j) { gqv[j] = gq[(8 * l + j) & 63]; gkv[j] = gk[(8 * l + j) & 63]; }
    for (int t = F.gw; t < NTOK; t += F.ngw) {
        const bf16* pr = PB + (size_t)t * NINP; const int b = t >> 13, s = t & 8191;
        { const u32x2 w = *(const u32x2*)(pr + C_CQ + 4 * l); const float a0 = bf2f(w.x & 0xffff), a1 = bf2f(w.x >> 16), a2 = bf2f(w.y & 0xffff), a3 = bf2f(w.y >> 16);
          const float sq = wave_sum(a0 * a0 + a1 * a1 + a2 * a2 + a3 * a3);
          const unsigned w2 = *(const unsigned*)(pr + C_CKV + 2 * l); const float c0 = bf2f(w2 & 0xffff), c1 = bf2f(w2 >> 16);
          const float sk = wave_sum(c0 * c0 + c1 * c1);
          if (l == 0) { RS[t * 4 + 1] = 1.0f / sqrtf(sq * (1.0f / 256) + EPS); RS[t * 4 + 2] = 1.0f / sqrtf(sk * (1.0f / 128) + EPS); } }
        { float v[8]; unpack8(*(const u32x4*)(pr + C_QN + 8 * l), v); float ss = 0.f;
#pragma unroll
          for (int j = 0; j < 8; ++j) ss += v[j] * v[j];
          ss = grp8_sum(ss); const float rinv = 1.0f / sqrtf(ss * (1.0f / 64) + EPS) * (0.125f * LOG2E); float n2 = 0.f;
#pragma unroll
          for (int j = 0; j < 8; ++j) { v[j] = v[j] * rinv * gqv[j]; n2 += v[j] * v[j]; }
          n2 = grp8_sum(n2);
          const int h = l >> 3, g = h >> 2, hp = h & 3; const size_t ridx = (((size_t)(b * 2 + g) * S + s) * 4 + hp);
          *(u32x4*)(WSP(bf16, WS_QN) + ridx * 64 + (8 * l & 63)) = pack8f(v);
          if ((l & 7) == 0) WSP(float, WS_QBN)[ridx] = sqrtf(n2) * kbn + CF[CF_MAXB2 + h]; }
        { float v[8]; unpack8(*(const u32x4*)(pr + C_KS + 8 * l), v); const int seg = l >> 4, i = l & 15, g = i >> 3, d0 = (i & 7) * 8;
          float ss = 0.f;
#pragma unroll
          for (int j = 0; j < 8; ++j) ss += v[j] * v[j];
          ss = grp8_sum(ss);
          if ((seg & 1) == 0) { const float rinv = 1.0f / sqrtf(ss * (1.0f / 64) + EPS);
#pragma unroll
              for (int j = 0; j < 8; ++j) v[j] = v[j] * rinv * gkv[j]; }
          bf16* dst = WSP(bf16, seg == 0 ? WS_KS : seg == 1 ? WS_VS : seg == 2 ? WS_KW : WS_VW);
          *(u32x4*)(dst + ((size_t)(b * 2 + g) * S + s) * 64 + d0) = pack8f(v); }
        if (l < 24) { const float x = bf2f(pr[C_GT + l]); WSP(float, WS_GATE)[t * 24 + l] = 1.0f / (1.0f + __expf(-x)); }
    }
}

__device__ __forceinline__ void compress_phase(Frame& F) {
    const float* CF = WSP(float, WS_CONST);
    const bf16* PB = WSP(bf16, WS_PB);
    LAS float* wl = (LAS float*)F.lds;
    LAS float* hs = (LAS float*)(F.lds + 32768) + F.wave * 128;
    for (int it = F.bid; it < 512; it += F.G) {
        const int kv = it >> 8, slab = (it >> 6) & 3, n = (it & 63) * 8 + F.wave, b = slab >> 1, g = slab & 1;
        const float* w1 = F.in[kv ? 14 : 11]; const float* w2 = F.in[kv ? 15 : 12];
        const int col = (kv ? C_VC : C_KC) + g * 64 + F.lane;
        float a0 = CF[(kv ? CF_CPOSV : CF_CPOSK) + F.lane], a1 = CF[(kv ? CF_CPOSV : CF_CPOSK) + 64 + F.lane];
        const bool valid = n < 511;
        for (int l = 0; l < 32; ++l) {
            __syncthreads();
            for (int i = F.tid; i < 2048; i += 512) *(LAS f32x4*)(wl + 4 * i) = *(const f32x4*)(w1 + (size_t)l * 8192 + 4 * i);
            float xv = 0.f; if (valid) xv = bf2f(PB[(size_t)(b * S + 16 * n + l) * NINP + col]);
            __syncthreads();
#pragma unroll 16
            for (int d = 0; d < 64; ++d) { const float x = __shfl(xv, d); a0 += x * wl[d * 128 + F.lane]; a1 += x * wl[d * 128 + 64 + F.lane]; }
        }
        { const float c0 = 0.7978845608028654f, c1 = 0.044715f;
          float t0 = tanhf(c0 * (a0 + c1 * a0 * a0 * a0)), t1 = tanhf(c0 * (a1 + c1 * a1 * a1 * a1));
          hs[F.lane] = 0.5f * a0 * (1.f + t0); hs[64 + F.lane] = 0.5f * a1 * (1.f + t1); }
        LDS_WAIT(); asm volatile("" ::: "memory");
        float o = 0.f;
        for (int f = 0; f < 128; ++f) o += hs[f] * w2[f * 64 + F.lane];
        if (kv == 0) { const float ss = wave_sum(o * o); o = o * (1.0f / sqrtf(ss * (1.0f / 64) + EPS)) * F.in[17][F.lane]; }
        if (valid) WSP(bf16, kv ? WS_VCMP : WS_KCMP)[((size_t)slab * 512 + n) * 64 + F.lane] = (bf16)(cvtpk(o, 0.f) & 0xffff);
        else if (n == 511) WSP(bf16, kv ? WS_VCMP : WS_KCMP)[((size_t)slab * 512 + n) * 64 + F.lane] = 0;
    }
    __syncthreads();
}

__device__ __forceinline__ void tp_b(Frame& F) {
    const float* CF = WSP(float, WS_CONST); const float kbm = CF[CF_KBM];
    const bf16* PB = WSP(bf16, WS_PB); const bf16* QR = WSP(bf16, WS_QRAW); const bf16* KVR = WSP(bf16, WS_KVRAW);
    const int l = F.lane, h = l >> 3, c = l & 7;
    const float* gq = F.in[8]; const float* gk = F.in[9];
    float gqn[8], gkn[8], gqr[4], gkr[4];
#pragma unroll
    for (int j = 0; j < 8; ++j) { gqn[j] = gq[8 * c + j]; gkn[j] = gk[8 * c + j]; }
    gqr[0] = gq[64 + 2 * c]; gqr[1] = gq[65 + 2 * c]; gqr[2] = gq[80 + 2 * c]; gqr[3] = gq[81 + 2 * c];
    gkr[0] = gk[64 + 2 * c]; gkr[1] = gk[65 + 2 * c]; gkr[2] = gk[80 + 2 * c]; gkr[3] = gk[81 + 2 * c];
    const float if0 = exp2f(-(float)(2 * c) * (13.287712379549449f / 16.0f)), if1 = exp2f(-(float)(2 * c + 1) * (13.287712379549449f / 16.0f));
    const float cq = 0.10206207261596575f * LOG2E;
    for (int t = F.gw; t < NTOK; t += F.ngw) {
        const int b = t >> 13, s = t & 8191; const size_t hrow = ((size_t)(b * 8 + h) * S + s);
        float sn0, cs0, sn1, cs1; sincosf((float)s * if0, &sn0, &cs0); sincosf((float)s * if1, &sn1, &cs1);
        {
          float v[8]; unpack8(*(const u32x4*)(QR + (size_t)t * 768 + h * 96 + 8 * c), v);
          const unsigned wa = *(const unsigned*)(QR + (size_t)t * 768 + h * 96 + 64 + 2 * c), wb = *(const unsigned*)(QR + (size_t)t * 768 + h * 96 + 80 + 2 * c);
          float r0 = bf2f(wa & 0xffff), r1 = bf2f(wa >> 16), r2 = bf2f(wb & 0xffff), r3 = bf2f(wb >> 16);
          float ss = r0 * r0 + r1 * r1 + r2 * r2 + r3 * r3;
#pragma unroll
          for (int j = 0; j < 8; ++j) ss += v[j] * v[j];
          ss = grp8_sum(ss); const float rinv = 1.0f / sqrtf(ss * (1.0f / 96) + EPS) * cq; float n2 = 0.f;
#pragma unroll
          for (int j = 0; j < 8; ++j) { v[j] = v[j] * rinv * gqn[j]; n2 += v[j] * v[j]; }
          r0 *= rinv * gqr[0]; r1 *= rinv * gqr[1]; r2 *= rinv * gqr[2]; r3 *= rinv * gqr[3];
          const float y0 = r0 * cs0 - r2 * sn0, y2 = r2 * cs0 + r0 * sn0, y1 = r1 * cs1 - r3 * sn1, y3 = r3 * cs1 + r1 * sn1;
          n2 += y0 * y0 + y1 * y1 + y2 * y2 + y3 * y3; n2 = grp8_sum(n2);
          bf16* dst = WSP(bf16, WS_QM) + hrow * 96;
          *(u32x4*)(dst + 8 * c) = pack8f(v); *(unsigned*)(dst + 64 + 2 * c) = cvtpk(y0, y1); *(unsigned*)(dst + 80 + 2 * c) = cvtpk(y2, y3);
          if (c == 0) WSP(float, WS_QBM)[hrow] = sqrtf(n2) * kbm; }
        {
          float v[8]; unpack8(*(const u32x4*)(KVR + (size_t)t * 1024 + h * 128 + 8 * c), v);
          const unsigned wa = *(const unsigned*)(PB + (size_t)t * NINP + C_KR + 2 * c), wb = *(const unsigned*)(PB + (size_t)t * NINP + C_KR + 16 + 2 * c);
          float r0 = bf2f(wa & 0xffff), r1 = bf2f(wa >> 16), r2 = bf2f(wb & 0xffff), r3 = bf2f(wb >> 16);
          float ss = r0 * r0 + r1 * r1 + r2 * r2 + r3 * r3;
#pragma unroll
          for (int j = 0; j < 8; ++j) ss += v[j] * v[j];
          ss = grp8_sum(ss); const float rinv = 1.0f / sqrtf(ss * (1.0f / 96) + EPS);
#pragma unroll
          for (int j = 0; j < 8; ++j) v[j] = v[j] * rinv * gkn[j];
          r0 *= rinv * gkr[0]; r1 *= rinv * gkr[1]; r2 *= rinv * gkr[2]; r3 *= rinv * gkr[3];
          const float y0 = r0 * cs0 - r2 * sn0, y2 = r2 * cs0 + r0 * sn0, y1 = r1 * cs1 - r3 * sn1, y3 = r3 * cs1 + r1 * sn1;
          bf16* dst = WSP(bf16, WS_KM) + hrow * 96;
          *(u32x4*)(dst + 8 * c) = pack8f(v); *(unsigned*)(dst + 64 + 2 * c) = cvtpk(y0, y1); *(unsigned*)(dst + 80 + 2 * c) = cvtpk(y2, y3); }
        *(u32x4*)(WSP(bf16, WS_VM) + hrow * 64 + 8 * c) = *(const u32x4*)(KVR + (size_t)t * 1024 + h * 128 + 64 + 8 * c);
    }
}

__device__ __forceinline__ void tp_c0(Frame& F) {
    bf16* Y = WSP(bf16, WS_Y); const int l = F.lane;
    for (int t = F.gw; t < NTOK; t += F.ngw) {
        u32x4* p = (u32x4*)(Y + (size_t)t * 1024 + 16 * l); float v0[8], v1[8]; unpack8(p[0], v0); unpack8(p[1], v1); float ss = 0.f;
#pragma unroll
        for (int j = 0; j < 8; ++j) ss += v0[j] * v0[j] + v1[j] * v1[j];
#pragma unroll
        for (int o = 1; o < 32; o <<= 1) ss += __shfl_xor(ss, o);
        const float rinv = 1.0f / sqrtf(ss * (1.0f / 512) + EPS);
#pragma unroll
        for (int j = 0; j < 8; ++j) { v0[j] *= rinv; v1[j] *= rinv; }
        p[0] = pack8f(v0); p[1] = pack8f(v1);
    }
}
__device__ __forceinline__ void tp_c(Frame& F) {
    float* RS = WSP(float, WS_RS); bf16* XB = WSP(bf16, WS_XB);
    for (int m = F.gw; m < NTOK; m += F.ngw) {
        const f32x4* xr = (const f32x4*)(F.out + (size_t)m * D) + F.lane; f32x4 v[4]; float s = 0.f;
#pragma unroll
        for (int j = 0; j < 4; ++j) { v[j] = xr[64 * j]; s += (v[j].x * v[j].x + v[j].y * v[j].y) + (v[j].z * v[j].z + v[j].w * v[j].w); }
        s = wave_sum(s); if (F.lane == 0) RS[m * 4 + 3] = 1.0f / sqrtf(s * (1.0f / D) + EPS);
        u32x2* o8 = (u32x2*)(XB + (size_t)m * D) + F.lane;
#pragma unroll
        for (int j = 0; j < 4; ++j) { u32x2 w; w.x = cvtpk(v[j].x, v[j].y); w.y = cvtpk(v[j].z, v[j].w); o8[64 * j] = w; }
    }
}

__device__ __forceinline__ int crow(int r, int hi) { return (r & 3) + 8 * (r >> 2) + 4 * hi; }
typedef short v4i16_t __attribute__((ext_vector_type(4)));
__device__ __forceinline__ s16x4 vtr(const LAS char* p) { return __builtin_bit_cast(s16x4, __builtin_amdgcn_ds_read_tr16_b64_v4i16((LAS v4i16_t*)p)); }

template <int ROWB> struct TileRegs { u32x4 r[(64 * ROWB / 16 + 511) / 512]; };
__device__ __forceinline__ const char* uni_ptr(const char* p) { const unsigned long long v = (unsigned long long)p; const unsigned lo = __builtin_amdgcn_readfirstlane((unsigned)v), hi = __builtin_amdgcn_readfirstlane((unsigned)(v >> 32)); return (const char*)(((unsigned long long)hi << 32) | lo); }
template <int ROWB> __device__ __forceinline__ void tile_load(TileRegs<ROWB>& T, const char* g_, int tid) {
    constexpr int NCH = 64 * ROWB / 16; const char* g = uni_ptr(g_);
#pragma unroll
    for (int i = 0; i < (NCH + 511) / 512; ++i) { const int c = tid + 512 * i; const unsigned off = (unsigned)c * 16u; if (c < NCH) T.r[i] = *(const u32x4*)(g + off); }
}
template <int ROWB, int STR> __device__ __forceinline__ void tile_store(const TileRegs<ROWB>& T, LAS char* l, int tid) {
    constexpr int NCH = 64 * ROWB / 16, CPR = ROWB / 16;
#pragma unroll
    for (int i = 0; i < (NCH + 511) / 512; ++i) { const int c = tid + 512 * i; if (c < NCH) *(LAS u32x4*)(l + (c / CPR) * STR + (c % CPR) * 16) = T.r[i]; }
}
template <int DK, int KSTR> __device__ __forceinline__ void qk_tile(f32x16& p0, f32x16& p1, const LAS char* Kt, const bf16x8* q, int lane) {
    const LAS char* kb = Kt + (lane & 31) * KSTR + (lane >> 5) * 16;
#pragma unroll
    for (int r = 0; r < 16; ++r) { p0[r] = 0.f; p1[r] = 0.f; }
#pragma unroll
    for (int s = 0; s < DK / 16; ++s) {
        const bf16x8 a0 = *(const LAS bf16x8*)(kb + s * 32), a1 = *(const LAS bf16x8*)(kb + 32 * KSTR + s * 32);
        p0 = __builtin_amdgcn_mfma_f32_32x32x16_bf16(a0, q[s], p0, 0, 0, 0);
        p1 = __builtin_amdgcn_mfma_f32_32x32x16_bf16(a1, q[s], p1, 0, 0, 0);
    }
    __builtin_amdgcn_sched_barrier(0);
}
__device__ __forceinline__ bf16x8 packp(const f32x16& p, int b) {
    u32x4 w; w.x = cvtpk(p[b], p[b + 1]); w.y = cvtpk(p[b + 2], p[b + 3]); w.z = cvtpk(p[b + 4], p[b + 5]); w.w = cvtpk(p[b + 6], p[b + 7]); return __builtin_bit_cast(bf16x8, w);
}
template <int VSTR> __device__ __forceinline__ void pv_tile(f32x16 (&o)[2], const LAS char* Vt, const f32x16& p0, const f32x16& p1, int lane) {
    const int i = lane & 15, g16 = lane >> 4, hi = g16 >> 1, dblk = (g16 & 1) * 16, q_ = i >> 2, p_ = i & 3;
    const LAS char* vb = Vt + (4 * hi + q_) * VSTR + (dblk + 4 * p_) * 2;
    __builtin_amdgcn_sched_barrier(0);
#pragma unroll
    for (int s = 0; s < 4; ++s) {
        const bf16x8 pa = packp(s < 2 ? p0 : p1, (s & 1) * 8);
#pragma unroll
        for (int d0 = 0; d0 < 2; ++d0) {
            const s16x4 lo = vtr(vb + (16 * s) * VSTR + d0 * 64), h8 = vtr(vb + (16 * s + 8) * VSTR + d0 * 64);
            const bf16x8 bv = {lo[0], lo[1], lo[2], lo[3], h8[0], h8[1], h8[2], h8[3]};
            o[d0] = __builtin_amdgcn_mfma_f32_32x32x16_bf16(pa, bv, o[d0], 0, 0, 0);
        }
        __builtin_amdgcn_sched_barrier(0);
    }
}
constexpr int KSTR64 = 144, KSTR96 = 208, VSTR64 = 192;

__device__ __forceinline__ void mla_unit(Frame& F, int bh, int qb) {
    const int lane = F.lane, hi = lane >> 5, w = F.wave;
    const int q0 = qb * 256, qpos = q0 + 32 * w + (lane & 31);
    const bf16* Qm = WSP(bf16, WS_QM) + ((size_t)bh * S + qpos) * 96;
    const char* Kg = (const char*)(WSP(bf16, WS_KM) + (size_t)bh * S * 96); const char* Vg = (const char*)(WSP(bf16, WS_VM) + (size_t)bh * S * 64);
    bf16x8 qf[6];
#pragma unroll
    for (int s = 0; s < 6; ++s) qf[s] = *(const bf16x8*)(Qm + 16 * s + 8 * hi);
    const float bound = WSP(float, WS_QBM)[(size_t)bh * S + qpos];
    LAS char* KT[2] = {(LAS char*)F.lds, (LAS char*)F.lds + 64 * KSTR96}; LAS char* VT[2] = {(LAS char*)F.lds + 2 * 64 * KSTR96, (LAS char*)F.lds + 2 * 64 * KSTR96 + 64 * VSTR64};
    f32x16 o[2]; float lsum = 0.f;
#pragma unroll
    for (int r = 0; r < 16; ++r) { o[0][r] = 0.f; o[1][r] = 0.f; }
    const int NT = (q0 + 256) / 64; const int wq0 = q0 + 32 * w;
    TileRegs<192> kr; TileRegs<128> vr;
    __syncthreads();
    tile_load<192>(kr, Kg, F.tid); tile_load<128>(vr, Vg, F.tid);
    tile_store<192, KSTR96>(kr, KT[0], F.tid); tile_store<128, VSTR64>(vr, VT[0], F.tid);
    __syncthreads();
    for (int t = 0; t < NT; ++t) {
        if (t + 1 < NT) { tile_load<192>(kr, Kg + (size_t)(t + 1) * 64 * 192, F.tid); tile_load<128>(vr, Vg + (size_t)(t + 1) * 64 * 128, F.tid); }
        if (64 * t <= wq0 + 31) {
            f32x16 p0, p1; qk_tile<96, KSTR96>(p0, p1, KT[t & 1], qf, lane);
            const bool diag = (64 * t + 63 > wq0);
#pragma unroll
            for (int r = 0; r < 16; ++r) { const int k0 = 64 * t + crow(r, hi);
                float e0 = __builtin_amdgcn_exp2f(p0[r] - bound), e1 = __builtin_amdgcn_exp2f(p1[r] - bound);
                if (diag) { if (k0 > qpos) e0 = 0.f; if (k0 + 32 > qpos) e1 = 0.f; }
                p0[r] = e0; p1[r] = e1; lsum += e0 + e1; }
            pv_tile<VSTR64>(o, VT[t & 1], p0, p1, lane);
        }
        if (t + 1 < NT) { tile_store<192, KSTR96>(kr, KT[(t + 1) & 1], F.tid); tile_store<128, VSTR64>(vr, VT[(t + 1) & 1], F.tid); }
        __syncthreads();
    }
    lsum += __shfl_xor(lsum, 32); const float linv = lsum > 0.f ? 1.0f / lsum : 0.f;
    bf16* Y = WSP(bf16, WS_Y); const int b = bh >> 3, h = bh & 7;
#pragma unroll
    for (int r = 0; r < 16; ++r) { const int row = crow(r, hi); const float f = __shfl(linv, row); bf16* yp = Y + ((size_t)b * S + wq0 + row) * 1024 + h * 64 + (lane & 31);
        yp[0] = (bf16)(cvtpk(o[0][r] * f, 0.f) & 0xffff); yp[32] = (bf16)(cvtpk(o[1][r] * f, 0.f) & 0xffff); }
}

__device__ __forceinline__ void nsa_unit(Frame& F, int bg, int cur) {
    const int lane = F.lane, hi = lane >> 5, w = F.wave, hp = w & 3, qs = w >> 2;
    const int b = bg >> 1, g = bg & 1, h = g * 4 + hp;
    const int q0 = 64 * cur, qi = 32 * qs + (lane & 31), qpos = q0 + qi;
    const float* CF = WSP(float, WS_CONST);
    LAS char* KT[2] = {(LAS char*)F.lds, (LAS char*)F.lds + 64 * KSTR64}; LAS char* VT[2] = {(LAS char*)F.lds + 2 * 64 * KSTR64, (LAS char*)F.lds + 2 * 64 * KSTR64 + 64 * VSTR64};
    LAS float* BW = (LAS float*)(F.lds + 49152);
    LAS unsigned* MSK = (LAS unsigned*)(F.lds + 49152 + 8192);
    LAS float* IMP = (LAS float*)(F.lds + 49152 + 8192 + 1024);
    LAS float* PARK = IMP + w * 2048 + lane;
    __syncthreads();
    for (int i = F.tid; i < 64 * 128; i += 512) IMP[i] = 0.f;
    for (int i = F.tid; i < 2048; i += 512) { const int hh = i >> 9, dd = i & 511; BW[i] = CF[CF_BIAS2 + (int)CF[CF_LUT + dd] * 8 + g * 4 + hh]; }
    const float bias31 = CF[CF_BIAS2 + 31 * 8 + h];
    const size_t qrow = ((size_t)bg * S + qpos) * 4 + hp;
    const bf16* Qp = WSP(bf16, WS_QN) + qrow * 64;
    bf16x8 qf[4];
#pragma unroll
    for (int s = 0; s < 4; ++s) qf[s] = *(const bf16x8*)(Qp + 16 * s + 8 * hi);
    const float bound = WSP(float, WS_QBN)[qrow];
    const float* gt = WSP(float, WS_GATE) + (size_t)(b * S + qpos) * 24 + h * 3;
    const LAS float* bw = BW + hp * 512;
    TileRegs<128> kr, vr;
    f32x16 ocmp[2];
    const int ncmp = 4 * cur + 3 < 511 ? 4 * cur + 3 : 511, nct = (ncmp + 63) / 64;
    const char* Kc = (const char*)(WSP(bf16, WS_KCMP) + (size_t)bg * 512 * 64); const char* Vc = (const char*)(WSP(bf16, WS_VCMP) + (size_t)bg * 512 * 64);
    float lc = 0.f;
    __syncthreads();
    for (int t = 0; t < nct; ++t) {
        tile_load<128>(kr, Kc + (size_t)t * 8192, F.tid); tile_store<128, KSTR64>(kr, KT[0], F.tid); __syncthreads();
        f32x16 p0, p1; qk_tile<64, KSTR64>(p0, p1, KT[0], qf, lane);
#pragma unroll
        for (int r = 0; r < 16; ++r) {
#pragma unroll
            for (int hf = 0; hf < 2; ++hf) { const int n = 64 * t + 32 * hf + crow(r, hi); const int dist = qpos - (16 * n + 31);
                const float bs = dist < 512 ? bw[dist < 0 ? 0 : dist] : bias31; const float sv = (hf ? p1[r] : p0[r]) + bs - bound;
                lc += dist >= 0 ? __builtin_amdgcn_exp2f(sv) : 0.f; } if ((r & 3) == 3) __builtin_amdgcn_sched_barrier(0); }
        __syncthreads();
    }
    lc += __shfl_xor(lc, 32); const float lcinv = lc > 0.f ? 1.0f / lc : 0.f;
    {
        f32x16 o[2];
#pragma unroll
        for (int r = 0; r < 16; ++r) { o[0][r] = 0.f; o[1][r] = 0.f; }
        float carry = 0.f;
        for (int t = 0; t < nct; ++t) {
            tile_load<128>(kr, Kc + (size_t)t * 8192, F.tid); tile_load<128>(vr, Vc + (size_t)t * 8192, F.tid);
            tile_store<128, KSTR64>(kr, KT[0], F.tid); tile_store<128, VSTR64>(vr, VT[0], F.tid); __syncthreads();
            f32x16 p0, p1; qk_tile<64, KSTR64>(p0, p1, KT[0], qf, lane);
#pragma unroll
            for (int r = 0; r < 16; ++r) {
#pragma unroll
                for (int hf = 0; hf < 2; ++hf) { const int n = 64 * t + 32 * hf + crow(r, hi); const int dist = qpos - (16 * n + 31);
                    const float bs = dist < 512 ? bw[dist < 0 ? 0 : dist] : bias31; const float sv = (hf ? p1[r] : p0[r]) + bs - bound;
                    const float e = dist >= 0 ? __builtin_amdgcn_exp2f(sv) * lcinv : 0.f; if (hf) p1[r] = e; else p0[r] = e; } if ((r & 3) == 3) __builtin_amdgcn_sched_barrier(0); }
            float val[8]; float yprev = carry;
#pragma unroll
            for (int hf = 0; hf < 2; ++hf)
#pragma unroll
                for (int gi = 0; gi < 4; ++gi) { const f32x16& P = hf ? p1 : p0; const float x = P[4 * gi + 3]; const float y = __shfl_xor(x, 32);
                    const float prev = hi ? y : yprev; val[hf * 4 + gi] = (P[4 * gi] + P[4 * gi + 1]) + (P[4 * gi + 2] + x) + prev; yprev = y; }
            carry = yprev;
            for (int turn = 0; turn < 4; ++turn) {
                if (hp == turn) {
#pragma unroll
                    for (int hf = 0; hf < 2; ++hf)
#pragma unroll
                        for (int gi = 0; gi < 4; ++gi) { const int jj = 16 * t + 8 * hf + 2 * gi + hi; IMP[qi * 128 + jj] += val[hf * 4 + gi]; }
                }
                __syncthreads();
            }
            pv_tile<VSTR64>(o, VT[0], p0, p1, lane);
            __syncthreads();
        }
        const float g0 = gt[0];
#pragma unroll
        for (int r = 0; r < 16; ++r) { const float f = __shfl(g0, crow(r, hi)); ocmp[0][r] = o[0][r] * f; ocmp[1][r] = o[1][r] * f; }
    }
    {
        for (int i8 = 0; i8 < 8; ++i8) { const int q = w * 8 + i8; unsigned long long mlo, mhi;
            if (cur < 16) { mlo = (1ull << (cur + 1)) - 1ull; mhi = 0ull; }
            else {
                const float a = IMP[q * 128 + lane], bb = IMP[q * 128 + 64 + lane]; int ra = 0, rb = 0;
                for (int i = 1; i <= cur - 2; ++i) { const float v = IMP[q * 128 + i];
                    ra += (v > a || (v == a && i < lane)) ? 1 : 0; rb += (v > bb || (v == bb && i < lane + 64)) ? 1 : 0; }
                const int ja = lane, jb = lane + 64;
                const bool sa = (ja >= 1 && ja <= cur - 2 && ra < 13) || ja == 0 || ja == cur || ja == cur - 1;
                const bool sb = (jb >= 1 && jb <= cur - 2 && rb < 13) || jb == cur || jb == cur - 1;
                mlo = __ballot(sa); mhi = __ballot(sb);
            }
            if (lane == 0) { MSK[q * 4 + 0] = (unsigned)mlo; MSK[q * 4 + 1] = (unsigned)(mlo >> 32); MSK[q * 4 + 2] = (unsigned)mhi; MSK[q * 4 + 3] = (unsigned)(mhi >> 32); }
        }
        __syncthreads();
    }
#pragma unroll
    for (int r = 0; r < 16; ++r) { PARK[r * 64] = ocmp[0][r]; PARK[(16 + r) * 64] = ocmp[1][r]; }
    {
        const char* Kg = (const char*)(WSP(bf16, WS_KS) + (size_t)bg * S * 64); const char* Vg = (const char*)(WSP(bf16, WS_VS) + (size_t)bg * S * 64);
        f32x16 o[2]; float ls = 0.f;
#pragma unroll
        for (int r = 0; r < 16; ++r) { o[0][r] = 0.f; o[1][r] = 0.f; }
        const int NT = cur + 1; const float cfar = bias31 - bound;
        tile_load<128>(kr, Kg, F.tid); tile_load<128>(vr, Vg, F.tid);
        tile_store<128, KSTR64>(kr, KT[0], F.tid); tile_store<128, VSTR64>(vr, VT[0], F.tid);
        __syncthreads();
        for (int j = 0; j < NT; ++j) {
            if (j + 1 < NT) { tile_load<128>(kr, Kg + (size_t)(j + 1) * 8192, F.tid); tile_load<128>(vr, Vg + (size_t)(j + 1) * 8192, F.tid); }
            const unsigned mw = MSK[qi * 4 + (j >> 5)]; const bool sel = (mw >> (j & 31)) & 1u;
            if (__ballot(sel) != 0ull) {
                f32x16 p0, p1; qk_tile<64, KSTR64>(p0, p1, KT[j & 1], qf, lane);
                if (cur - j >= 9) {
#pragma unroll
                    for (int r = 0; r < 16; ++r) { const float e0 = sel ? __builtin_amdgcn_exp2f(p0[r] + cfar) : 0.f, e1 = sel ? __builtin_amdgcn_exp2f(p1[r] + cfar) : 0.f; p0[r] = e0; p1[r] = e1; ls += e0 + e1; }
                } else {
#pragma unroll
                    for (int r = 0; r < 16; ++r) {
#pragma unroll
                        for (int hf = 0; hf < 2; ++hf) { const int dist = qpos - (64 * j + 32 * hf + crow(r, hi));
                            const float bs = dist < 512 ? bw[dist < 0 ? 0 : dist] : bias31; const float sv = (hf ? p1[r] : p0[r]) + bs - bound;
                            const float e = (sel && dist >= 0) ? __builtin_amdgcn_exp2f(sv) : 0.f; if (hf) p1[r] = e; else p0[r] = e; ls += e; } if ((r & 3) == 3) __builtin_amdgcn_sched_barrier(0); }
                }
                pv_tile<VSTR64>(o, VT[j & 1], p0, p1, lane);
            }
            if (j + 1 < NT) { tile_store<128, KSTR64>(kr, KT[(j + 1) & 1], F.tid); tile_store<128, VSTR64>(vr, VT[(j + 1) & 1], F.tid); }
            __syncthreads();
        }
        ls += __shfl_xor(ls, 32); const float fs = ls > 0.f ? gt[1] / ls : 0.f;
#pragma unroll
        for (int r = 0; r < 16; ++r) { const float f = __shfl(fs, crow(r, hi)); PARK[r * 64] += o[0][r] * f; PARK[(16 + r) * 64] += o[1][r] * f; }
    }
    {
        const char* Kg = (const char*)(WSP(bf16, WS_KW) + (size_t)bg * S * 64); const char* Vg = (const char*)(WSP(bf16, WS_VW) + (size_t)bg * S * 64);
        f32x16 o[2]; float ls = 0.f;
#pragma unroll
        for (int r = 0; r < 16; ++r) { o[0][r] = 0.f; o[1][r] = 0.f; }
        const int j0 = cur >= 8 ? cur - 8 : 0;
        tile_load<128>(kr, Kg + (size_t)j0 * 8192, F.tid); tile_load<128>(vr, Vg + (size_t)j0 * 8192, F.tid);
        tile_store<128, KSTR64>(kr, KT[0], F.tid); tile_store<128, VSTR64>(vr, VT[0], F.tid);
        __syncthreads();
        for (int j = j0; j <= cur; ++j) { const int bi = (j - j0) & 1;
            if (j < cur) { tile_load<128>(kr, Kg + (size_t)(j + 1) * 8192, F.tid); tile_load<128>(vr, Vg + (size_t)(j + 1) * 8192, F.tid); }
            f32x16 p0, p1; qk_tile<64, KSTR64>(p0, p1, KT[bi], qf, lane);
#pragma unroll
            for (int r = 0; r < 16; ++r) {
#pragma unroll
                for (int hf = 0; hf < 2; ++hf) { const int dist = qpos - (64 * j + 32 * hf + crow(r, hi)); const bool ok = dist >= 0 && dist < 512;
                    const float sv = (hf ? p1[r] : p0[r]) + bw[ok ? dist : 0] - bound;
                    const float e = ok ? __builtin_amdgcn_exp2f(sv) : 0.f; if (hf) p1[r] = e; else p0[r] = e; ls += e; } if ((r & 3) == 3) __builtin_amdgcn_sched_barrier(0); }
            pv_tile<VSTR64>(o, VT[bi], p0, p1, lane);
            if (j < cur) { tile_store<128, KSTR64>(kr, KT[bi ^ 1], F.tid); tile_store<128, VSTR64>(vr, VT[bi ^ 1], F.tid); }
            __syncthreads();
        }
        ls += __shfl_xor(ls, 32); const float fs = ls > 0.f ? gt[2] / ls : 0.f;
#pragma unroll
        for (int r = 0; r < 16; ++r) { const float f = __shfl(fs, crow(r, hi)); PARK[r * 64] += o[0][r] * f; PARK[(16 + r) * 64] += o[1][r] * f; }
    }
    bf16* Y = WSP(bf16, WS_Y);
#pragma unroll
    for (int r = 0; r < 16; ++r) { const int row = crow(r, hi); bf16* yp = Y + ((size_t)b * S + q0 + 32 * qs + row) * 1024 + 512 + h * 64 + (lane & 31);
        yp[0] = (bf16)(cvtpk(PARK[r * 64], 0.f) & 0xffff); yp[32] = (bf16)(cvtpk(PARK[(16 + r) * 64], 0.f) & 0xffff); }
}

__device__ __forceinline__ void mem_unit(Frame& F, int bh, int qb) {
    const int lane = F.lane, hi = lane >> 5, w = F.wave; const int b = bh >> 2, hm = bh & 3;
    const int tok = b * S + qb * 256 + 32 * w + (lane & 31);
    const float* CF = WSP(float, WS_CONST);
    const bf16* qp = WSP(bf16, WS_QMEM) + (size_t)tok * 256 + hm * 64; float qv[4][8]; float ss = 0.f;
#pragma unroll
    for (int s = 0; s < 4; ++s) { unpack8(*(const u32x4*)(qp + 16 * s + 8 * hi), qv[s]);
#pragma unroll
        for (int j = 0; j < 8; ++j) ss += qv[s][j] * qv[s][j]; }
    ss += __shfl_xor(ss, 32); const float rinv = 1.0f / sqrtf(ss * (1.0f / 64) + EPS) * (0.125f * LOG2E); float n2 = 0.f;
    bf16x8 qf[4];
#pragma unroll
    for (int s = 0; s < 4; ++s) {
#pragma unroll
        for (int j = 0; j < 8; ++j) { qv[s][j] *= rinv * F.in[26][16 * s + 8 * hi + j]; n2 += qv[s][j] * qv[s][j]; }
        qf[s] = __builtin_bit_cast(bf16x8, pack8f(qv[s])); }
    n2 += __shfl_xor(n2, 32); const float bound = sqrtf(n2) * CF[CF_KBMEM];
    LAS char* KT = (LAS char*)F.lds; LAS char* VT = (LAS char*)F.lds + 64 * KSTR64;
    const char* Kg = (const char*)(WSP(bf16, WS_KMEM) + (size_t)bh * 256 * 64); const char* Vg = (const char*)(WSP(bf16, WS_VMEM) + (size_t)bh * 256 * 64);
    f32x16 o[2]; float ls = 0.f;
#pragma unroll
    for (int r = 0; r < 16; ++r) { o[0][r] = 0.f; o[1][r] = 0.f; }
    TileRegs<128> kr, vr;
    for (int t = 0; t < 4; ++t) {
        __syncthreads();
        tile_load<128>(kr, Kg + (size_t)t * 8192, F.tid); tile_load<128>(vr, Vg + (size_t)t * 8192, F.tid);
        tile_store<128, KSTR64>(kr, KT, F.tid); tile_store<128, VSTR64>(vr, VT, F.tid);
        __syncthreads();
        f32x16 p0, p1; qk_tile<64, KSTR64>(p0, p1, KT, qf, lane);
#pragma unroll
        for (int r = 0; r < 16; ++r) { const float e0 = __builtin_amdgcn_exp2f(p0[r] - bound), e1 = __builtin_amdgcn_exp2f(p1[r] - bound); p0[r] = e0; p1[r] = e1; ls += e0 + e1; }
        pv_tile<VSTR64>(o, VT, p0, p1, lane);
    }
    ls += __shfl_xor(ls, 32); const float linv = 1.0f / ls;
    bf16* O = WSP(bf16, WS_OMEM);
#pragma unroll
    for (int r = 0; r < 16; ++r) { const int row = crow(r, hi); const float f = __shfl(linv, row); bf16* yp = O + ((size_t)b * S + qb * 256 + 32 * w + row) * 256 + hm * 64 + (lane & 31);
        yp[0] = (bf16)(cvtpk(o[0][r] * f, 0.f) & 0xffff); yp[32] = (bf16)(cvtpk(o[1][r] * f, 0.f) & 0xffff); }
}

__device__ __forceinline__ void tp_d(Frame& F) {
    LAS float* WT = (LAS float*)F.lds;
    LAS unsigned* lcnt = (LAS unsigned*)(F.lds + LDSX_OFF);
    LAS unsigned* lbase = lcnt + 32;
    const float* rw = F.in[30]; const float* gm = F.in[29]; const float* rb = F.in[31];
    __syncthreads();
    for (int i = F.tid; i < 32768; i += 512) { const int k = i >> 5, e = i & 31; WT[e * 1024 + k] = rw[i] * gm[k]; }
    __syncthreads();
    float* RS = WSP(float, WS_RS); bf16* XB = WSP(bf16, WS_XB); unsigned* cnt = (unsigned*)(F.ws + WS_CTL) + CW_CNT;
    int* ASG = WSP(int, WS_ASG);
    const int l = F.lane;
    for (int m0 = F.bid * 8; m0 < NTOK; m0 += F.G * 8) {
        const int m = m0 + F.wave;
        if (F.tid < 32) lcnt[F.tid] = 0u;
        const f32x4* xr = (const f32x4*)(F.out + (size_t)m * D) + l; f32x4 v[4]; float s = 0.f;
#pragma unroll
        for (int j = 0; j < 4; ++j) { v[j] = xr[64 * j]; s += (v[j].x * v[j].x + v[j].y * v[j].y) + (v[j].z * v[j].z + v[j].w * v[j].w); }
        s = wave_sum(s); const float rinv = 1.0f / sqrtf(s * (1.0f / D) + EPS);
        if (l == 0) RS[m * 4 + 3] = rinv;
        u32x2* o8 = (u32x2*)(XB + (size_t)m * D) + l;
#pragma unroll
        for (int j = 0; j < 4; ++j) { u32x2 w; w.x = cvtpk(v[j].x * rinv, v[j].y * rinv); w.y = cvtpk(v[j].z * rinv, v[j].w * rinv); o8[64 * j] = w; }
        float mylog = 0.f;
        for (int e = 0; e < 32; ++e) { float a = 0.f;
#pragma unroll
            for (int j = 0; j < 4; ++j) { const f32x4 wv = *(const LAS f32x4*)(WT + e * 1024 + 256 * j + 4 * l); a += (v[j].x * wv.x + v[j].y * wv.y) + (v[j].z * wv.z + v[j].w * wv.w); }
            a = wave_sum(a); if ((l & 31) == e) mylog = a * rinv + rb[e]; }
        int idx[4]; float val[4]; float cur = mylog;
#pragma unroll
        for (int k = 0; k < 4; ++k) { float bv = cur; int bi = l & 31;
#pragma unroll
            for (int o = 1; o < 32; o <<= 1) { const float ov = __shfl_xor(bv, o); const int oi = __shfl_xor(bi, o); if (ov > bv || (ov == bv && oi < bi)) { bv = ov; bi = oi; } }
            idx[k] = bi; val[k] = bv; if ((l & 31) == bi) cur = -3.0e38f; }
        float ge[4]; { const float e1 = __expf(val[1] - val[0]), e2 = __expf(val[2] - val[0]), e3 = __expf(val[3] - val[0]); const float inv = 1.0f / (1.0f + e1 + e2 + e3); ge[0] = inv; ge[1] = e1 * inv; ge[2] = e2 * inv; ge[3] = e3 * inv; }
        __syncthreads();
        unsigned lp = 0;
        { const int myi = l == 0 ? idx[0] : l == 1 ? idx[1] : l == 2 ? idx[2] : idx[3]; if (l < 4) lp = atomicAdd((unsigned*)&lcnt[myi], 1u); }
        __syncthreads();
        if (F.tid < 32) { const unsigned c = lcnt[F.tid]; lbase[F.tid] = c ? atomicAdd(&cnt[F.tid], c) : 0u; }
        __syncthreads();
        { const int myi = l == 0 ? idx[0] : l == 1 ? idx[1] : l == 2 ? idx[2] : idx[3]; const float myg = l == 0 ? ge[0] : l == 1 ? ge[1] : l == 2 ? ge[2] : ge[3];
          if (l < 4) { ASG[(m * 4 + l) * 2 + 0] = myi | ((int)(lbase[myi] + lp) << 8); ASG[(m * 4 + l) * 2 + 1] = __float_as_int(myg); } }
        __syncthreads();
    }
}
__device__ __forceinline__ void moe_tables(Frame& F, LAS int* mt, LAS int* ro) {
    __syncthreads();
    if (F.tid == 0) { unsigned* cnt = (unsigned*)(F.ws + WS_CTL) + CW_CNT; int acc = 0;
        for (int e = 0; e < 32; ++e) { const int c = (int)__hip_atomic_load(cnt + e, __ATOMIC_RELAXED, __HIP_MEMORY_SCOPE_AGENT); const int t = (c + 255) >> 8; mt[e] = t; ro[e] = acc; acc += t * 256; } }
    __syncthreads();
}
__device__ __forceinline__ void moe_gather(Frame& F) {
    LAS int* mt = (LAS int*)(F.lds + LDSX_OFF + 1024); LAS int* ro = mt + 32;
    moe_tables(F, mt, ro);
    const int* ASG = WSP(int, WS_ASG); const bf16* XB = WSP(bf16, WS_XB); bf16* A1 = WSP(bf16, WS_A1);
    for (int m = F.gw; m < NTOK; m += F.ngw) {
        const u32x4* src = (const u32x4*)(XB + (size_t)m * D) + F.lane; const u32x4 a = src[0], b = src[64];
#pragma unroll
        for (int k = 0; k < 4; ++k) { const int pe = ASG[(m * 4 + k) * 2]; const int e = pe & 255, pos = pe >> 8; const size_t row = (size_t)ro[e] + pos;
            u32x4* dst = (u32x4*)(A1 + row * D) + F.lane; dst[0] = a; dst[64] = b; }
    }
}
__device__ __forceinline__ void moe_combine(Frame& F) {
    LAS int* mt = (LAS int*)(F.lds + LDSX_OFF + 1024); LAS int* ro = mt + 32;
    moe_tables(F, mt, ro);
    const int* ASG = WSP(int, WS_ASG); const bf16* Yb = WSP(bf16, WS_A1);
    for (int m = F.gw; m < NTOK; m += F.ngw) {
        f32x4* op = (f32x4*)(F.out + (size_t)m * D) + 4 * F.lane; f32x4 o[4];
#pragma unroll
        for (int j = 0; j < 4; ++j) o[j] = op[j];
#pragma unroll
        for (int k = 0; k < 4; ++k) { const int pe = ASG[(m * 4 + k) * 2]; const float gw = __int_as_float(ASG[(m * 4 + k) * 2 + 1]); const int e = pe & 255, pos = pe >> 8; const size_t row = (size_t)ro[e] + pos;
            const u32x4* yp = (const u32x4*)(Yb + row * D + 16 * F.lane); float y0[8], y1[8]; unpack8(yp[0], y0); unpack8(yp[1], y1);
            o[0] += gw * (f32x4){y0[0], y0[1], y0[2], y0[3]}; o[1] += gw * (f32x4){y0[4], y0[5], y0[6], y0[7]};
            o[2] += gw * (f32x4){y1[0], y1[1], y1[2], y1[3]}; o[3] += gw * (f32x4){y1[4], y1[5], y1[6], y1[7]}; }
#pragma unroll
        for (int j = 0; j < 4; ++j) op[j] = o[j];
    }
}

#ifndef LB
#define LB 512
#endif
__global__ void __launch_bounds__(LB) fwd_kernel(Args args) {
    extern __shared__ __attribute__((aligned(16))) unsigned char lds_raw[];
    Frame F;
    F.lds = (LAS unsigned char*)lds_raw; F.tid = threadIdx.x; F.lane = F.tid & 63; F.wave = __builtin_amdgcn_readfirstlane(F.tid >> 6);
    F.G = gridDim.x; F.bid = blockIdx.x; F.gw = F.bid * 8 + F.wave; F.ngw = F.G * 8;
    F.in = args.in; F.out = args.out; F.ws = args.ws;
    for (int u = F.tid; u < 128; u += 512) ((LAS unsigned*)(F.lds + LDSCTL_OFF))[u] = 0u;
    __syncthreads();
    unsigned* ctl = (unsigned*)(F.ws + WS_CTL);
    XcdBarrier bar = xcd_barrier_post(ctl + CW_BAR, (volatile LAS unsigned*)(F.lds + LDSCTL_OFF) + 8);
#ifndef PHM
#define PHM 0xFFFFFFFFu
#endif
#define RELAUNDER() do { int t_ = threadIdx.x; asm volatile("" : "+v"(t_)); F.tid = t_; F.lane = t_ & 63; } while (0)
#define PH(n) RELAUNDER(); if (PHM & (1u << (n)))
#define GRID_BAR() xcd_barrier(bar)
    float* RS = WSP(float, WS_RS);
    PH(0) p0_prologue(F); GRID_BAR();
    PH(1) { pg8::Gemm g{WSP(bf16, WS_XB), WSP(bf16, WS_WIN), 1024, 1024, 1024}; pg8::StaticOrder So; So.init(NTOK, NINP, F.G, F.bid);
      pg8::EpiScaleBf16 E{WSP(bf16, WS_PB), NINP, RS + 0, 4}; pg8::gemm_phase(F.lds, g, So, E); }
    GRID_BAR();
    PH(2) tp_a(F); PH(17) compress_phase(F); GRID_BAR();
    PH(3) { pg8::Gemm g{WSP(bf16, WS_PB) + C_CQ, WSP(bf16, WS_WUQ), NINP, 256, 256}; pg8::StaticOrder So; So.init(NTOK, 768, F.G, F.bid);
      pg8::EpiScaleBf16 E{WSP(bf16, WS_QRAW), 768, RS + 1, 4}; pg8::gemm_phase(F.lds, g, So, E); }
    PH(3) { pg8::Gemm g{WSP(bf16, WS_PB) + C_CKV, WSP(bf16, WS_WUKV), NINP, 256, 256}; pg8::StaticOrder So; So.init(NTOK, 1024, F.G, F.bid);
      pg8::EpiScaleBf16 E{WSP(bf16, WS_KVRAW), 1024, RS + 2, 4}; pg8::gemm_phase(F.lds, g, So, E); }
    GRID_BAR();
    PH(4) tp_b(F); GRID_BAR();
    { const int vcu = (F.G % 8 == 0) ? (F.bid % 8) * (F.G / 8) + F.bid / 8 : F.bid;
      PH(5) for (int v = vcu; v < 256; v += F.G) { const int bh = v >> 4, sidx = v & 15; mla_unit(F, bh, 31 - sidx); mla_unit(F, bh, sidx); }
      PH(18) for (int v = vcu; v < 256; v += F.G) { const int bg = v >> 6, sidx = v & 63; nsa_unit(F, bg, 127 - sidx); nsa_unit(F, bg, sidx); } }
    GRID_BAR();
    PH(6) tp_c0(F); GRID_BAR();
    PH(7) { pg8::Gemm g{WSP(bf16, WS_Y), WSP(bf16, WS_WOUT), 1024, 1024, 1024}; pg8::StaticOrder So; So.init(NTOK, 1024, F.G, F.bid);
      pg8::EpiResF32 E{F.in[0], F.out, 1024}; pg8::gemm_phase(F.lds, g, So, E); }
    GRID_BAR();
    PH(8) tp_c(F); GRID_BAR();
    PH(9) { pg8::Gemm g{WSP(bf16, WS_XB), WSP(bf16, WS_WMQ), 1024, 1024, 1024}; pg8::StaticOrder So; So.init(NTOK, 256, F.G, F.bid);
      pg8::EpiScaleBf16 E{WSP(bf16, WS_QMEM), 256, RS + 3, 4}; pg8::gemm_phase(F.lds, g, So, E); }
    GRID_BAR();
    PH(10) for (int v = F.bid; v < 256; v += F.G) mem_unit(F, v >> 5, v & 31);
    GRID_BAR();
    PH(11) { pg8::Gemm g{WSP(bf16, WS_OMEM), WSP(bf16, WS_WMO), 256, 256, 256}; pg8::StaticOrder So; So.init(NTOK, 1024, F.G, F.bid);
      pg8::EpiResF32 E{F.out, F.out, 1024}; pg8::gemm_phase(F.lds, g, So, E); }
    GRID_BAR();
    PH(12) tp_d(F); GRID_BAR();
    PH(13) moe_gather(F); GRID_BAR();
    { LAS int* mt = (LAS int*)(F.lds + LDSX_OFF + 1024); LAS int* ro = mt + 32;
      pg8::MoeOrder Mo; Mo.xl = F.bid & 7; Mo.cl = F.bid >> 3; Mo.nl = F.G >> 3;
#pragma unroll
      for (int s = 0; s < 4; ++s) { Mo.mt[s] = mt[Mo.xl + 8 * s]; Mo.tp[s] = ro[Mo.xl + 8 * s] >> 8; }
      PH(14) { Mo.ntn = 8; pg8::Gemm g{WSP(bf16, WS_A1), WSP(bf16, WS_WGU), 1024, 1024, 1024}; pg8::EpiSwiglu E{WSP(bf16, WS_ACT), F.in[33]}; pg8::gemm_phase(F.lds, g, Mo, E); }
      GRID_BAR();
      PH(15) { Mo.ntn = 4; pg8::Gemm g{WSP(bf16, WS_ACT), WSP(bf16, WS_WD), 1024, 1024, 1024}; pg8::EpiDown E{WSP(bf16, WS_A1), F.in[35]}; pg8::gemm_phase(F.lds, g, Mo, E); }
      GRID_BAR(); }
    PH(16) moe_combine(F);
}

extern "C" void kernel_launch(void* const* d_in, const int* in_sizes, int n_in, void* d_out, int out_size, void* d_ws, size_t ws_size, hipStream_t stream) {
    static int grid = 0;
    if (grid == 0) {
        if (n_in != 36 || out_size != NTOK * D || ws_size < WS_END) { fprintf(stderr, "kernel_launch: unexpected shapes (n_in %d out %d ws %zu need %zu)\n", n_in, out_size, ws_size, (size_t)WS_END); grid = -1; return; }
        int dev = 0, cus = 0;
        if (hipGetDevice(&dev) != hipSuccess || hipDeviceGetAttribute(&cus, hipDeviceAttributeMultiprocessorCount, dev) != hipSuccess) { grid = -1; return; }
        if (hipFuncSetAttribute((const void*)fwd_kernel, hipFuncAttributeMaxDynamicSharedMemorySize, LDS_BYTES) != hipSuccess) { fprintf(stderr, "kernel_launch: hipFuncSetAttribute failed\n"); grid = -1; return; }
        (void)hipGetLastError();
        grid = cus >= 256 ? 256 : (cus / 8) * 8;
    }
    if (grid <= 0) return;
    (void)hipMemsetAsync((char*)d_ws + WS_CTL, 0, CTL_BYTES, stream);
    Args a{};
    for (int i = 0; i < 36; ++i) a.in[i] = (const float*)d_in[i];
    a.out = (float*)d_out; a.ws = (unsigned char*)d_ws;
    hipLaunchKernelGGL(fwd_kernel, dim3(grid), dim3(512), LDS_BYTES, stream, a);
}
```

```cpp
#include <hip/hip_runtime.h>
#include <cstdint>
#include <cstdio>

#define GAS __attribute__((address_space(1)))
#define LAS __attribute__((address_space(3)))
typedef unsigned short bf16;
typedef short bf16x8 __attribute__((ext_vector_type(8)));
typedef short s16x4 __attribute__((ext_vector_type(4)));
typedef float f32x4 __attribute__((ext_vector_type(4)));
typedef float f32x16 __attribute__((ext_vector_type(16)));
typedef unsigned u32x4 __attribute__((ext_vector_type(4)));
typedef unsigned u32x2 __attribute__((ext_vector_type(2)));
typedef float f32x2_t __attribute__((ext_vector_type(2)));
typedef __bf16 bf16x2_t __attribute__((ext_vector_type(2)));

constexpr int NB = 2, S = 8192, D = 1024, NTOK = NB * S;
constexpr int NINP = 1792;
constexpr int C_CQ = 0, C_CKV = 256, C_KR = 384, C_QN = 416, C_KC = 928, C_VC = 1056, C_KS = 1184, C_VS = 1312, C_KW = 1440, C_VW = 1568, C_GT = 1696;
constexpr float EPS = 1e-6f;
constexpr float LOG2E = 1.4426950408889634f;
constexpr int NEXP = 32, MROWS = 65536 + 32 * 256;

constexpr size_t MiB = 1u << 20;
constexpr size_t al256(size_t x) { return (x + 255) & ~(size_t)255; }
constexpr size_t WS_CTL = 0, CTL_BYTES = 1 * MiB;
constexpr size_t WS_CONST = 1 * MiB;
constexpr size_t WS_WIN = 2 * MiB;
constexpr size_t WS_WUQ = WS_WIN + al256((size_t)NINP * 1024 * 2);
constexpr size_t WS_WUKV = WS_WUQ + al256((size_t)768 * 256 * 2);
constexpr size_t WS_WOUT = WS_WUKV + al256((size_t)1024 * 256 * 2);
constexpr size_t WS_WMQ = WS_WOUT + al256((size_t)1024 * 1024 * 2);
constexpr size_t WS_WMO = WS_WMQ + al256((size_t)256 * 1024 * 2);
constexpr size_t WS_W1T = WS_WMO + al256((size_t)1024 * 256 * 2);
constexpr size_t WS_WMKVT = WS_W1T + al256((size_t)2 * 128 * 2048 * 2);
constexpr size_t WS_MEMB = WS_WMKVT + al256((size_t)512 * 1024 * 2);
constexpr size_t WS_KVMR = WS_MEMB + al256((size_t)512 * 1024 * 2);
constexpr size_t WS_RSM = WS_KVMR + al256((size_t)512 * 512 * 2);
static_assert(WS_RSM + 4096 <= 16 * MiB, "small-weight region");
constexpr size_t WS_WGU = 16 * MiB;
constexpr size_t WS_WD = WS_WGU + 128 * MiB;
constexpr size_t WS_XB = WS_WD + 64 * MiB;
constexpr size_t WS_PB = WS_XB + 32 * MiB;
constexpr size_t WS_QRAW = WS_PB + 56 * MiB;
constexpr size_t WS_KVRAW = WS_QRAW + 24 * MiB;
constexpr size_t WS_QM = WS_KVRAW + 32 * MiB;
constexpr size_t WS_KM = WS_QM + 24 * MiB;
constexpr size_t WS_VM = WS_KM + 24 * MiB;
constexpr size_t WS_QN = WS_VM + 16 * MiB;
constexpr size_t WS_KS = WS_QN + 16 * MiB;
constexpr size_t WS_VS = WS_KS + 4 * MiB;
constexpr size_t WS_KW = WS_VS + 4 * MiB;
constexpr size_t WS_VW = WS_KW + 4 * MiB;
constexpr size_t WS_KCMP = WS_VW + 4 * MiB;
constexpr size_t WS_VCMP = WS_KCMP + 1 * MiB;
constexpr size_t WS_KMEM = WS_VCMP + 1 * MiB;
constexpr size_t WS_VMEM = WS_KMEM + 1 * MiB;
constexpr size_t WS_QBM = WS_VMEM + 1 * MiB;
constexpr size_t WS_QBN = WS_QBM + 1 * MiB;
constexpr size_t WS_RS = WS_QBN + 1 * MiB;
constexpr size_t WS_GATE = WS_RS + 1 * MiB;
constexpr size_t WS_ASG = WS_GATE + 2 * MiB;
constexpr size_t WS_Y = WS_ASG + 1 * MiB;
constexpr size_t WS_QMEM = WS_Y + 32 * MiB;
constexpr size_t WS_OMEM = WS_QMEM + 8 * MiB;
constexpr size_t WS_A1 = WS_OMEM + 8 * MiB;
constexpr size_t WS_ACT = WS_A1 + 144 * MiB;
constexpr size_t WS_END = WS_ACT + 144 * MiB;
constexpr int CW_BAR = 4096;
constexpr int CW_CNT = 16384;
constexpr int CF_CPP = 4096;
constexpr int CF_KBM = 0, CF_KBN = 1, CF_KBMEM = 2, CF_MAXB2 = 8  , CF_BIAS2 = 64  , CF_LUT = 512  , CF_CPOSK = 1024  , CF_CPOSV = 1152  ;

constexpr int RING_BYTES = 131072;
constexpr int LDS_BYTES = 147456;
constexpr int LDSX_OFF = RING_BYTES + 1024;
constexpr int LDSCTL_OFF = LDS_BYTES - 1024;

__device__ __forceinline__ float bf2f(unsigned v) { return __uint_as_float(v << 16); }
__device__ __forceinline__ unsigned cvtpk(float lo, float hi) { f32x2_t v = {lo, hi}; bf16x2_t b = __builtin_convertvector(v, bf16x2_t); return __builtin_bit_cast(unsigned, b); }
__device__ __forceinline__ unsigned lane_id_opaque() { unsigned r; asm volatile("v_mbcnt_lo_u32_b32 %0, -1, 0\n\tv_mbcnt_hi_u32_b32 %0, -1, %0" : "=v"(r)); return r; }
template <int M> __device__ __forceinline__ float shx(float v) {
    if constexpr (M < 32) { return __int_as_float(__builtin_amdgcn_ds_swizzle(__float_as_int(v), (M << 10) | 0x1f)); }
    else { auto r = __builtin_amdgcn_permlane32_swap(__float_as_uint(v), __float_as_uint(v), false, false);
           const bool lo = lane_id_opaque() < 32u; return __uint_as_float(lo ? r[1] : r[0]); }
}
template <int M> __device__ __forceinline__ int shxi(int v) { return __float_as_int(shx<M>(__int_as_float(v))); }
__device__ __forceinline__ float sum32x(float v) { auto r = __builtin_amdgcn_permlane32_swap(__float_as_uint(v), __float_as_uint(v), false, false); return __uint_as_float(r[0]) + __uint_as_float(r[1]); }
__device__ __forceinline__ float wave_sum(float v) {
    v += shx<1>(v); v += shx<2>(v); v += shx<4>(v); v += shx<8>(v); v += shx<16>(v); return sum32x(v);
}
__device__ __forceinline__ float wave_max(float v) {
    v = fmaxf(v, shx<1>(v)); v = fmaxf(v, shx<2>(v)); v = fmaxf(v, shx<4>(v)); v = fmaxf(v, shx<8>(v)); v = fmaxf(v, shx<16>(v)); return fmaxf(v, shx<32>(v));
}
__device__ __forceinline__ float grp8_sum(float v) { v += shx<1>(v); v += shx<2>(v); v += shx<4>(v); return v; }
#define LDS_WAIT() asm volatile("s_waitcnt lgkmcnt(0)" ::: "memory")
#define VM_WAIT() asm volatile("s_waitcnt vmcnt(0)" ::: "memory")

namespace pg8 {
constexpr int BM = 256, BK = 64, HALF = 128, HTB = HALF * BK * 2, STAGE_BYTES = 8 * HTB, NXCD = 8, WGM = 8;
__host__ __device__ __forceinline__ int lds_byte(int r, int c) { const int st = (r >> 4) * 2 + (c >> 5), rr = r & 15, cc = c & 31, ob = rr * 64 + cc * 2; return st * 1024 + (ob ^ (((ob >> 9) & 1) << 5)); }
__host__ __device__ __forceinline__ void stage_rc(int b, int& R, int& C) { const int st = b / 1024, sb = b % 1024, swz = sb ^ (((sb >> 9) & 1) << 5); R = (st >> 1) * 16 + swz / 64; C = (st & 1) * 32 + (swz % 64) / 2; }
__host__ __device__ __forceinline__ int perm32(int rho) { const int n = rho >> 4, i = rho & 15; return 8 * (i >> 2) + 4 * n + (i & 3); }
struct Unit { int pm, pn, aux; };
struct Gemm { const bf16* A; const bf16* Bt; int lda, ldb, K; };
struct StaticOrder {
    int nM, nN, nwg, G, c;
    __device__ void init(int M, int N, int G_, int c_) { nM = M / BM; nN = N / BM; nwg = nM * nN; G = G_; c = c_; }
    __device__ bool next(int i, Unit& u) const {
        const long L = (long)i * G + c; if (L >= nwg) return false;
        int wgid = (int)L; { const int q = nwg / NXCD, r = nwg % NXCD, xcd = wgid % NXCD, off = wgid / NXCD; wgid = (xcd < r ? xcd * (q + 1) : r * (q + 1) + (xcd - r) * q) + off; }
        const int nig = WGM * nN, gid = wgid / nig, fm = gid * WGM, gsz = (nM - fm) < WGM ? (nM - fm) : WGM;
        u.pm = fm + ((wgid % nig) % gsz); u.pn = (wgid % nig) / gsz; u.aux = 0; return true;
    }
};
struct MoeOrder {
    int ntn, xl, cl, nl; int mt[4], tp[4];
    __device__ bool next(int i, Unit& u) const {
        int L = i * nl + cl;
#pragma unroll
        for (int s = 0; s < 4; ++s) { const int nu = mt[s] * ntn; if (L < nu) { const int e = xl + 8 * s; u.pm = tp[s] + L % mt[s]; u.pn = e * ntn + L / mt[s]; u.aux = e; return true; } L -= nu; }
        return false;
    }
};
template <class Epi, class Sched>
__device__ __forceinline__ void gemm_phase(LAS unsigned char* lds, const Gemm g, const Sched& S, const Epi& E, int tid_in) {
    int tid_ = tid_in; asm volatile("" : "+v"(tid_));
    const int tid = tid_, wid = __builtin_amdgcn_readfirstlane(tid >> 6), lane = tid & 63, wr = wid >> 2, wc = wid & 3, fr = lane & 15, fq = lane >> 4;
    const int K = g.K, nt = K / BK;
    unsigned voffA[2], voffB[2];
#pragma unroll
    for (int i = 0; i < 2; ++i) { int R, C; stage_rc(tid * 16 + i * 8192, R, C); const int Rb = Epi::PERM ? ((R & ~31) + perm32(R & 31)) : R;
        voffA[i] = (unsigned)(R * g.lda + C) * 2u; voffB[i] = (unsigned)(Rb * g.ldb + C) * 2u; }
    const size_t kstep = (size_t)(BK * 2);
    const size_t hstepA = (size_t)HALF * g.lda * 2, hstepB = (size_t)HALF * g.ldb * 2;
    const size_t tstepA = 2 * hstepA, tstepB = 2 * hstepB;
    const unsigned ldsw = (unsigned)wid * 1024u;
    const int aoff = lds_byte(wr * 64 + fr, fq * 8), boff = lds_byte(wc * 32 + fr, fq * 8);
#define PG8_SA(b, h) (((b) * 2 + (h)) * HTB)
#define PG8_SB(b, h) ((4 + (b) * 2 + (h)) * HTB)
#define PG8_STAGE(bufoff, gbase, voff) do { _Pragma("unroll") for (int _i = 0; _i < 2; ++_i) \
        __builtin_amdgcn_global_load_lds((const unsigned*)((const char*)(gbase) + (voff)[_i]), (LAS unsigned*)(lds + (bufoff) + ldsw + _i * 8192), 16, 0, 0); } while (0)
#define PG8_LDA(dst, b, h) do { _Pragma("unroll") for (int m = 0; m < 4; ++m) _Pragma("unroll") for (int k = 0; k < 2; ++k) dst[m][k] = *(const LAS bf16x8*)(lds + PG8_SA(b, h) + aoff + m * 2048 + k * 1024); } while (0)
#define PG8_LDB(dst, b, h) do { _Pragma("unroll") for (int n = 0; n < 2; ++n) _Pragma("unroll") for (int k = 0; k < 2; ++k) dst[n][k] = *(const LAS bf16x8*)(lds + PG8_SB(b, h) + boff + n * 2048 + k * 1024); } while (0)
#define PG8_MMA(ai, bj, At, Bt) do { __builtin_amdgcn_s_setprio(1); _Pragma("unroll") for (int m = 0; m < 4; ++m) _Pragma("unroll") for (int n = 0; n < 2; ++n) _Pragma("unroll") for (int k = 0; k < 2; ++k) \
        acc[ai][bj][m][n] = __builtin_amdgcn_mfma_f32_16x16x32_bf16(Bt[n][k], At[m][k], acc[ai][bj][m][n], 0, 0, 0); __builtin_amdgcn_s_setprio(0); } while (0)
#define PG8_WAIT_V(n) asm volatile("s_waitcnt vmcnt(" #n ")" ::: "memory")
#define PG8_WAIT_L(n) asm volatile("s_waitcnt lgkmcnt(" #n ")" ::: "memory")
#define PG8_BAR __builtin_amdgcn_s_barrier()
#define PG8_SCHED __builtin_amdgcn_sched_barrier(0)
    Unit cur, nxt; int ui = 0;
    if (!S.next(0, cur)) return;
    f32x4 acc[2][2][4][2];
#pragma unroll
    for (int a = 0; a < 2; ++a)
#pragma unroll
        for (int b = 0; b < 2; ++b)
#pragma unroll
            for (int m = 0; m < 4; ++m)
#pragma unroll
                for (int n = 0; n < 2; ++n) acc[a][b][m][n] = (f32x4){0.f, 0.f, 0.f, 0.f};
    bf16x8 At[4][2], B0[2][2], B1[2][2];
    const char* cA = (const char*)g.A + (size_t)cur.pm * tstepA; const char* cB = (const char*)g.Bt + (size_t)cur.pn * tstepB;
    PG8_STAGE(PG8_SB(0, 0), cB, voffB); PG8_STAGE(PG8_SB(0, 1), cB + hstepB, voffB); PG8_STAGE(PG8_SA(0, 0), cA, voffA); PG8_STAGE(PG8_SA(0, 1), cA + hstepA, voffA);
    if (wr == 1) PG8_BAR;
    PG8_WAIT_V(2); PG8_BAR;
    PG8_STAGE(PG8_SB(1, 0), cB + kstep, voffB); PG8_STAGE(PG8_SA(1, 0), cA + kstep, voffA); PG8_STAGE(PG8_SB(1, 1), cB + hstepB + kstep, voffB);
    PG8_WAIT_V(6); PG8_BAR;
    for (;;) {
        const bool has_next = S.next(ui + 1, nxt);
        const char* nA = has_next ? (const char*)g.A + (size_t)nxt.pm * tstepA : cA; const char* nB = has_next ? (const char*)g.Bt + (size_t)nxt.pn * tstepB : cB;
#pragma unroll 1
        for (int t = 0; t < nt; t += 2) {
            const bool last = (t == nt - 2);
            const char* a1 = cA + (size_t)(t + 1) * kstep;
            const char* a2 = last ? nA : cA + (size_t)(t + 2) * kstep; const char* b2 = last ? nB : cB + (size_t)(t + 2) * kstep;
            const char* a3 = a2 + kstep; const char* b3 = b2 + kstep;
            PG8_LDB(B0, 0, 0); PG8_LDB(B1, 0, 1); PG8_SCHED; PG8_LDA(At, 0, 0); PG8_STAGE(PG8_SA(1, 1), a1 + hstepA, voffA);
            PG8_WAIT_V(8); PG8_WAIT_L(0); PG8_BAR; PG8_MMA(0, 0, At, B0); PG8_MMA(0, 1, At, B1); PG8_BAR; PG8_SCHED;
            PG8_LDA(At, 0, 1); PG8_STAGE(PG8_SB(0, 0), b2, voffB); PG8_STAGE(PG8_SB(0, 1), b2 + hstepB, voffB); PG8_STAGE(PG8_SA(0, 0), a2, voffA);
            PG8_WAIT_V(8); PG8_WAIT_L(0); PG8_BAR; PG8_MMA(1, 0, At, B0); PG8_MMA(1, 1, At, B1); PG8_BAR; PG8_SCHED;
            PG8_LDB(B0, 1, 0); PG8_LDB(B1, 1, 1); PG8_SCHED; PG8_LDA(At, 1, 0); PG8_STAGE(PG8_SA(0, 1), a2 + hstepA, voffA);
            PG8_WAIT_V(8); PG8_WAIT_L(0); PG8_BAR; PG8_MMA(0, 0, At, B0); PG8_MMA(0, 1, At, B1); PG8_BAR; PG8_SCHED;
            PG8_LDA(At, 1, 1); PG8_STAGE(PG8_SB(1, 0), b3, voffB); PG8_STAGE(PG8_SB(1, 1), b3 + hstepB, voffB); PG8_STAGE(PG8_SA(1, 0), a3, voffA);
            PG8_WAIT_V(8); PG8_WAIT_L(0); PG8_BAR; PG8_MMA(1, 0, At, B0); PG8_MMA(1, 1, At, B1); PG8_BAR; PG8_SCHED;
        }
        if (wr == 0) PG8_BAR;
        E(acc, cur, wr, wc, fr, fq);
        if (!has_next) break;
#pragma unroll
        for (int a = 0; a < 2; ++a)
#pragma unroll
            for (int b = 0; b < 2; ++b)
#pragma unroll
                for (int m = 0; m < 4; ++m)
#pragma unroll
                    for (int n = 0; n < 2; ++n) acc[a][b][m][n] = (f32x4){0.f, 0.f, 0.f, 0.f};
        cur = nxt; cA = nA; cB = nB; ++ui;
        if (wr == 1) PG8_BAR;
    }
    PG8_WAIT_V(0);
    PG8_BAR;
#undef PG8_SA
#undef PG8_SB
#undef PG8_STAGE
#undef PG8_LDA
#undef PG8_LDB
#undef PG8_MMA
#undef PG8_WAIT_V
#undef PG8_WAIT_L
#undef PG8_BAR
#undef PG8_SCHED
}
struct EpiScaleBf16 {
    static constexpr bool PERM = true;
    bf16* O; int ldc; const float* rs; int rs_stride;
    __device__ __forceinline__ void operator()(const f32x4 (&acc)[2][2][4][2], const Unit& u, int wr, int wc, int fr, int fq) const {
        const int row0 = u.pm * BM + wr * 64 + fr, col0 = u.pn * BM + wc * 32 + 8 * fq;
#pragma unroll
        for (int ai = 0; ai < 2; ++ai)
#pragma unroll
            for (int m = 0; m < 4; ++m) { const int row = row0 + ai * HALF + m * 16; const float sc = rs ? rs[(size_t)row * rs_stride] : 1.0f; bf16* rowp = O + (size_t)row * ldc + col0;
#pragma unroll
                for (int bj = 0; bj < 2; ++bj) { const f32x4 v0 = acc[ai][bj][m][0] * sc, v1 = acc[ai][bj][m][1] * sc;
                    u32x4 w; w.x = cvtpk(v0[0], v0[1]); w.y = cvtpk(v0[2], v0[3]); w.z = cvtpk(v1[0], v1[1]); w.w = cvtpk(v1[2], v1[3]);
                    *(u32x4*)(rowp + bj * HALF) = w; } }
    }
};
struct EpiResF32 {
    static constexpr bool PERM = false;
    const float* base; float* out; int ldc;
    __device__ __forceinline__ void operator()(const f32x4 (&acc)[2][2][4][2], const Unit& u, int wr, int wc, int fr, int fq) const {
        const int row0 = u.pm * BM + wr * 64 + fr, col0 = u.pn * BM + wc * 32 + 4 * fq;
#pragma unroll
        for (int ai = 0; ai < 2; ++ai)
#pragma unroll
            for (int m = 0; m < 4; ++m) { const size_t off = (size_t)(row0 + ai * HALF + m * 16) * ldc + col0;
#pragma unroll
                for (int bj = 0; bj < 2; ++bj)
#pragma unroll
                    for (int n = 0; n < 2; ++n) { const f32x4 bs = *(const f32x4*)(base + off + bj * HALF + n * 16); *(f32x4*)(out + off + bj * HALF + n * 16) = bs + acc[ai][bj][m][n]; } }
    }
};
struct EpiResF32Bf16 {
    static constexpr bool PERM = false;
    const float* base; float* out; bf16* xb; float* ssq; int ldc;
    __device__ __forceinline__ void operator()(const f32x4 (&acc)[2][2][4][2], const Unit& u, int wr, int wc, int fr, int fq) const {
        const int row0 = u.pm * BM + wr * 64 + fr, col0 = u.pn * BM + wc * 32 + 4 * fq;
#pragma unroll
        for (int ai = 0; ai < 2; ++ai)
#pragma unroll
            for (int m = 0; m < 4; ++m) { const int row = row0 + ai * HALF + m * 16; const size_t off = (size_t)row * ldc + col0; float ss = 0.f;
#pragma unroll
                for (int bj = 0; bj < 2; ++bj)
#pragma unroll
                    for (int n = 0; n < 2; ++n) { const f32x4 v = *(const f32x4*)(base + off + bj * HALF + n * 16) + acc[ai][bj][m][n];
                        ss += (v[0] * v[0] + v[1] * v[1]) + (v[2] * v[2] + v[3] * v[3]);
                        u32x2 w; w.x = cvtpk(v[0], v[1]); w.y = cvtpk(v[2], v[3]); *(u32x2*)(xb + off + bj * HALF + n * 16) = w; }
                ss += shx<16>(ss); ss = sum32x(ss);
                if (fq == 0) ssq[(size_t)row * 16 + u.pn * 4 + wc] = ss; }
    }
};
struct EpiAddBf16 {
    static constexpr bool PERM = true;
    bf16* xb; int ldc;
    __device__ __forceinline__ void operator()(const f32x4 (&acc)[2][2][4][2], const Unit& u, int wr, int wc, int fr, int fq) const {
        const int row0 = u.pm * BM + wr * 64 + fr, col0 = u.pn * BM + wc * 32 + 8 * fq;
#pragma unroll
        for (int ai = 0; ai < 2; ++ai)
#pragma unroll
            for (int m = 0; m < 4; ++m) { bf16* rowp = xb + (size_t)(row0 + ai * HALF + m * 16) * ldc + col0;
#pragma unroll
                for (int bj = 0; bj < 2; ++bj) { const u32x4 o = *(const u32x4*)(rowp + bj * HALF); const f32x4 a0 = acc[ai][bj][m][0], a1 = acc[ai][bj][m][1];
                    u32x4 w; w.x = cvtpk(__uint_as_float(o.x << 16) + a0[0], __uint_as_float(o.x & 0xffff0000u) + a0[1]); w.y = cvtpk(__uint_as_float(o.y << 16) + a0[2], __uint_as_float(o.y & 0xffff0000u) + a0[3]);
                    w.z = cvtpk(__uint_as_float(o.z << 16) + a1[0], __uint_as_float(o.z & 0xffff0000u) + a1[1]); w.w = cvtpk(__uint_as_float(o.w << 16) + a1[2], __uint_as_float(o.w & 0xffff0000u) + a1[3]);
                    *(u32x4*)(rowp + bj * HALF) = w; } }
    }
};
struct EpiAddBf16Ssq {
    static constexpr bool PERM = true;
    bf16* xb; int ldc; float* ssq;
    __device__ __forceinline__ void operator()(const f32x4 (&acc)[2][2][4][2], const Unit& u, int wr, int wc, int fr, int fq) const {
        const int row0 = u.pm * BM + wr * 64 + fr, col0 = u.pn * BM + wc * 32 + 8 * fq;
#pragma unroll
        for (int ai = 0; ai < 2; ++ai)
#pragma unroll
            for (int m = 0; m < 4; ++m) { const int row = row0 + ai * HALF + m * 16; bf16* rowp = xb + (size_t)row * ldc + col0; float ss = 0.f;
#pragma unroll
                for (int bj = 0; bj < 2; ++bj) { const u32x4 o = *(const u32x4*)(rowp + bj * HALF); const f32x4 a0 = acc[ai][bj][m][0], a1 = acc[ai][bj][m][1];
                    const float v0 = __uint_as_float(o.x << 16) + a0[0], v1 = __uint_as_float(o.x & 0xffff0000u) + a0[1], v2 = __uint_as_float(o.y << 16) + a0[2], v3 = __uint_as_float(o.y & 0xffff0000u) + a0[3];
                    const float v4 = __uint_as_float(o.z << 16) + a1[0], v5 = __uint_as_float(o.z & 0xffff0000u) + a1[1], v6 = __uint_as_float(o.w << 16) + a1[2], v7 = __uint_as_float(o.w & 0xffff0000u) + a1[3];
                    ss += ((v0 * v0 + v1 * v1) + (v2 * v2 + v3 * v3)) + ((v4 * v4 + v5 * v5) + (v6 * v6 + v7 * v7));
                    u32x4 w; w.x = cvtpk(v0, v1); w.y = cvtpk(v2, v3); w.z = cvtpk(v4, v5); w.w = cvtpk(v6, v7);
                    *(u32x4*)(rowp + bj * HALF) = w; }
                ss += shx<16>(ss); ss = sum32x(ss);
                if (fq == 0) ssq[(size_t)row * 16 + u.pn * 4 + wc] = ss; }
    }
};
struct EpiSsqScaleBf16 {
    static constexpr bool PERM = true;
    bf16* O; int ldc; const float* ssq;
    __device__ __forceinline__ void operator()(const f32x4 (&acc)[2][2][4][2], const Unit& u, int wr, int wc, int fr, int fq) const {
        const int row0 = u.pm * BM + wr * 64 + fr, col0 = u.pn * BM + wc * 32 + 8 * fq;
#pragma unroll
        for (int ai = 0; ai < 2; ++ai)
#pragma unroll
            for (int m = 0; m < 4; ++m) { const int row = row0 + ai * HALF + m * 16; const f32x4* sp = (const f32x4*)(ssq + (size_t)row * 16);
                const f32x4 s0 = sp[0], s1 = sp[1], s2 = sp[2], s3 = sp[3];
                const float tot = ((s0[0] + s0[1]) + (s0[2] + s0[3])) + ((s1[0] + s1[1]) + (s1[2] + s1[3])) + ((s2[0] + s2[1]) + (s2[2] + s2[3])) + ((s3[0] + s3[1]) + (s3[2] + s3[3]));
                const float sc = 1.0f / sqrtf(tot * (1.0f / 1024) + EPS); bf16* rowp = O + (size_t)row * ldc + col0;
#pragma unroll
                for (int bj = 0; bj < 2; ++bj) { const f32x4 v0 = acc[ai][bj][m][0] * sc, v1 = acc[ai][bj][m][1] * sc;
                    u32x4 w; w.x = cvtpk(v0[0], v0[1]); w.y = cvtpk(v0[2], v0[3]); w.z = cvtpk(v1[0], v1[1]); w.w = cvtpk(v1[2], v1[3]);
                    *(u32x4*)(rowp + bj * HALF) = w; } }
    }
};
struct EpiSwiglu {
    static constexpr bool PERM = true;
    bf16* act; const float* bgu;
    __device__ __forceinline__ void operator()(const f32x4 (&acc)[2][2][4][2], const Unit& u, int wr, int wc, int fr, int fq) const {
        const int e = u.aux, pnl = u.pn - e * 8;
        const int row0 = u.pm * BM + wr * 64 + fr, c0 = pnl * BM + wc * 32 + 8 * fq;
#pragma unroll
        for (int bj = 0; bj < 2; ++bj) { const f32x4 b0 = *(const f32x4*)(bgu + (size_t)e * 2048 + c0 + bj * HALF), b1 = *(const f32x4*)(bgu + (size_t)e * 2048 + c0 + bj * HALF + 4);
#pragma unroll
            for (int ai = 0; ai < 2; ++ai)
#pragma unroll
                for (int m = 0; m < 4; ++m) { const int row = row0 + ai * HALF + m * 16; const f32x4 v0 = acc[ai][bj][m][0] + b0, v1 = acc[ai][bj][m][1] + b1; float o[4];
#pragma unroll
                    for (int j = 0; j < 4; ++j) { float gt = j < 2 ? v0[2 * j] : v1[2 * j - 4], up = j < 2 ? v0[2 * j + 1] : v1[2 * j - 3];
                        gt = fminf(gt, 7.0f); up = fminf(fmaxf(up, -7.0f), 7.0f);
                        const float sg = __builtin_amdgcn_rcpf(1.0f + __builtin_amdgcn_exp2f(-1.702f * LOG2E * gt));
                        o[j] = (up + 1.0f) * gt * sg; }
                    u32x2 w; w.x = cvtpk(o[0], o[1]); w.y = cvtpk(o[2], o[3]);
                    *(u32x2*)(act + (size_t)row * 1024 + ((c0 + bj * HALF) >> 1)) = w; } }
    }
};
struct EpiDown {
    static constexpr bool PERM = true;
    bf16* Y; const float* bd;
    __device__ __forceinline__ void operator()(const f32x4 (&acc)[2][2][4][2], const Unit& u, int wr, int wc, int fr, int fq) const {
        const int e = u.aux, pnl = u.pn - e * 4;
        const int row0 = u.pm * BM + wr * 64 + fr, c0 = pnl * BM + wc * 32 + 8 * fq;
#pragma unroll
        for (int bj = 0; bj < 2; ++bj) { const f32x4 b0 = *(const f32x4*)(bd + (size_t)e * 1024 + c0 + bj * HALF), b1 = *(const f32x4*)(bd + (size_t)e * 1024 + c0 + bj * HALF + 4);
#pragma unroll
            for (int ai = 0; ai < 2; ++ai)
#pragma unroll
                for (int m = 0; m < 4; ++m) { const int row = row0 + ai * HALF + m * 16; const f32x4 v0 = acc[ai][bj][m][0] + b0, v1 = acc[ai][bj][m][1] + b1;
                    u32x4 w; w.x = cvtpk(v0[0], v0[1]); w.y = cvtpk(v0[2], v0[3]); w.z = cvtpk(v1[0], v1[1]); w.w = cvtpk(v1[2], v1[3]);
                    *(u32x4*)(Y + (size_t)row * 1024 + c0 + bj * HALF) = w; } }
    }
};
}

#define XB_TMO      128
#define XB_XCNT(j)  (256  + 64 * (j))
#define XB_XSUB(j)  (1280 + 64 * (j))
#define XB_XGEN(j)  (2304 + 64 * (j))
#define XB_TOP      3328
#define XB_TOPGEN   3392
#define XCD_BAR_WORDS 3456
#define XB_SPIN_CAP (1u << 18)
__device__ __forceinline__ unsigned xb_ld(unsigned* p)              { return __hip_atomic_load(p, __ATOMIC_RELAXED, __HIP_MEMORY_SCOPE_AGENT); }
__device__ __forceinline__ unsigned xb_add(unsigned* p, unsigned v) { return __hip_atomic_fetch_add(p, v, __ATOMIC_RELAXED, __HIP_MEMORY_SCOPE_AGENT); }
__device__ __forceinline__ unsigned xb_xcc_id() { return (unsigned)__builtin_amdgcn_s_getreg((3 << 11) | 20) & 0xFu; }
#define XB_SPIN(cond, bar) do { unsigned _sp = 0; while (cond) { __builtin_amdgcn_s_sleep(1); \
    if ((++_sp & 255u) == 0u) { if (xb_ld(&(bar)[XB_TMO])) break; if (_sp > XB_SPIN_CAP) { atomicAdd(&(bar)[XB_TMO], 1u); break; } } } } while (0)
struct XcdBarrier { unsigned* bar; unsigned x; volatile LAS unsigned* st; };
__device__ __forceinline__ XcdBarrier xcd_barrier_post(unsigned* bar, volatile LAS unsigned* st) {
    XcdBarrier b; b.bar = bar; b.x = xb_xcc_id(); b.st = st;
    if (threadIdx.x == 0) (void)xb_add(&bar[XB_XCNT(b.x)], 1u);
    return b;
}
__device__ __forceinline__ void xcd_barrier_complete(unsigned* bar, unsigned x, unsigned& nloc, unsigned& nx) {
    const unsigned G = gridDim.x * gridDim.y * gridDim.z;
    unsigned sum, cnt, mine, sp = 0u;
    for (;;) {
        sum = 0u; cnt = 0u; mine = 0u;
#pragma unroll
        for (unsigned j = 0; j < 16; ++j) { const unsigned c = xb_ld(&bar[XB_XCNT(j)]); sum += c; cnt += (c > 0u) ? 1u : 0u; mine = (j == x) ? c : mine; }
        if (sum == G) break;
        __builtin_amdgcn_s_sleep(1);
        if ((++sp & 255u) == 0u) { if (xb_ld(&bar[XB_TMO])) break; if (sp > XB_SPIN_CAP) { atomicAdd(&bar[XB_TMO], 1u); break; } }
    }
    nloc = mine > 0u ? mine : 1u; nx = cnt > 0u ? cnt : 1u;
}
__device__ __forceinline__ void xcd_barrier(const XcdBarrier& b, bool leader) {
    asm volatile("s_waitcnt vmcnt(0)" ::: "memory");
    __syncthreads();
    if (leader) {
        unsigned* bar = b.bar;
        __builtin_amdgcn_s_waitcnt(0);
        unsigned nloc = b.st[0], nx = b.st[1];
        if (nloc == 0u) { xcd_barrier_complete(bar, b.x, nloc, nx); b.st[0] = nloc; b.st[1] = nx; }
        const unsigned old = xb_add(&bar[XB_XSUB(b.x)], 1u);
        const unsigned gen = old / nloc;
        if (old + 1u == (gen + 1u) * nloc) {
            __builtin_amdgcn_fence(__ATOMIC_RELEASE, "agent");
            asm volatile("s_waitcnt vmcnt(0)" ::: "memory");
            const unsigned og = xb_add(&bar[XB_TOP], 1u);
            const unsigned tg = og / nx;
            if (og + 1u == (tg + 1u) * nx) xb_add(&bar[XB_TOPGEN], 1u);
            else XB_SPIN(xb_ld(&bar[XB_TOPGEN]) == tg, bar);
            __builtin_amdgcn_fence(__ATOMIC_ACQUIRE, "agent");
            xb_add(&bar[XB_XGEN(b.x)], 1u);
            asm volatile("s_waitcnt vmcnt(0)" ::: "memory");
        } else {
            XB_SPIN(xb_ld(&bar[XB_XGEN(b.x)]) == gen, bar);
            __builtin_amdgcn_fence(__ATOMIC_ACQUIRE, "agent");
            asm volatile("s_waitcnt vmcnt(0)" ::: "memory");
        }
    }
    __syncthreads();
}

struct Args { const float* in[36]; float* out; unsigned char* ws; };
struct Frame {
    LAS unsigned char* lds; int tid, lane, wave, G, bid, gw, ngw;
    const float* const* in; float* out; unsigned char* ws;
};
#ifndef PRB_A
#define PRB_A -1
#endif
#ifndef PRB_B
#define PRB_B -1
#endif
#define FSTAMP(F, k) do { if (PRB_A >= 0 && (F).bid == 0 && (F).tid == 0) ((volatile LAS unsigned long long*)((F).lds + LDSCTL_OFF + 128))[k] = __builtin_amdgcn_s_memrealtime(); } while (0)
#define WSP(T, off) ((T*)(F.ws + (off)))

struct TrItem { const float* wp; const float* gp; bf16* dst; int ldw, ldd; float msk; };
__device__ __forceinline__ void tr_decode(Frame& F, int it, TrItem& d) {
    const float* const* in = F.in; const float* nog = nullptr;
    constexpr int I0 = 16 * 28, I1 = 4 * 12, I2 = 4 * 16, I3 = 16 * 16, I4 = 16 * 4, I5 = 4 * 16, I6 = 32 * 16 * 32, I7 = 32 * 16 * 16;
    int r = it; const float* W; int ldw, kvalid, nvalid, gsplit = 1 << 30, ldd, kb, nb; const float* g1 = nog; const float* g2 = nog; bf16* WT;
    if (r < I0) { kb = r / 28; nb = r % 28; W = in[3]; ldw = 1720; kvalid = 1024; nvalid = 1720; g1 = in[2]; g2 = in[2]; WT = WSP(bf16, WS_WIN); ldd = 1024; }
    else if ((r -= I0) < I1) { kb = r / 12; nb = r % 12; W = in[5]; ldw = 768; kvalid = 256; nvalid = 768; g1 = in[4]; g2 = in[4]; WT = WSP(bf16, WS_WUQ); ldd = 256; }
    else if ((r -= I1) < I2) { kb = r / 16; nb = r % 16; W = in[7]; ldw = 1024; kvalid = 128; nvalid = 1024; g1 = in[6]; g2 = in[6]; WT = WSP(bf16, WS_WUKV); ldd = 256; }
    else if ((r -= I2) < I3) { kb = r / 16; nb = r % 16; W = in[21]; ldw = 1024; kvalid = 1024; nvalid = 1024; g1 = in[19]; g2 = in[20]; gsplit = 512; WT = WSP(bf16, WS_WOUT); ldd = 1024; }
    else if ((r -= I3) < I4) { kb = r / 4; nb = r % 4; W = in[24]; ldw = 256; kvalid = 1024; nvalid = 256; g1 = in[22]; g2 = in[22]; WT = WSP(bf16, WS_WMQ); ldd = 1024; }
    else if ((r -= I4) < I5) { kb = r / 16; nb = r % 16; W = in[28]; ldw = 1024; kvalid = 256; nvalid = 1024; WT = WSP(bf16, WS_WMO); ldd = 256; }
    else if ((r -= I5) < I6) { const int e = r / 512, q = r % 512; kb = q / 32; nb = q % 32; W = in[32] + (size_t)e * 1024 * 2048; ldw = 2048; kvalid = 1024; nvalid = 2048; g1 = in[29]; g2 = in[29]; WT = WSP(bf16, WS_WGU) + (size_t)e * 2048 * 1024; ldd = 1024; }
    else if ((r -= I6) < I7) { const int e = r / 256, q = r % 256; kb = q / 16; nb = q % 16; W = in[34] + (size_t)e * 1024 * 1024; ldw = 1024; kvalid = 1024; nvalid = 1024; WT = WSP(bf16, WS_WD) + (size_t)e * 1024 * 1024; ldd = 1024; }
    else if ((r -= I7) < 128) { const int kv = r / 64, q = r % 64; kb = q / 2; nb = q % 2; W = in[kv ? 14 : 11]; ldw = 128; kvalid = 2048; nvalid = 128; WT = WSP(bf16, WS_W1T) + (size_t)kv * 128 * 2048; ldd = 2048; }
    else { r -= 128; kb = r / 8; nb = r % 8; W = in[25]; ldw = 512; kvalid = 1024; nvalid = 512; g1 = in[23]; g2 = in[23]; WT = WSP(bf16, WS_WMKVT); ldd = 1024; }
    const int k0 = 64 * kb, n0 = 64 * nb, cg = F.lane & 15, rp = F.lane >> 4, nc = n0 + 4 * cg;
    const bool ok = (nc < nvalid) && (k0 < kvalid);
    d.gp = g1 ? ((k0 < gsplit ? g1 + k0 : g2 + (k0 - gsplit)) + 2 * rp) : nullptr;
    d.wp = W + (ok ? (size_t)(k0 + 2 * rp) * ldw + nc : (size_t)0);
    d.msk = ok ? 1.0f : 0.0f; d.ldw = ldw; d.ldd = ldd; d.dst = WT + (size_t)n0 * ldd + k0;
}
__device__ __forceinline__ void tr_load(const TrItem& d, f32x4 (&a)[8], f32x4 (&b)[8]) {
#pragma unroll
    for (int j = 0; j < 8; ++j) { a[j] = __builtin_nontemporal_load((const f32x4*)(d.wp + (size_t)(8 * j) * d.ldw)); b[j] = __builtin_nontemporal_load((const f32x4*)(d.wp + (size_t)(8 * j + 1) * d.ldw)); }
}
__device__ __forceinline__ void tr_finish(const TrItem& d, f32x4 (&a)[8], f32x4 (&b)[8], LAS unsigned* scr, int lane) {
    const int cg = lane & 15, rp = lane >> 4;
#pragma unroll
    for (int j = 0; j < 8; ++j) {
        float ga = d.msk, gb = d.msk;
        if (d.gp) { const f32x2_t g2v = *(const f32x2_t*)(d.gp + 8 * j); ga *= g2v.x; gb *= g2v.y; }
        a[j] = a[j] * ga; b[j] = b[j] * gb;
        LAS unsigned* q = scr + (4 * cg) * 36 + 4 * j + rp;
        q[0] = cvtpk(a[j].x, b[j].x); q[36] = cvtpk(a[j].y, b[j].y); q[72] = cvtpk(a[j].z, b[j].z); q[108] = cvtpk(a[j].w, b[j].w); }
    LDS_WAIT(); asm volatile("" ::: "memory");
#pragma unroll
    for (int i = 0; i < 8; ++i) { const int n = 8 * i + (lane >> 3), c = lane & 7;
        const u32x4 v = *(const LAS u32x4*)(scr + n * 36 + 4 * c);
        *(u32x4*)(d.dst + (size_t)n * d.ldd + 8 * c) = v; }
    LDS_WAIT(); asm volatile("" ::: "memory");
}

__device__ __forceinline__ void p0_prologue(Frame& F) {
    LAS unsigned* scr = (LAS unsigned*)(F.lds + F.wave * 16384);
    const float* const* in = F.in;
    constexpr int NITEMS = 16 * 28 + 4 * 12 + 4 * 16 + 16 * 16 + 16 * 4 + 4 * 16 + 32 * 16 * 32 + 32 * 16 * 16 + 2 * 32 * 2 + 16 * 8;
    { TrItem d0, d1; f32x4 a0[8], b0[8], a1[8], b1[8];
      int it = F.gw; if (it < NITEMS) { tr_decode(F, it, d0); tr_load(d0, a0, b0); }
#pragma unroll 1
      while (it < NITEMS) {
          const int it1 = it + F.ngw; if (it1 < NITEMS) { tr_decode(F, it1, d1); tr_load(d1, a1, b1); }
          tr_finish(d0, a0, b0, scr, F.lane);
          if (it1 >= NITEMS) break;
          const int it2 = it1 + F.ngw; if (it2 < NITEMS) { tr_decode(F, it2, d0); tr_load(d0, a0, b0); }
          tr_finish(d1, a1, b1, scr, F.lane);
          it = it2;
      } }
    FSTAMP(F, 32);
    { float* RS = WSP(float, WS_RS); bf16* XB = WSP(bf16, WS_XB);
      for (int m = F.gw; m < NTOK; m += F.ngw) {
        const f32x4* xr = (const f32x4*)(in[0] + (size_t)m * D) + F.lane; f32x4 v[4]; float s = 0.f;
#pragma unroll
        for (int j = 0; j < 4; ++j) { v[j] = xr[64 * j]; s += (v[j].x * v[j].x + v[j].y * v[j].y) + (v[j].z * v[j].z + v[j].w * v[j].w); }
        s = wave_sum(s); if (F.lane == 0) RS[m * 4 + 0] = 1.0f / sqrtf(s * (1.0f / D) + EPS);
        u32x2* o8 = (u32x2*)(XB + (size_t)m * D) + F.lane;
#pragma unroll
        for (int j = 0; j < 4; ++j) { u32x2 w; w.x = cvtpk(v[j].x, v[j].y); w.y = cvtpk(v[j].z, v[j].w); o8[64 * j] = w; }
      } }
    { float* RSM = WSP(float, WS_RSM); bf16* MB = WSP(bf16, WS_MEMB);
      for (int m = F.gw; m < 512; m += F.ngw) {
        const f32x4* xr = (const f32x4*)(in[1] + (size_t)m * D) + F.lane; f32x4 v[4]; float s = 0.f;
#pragma unroll
        for (int j = 0; j < 4; ++j) { v[j] = xr[64 * j]; s += (v[j].x * v[j].x + v[j].y * v[j].y) + (v[j].z * v[j].z + v[j].w * v[j].w); }
        s = wave_sum(s); if (F.lane == 0) RSM[m] = 1.0f / sqrtf(s * (1.0f / D) + EPS);
        u32x2* o8 = (u32x2*)(MB + (size_t)m * D) + F.lane;
#pragma unroll
        for (int j = 0; j < 4; ++j) { u32x2 w; w.x = cvtpk(v[j].x, v[j].y); w.y = cvtpk(v[j].z, v[j].w); o8[64 * j] = w; }
      } }
    FSTAMP(F, 33);
    if (F.bid < 32) { const int kv = F.bid >> 4, part = (F.bid & 15) * 4 + (F.tid >> 7), f = F.tid & 127;
        const float* pos = in[kv ? 13 : 10] + 32 * part; const float* w1 = in[kv ? 14 : 11] + (size_t)(32 * part) * 128 + f; float wv[32], acc = 0.f;
#pragma unroll
        for (int k = 0; k < 32; ++k) wv[k] = w1[(size_t)k * 128];
#pragma unroll
        for (int k = 0; k < 32; ++k) acc += pos[k] * wv[k];
        WSP(float, WS_CONST)[CF_CPP + (kv * 64 + part) * 128 + f] = acc; }
    float* CF = WSP(float, WS_CONST);
    if (F.bid == 0 && F.wave == 1) {
        const int l = F.lane;
        float m1 = 0.f; for (int i = l; i < 96; i += 64) m1 = fmaxf(m1, fabsf(in[9][i])); m1 = wave_max(m1);
        float m2 = wave_max(fabsf(in[17][l])); float m3 = wave_max(fabsf(in[27][l]));
        if (l == 0) { CF[CF_KBM] = sqrtf(96.f) * m1; CF[CF_KBN] = 8.f * m2; CF[CF_KBMEM] = 8.f * m3; }
        if (l < 8) { float mb = -1e30f; for (int b = 0; b < 32; ++b) mb = fmaxf(mb, in[18][b * 8 + l]); CF[CF_MAXB2 + l] = mb * LOG2E; }
        for (int i = l; i < 256; i += 64) CF[CF_BIAS2 + i] = in[18][i] * LOG2E;
        for (int n = l; n < 512; n += 64) { int bk; if (n < 16) bk = n; else { bk = 16 + (int)(logf((float)n / 16.0f) / logf(32.0f) * 16.0f); bk = bk < 31 ? bk : 31; } CF[CF_LUT + n] = (float)bk; }
    }
}
__device__ __forceinline__ void unpack8(const u32x4 w, float (&v)[8]) {
    v[0] = bf2f(w.x & 0xffff); v[1] = bf2f(w.x >> 16); v[2] = bf2f(w.y & 0xffff); v[3] = bf2f(w.y >> 16);
    v[4] = bf2f(w.z & 0xffff); v[5] = bf2f(w.z >> 16); v[6] = bf2f(w.w & 0xffff); v[7] = bf2f(w.w >> 16);
}
__device__ __forceinline__ u32x4 pack8f(const float (&v)[8]) { u32x4 w; w.x = cvtpk(v[0], v[1]); w.y = cvtpk(v[2], v[3]); w.z = cvtpk(v[4], v[5]); w.w = cvtpk(v[6], v[7]); return w; }

__device__ __forceinline__ void tp_a(Frame& F) {
    const float* CF = WSP(float, WS_CONST); const float kbn = CF[CF_KBN];
    const bf16* PB = WSP(bf16, WS_PB); float* RS = WSP(float, WS_RS);
    const int l = F.lane;
    const float* gq = F.in[16]; const float* gk = F.in[17];
    float gqv[8], gkv[8];
#pragma unroll
    for (int j = 0; j < 8; ++j) { gqv[j] = gq[(8 * l + j) & 63]; gkv[j] = gk[(8 * l + j) & 63]; }
    for (int t = F.gw; t < NTOK; t += F.ngw) {
        const bf16* pr = PB + (size_t)t * NINP; const int b = t >> 13, s = t & 8191;
        { const u32x2 w = *(const u32x2*)(pr + C_CQ + 4 * l); const float a0 = bf2f(w.x & 0xffff), a1 = bf2f(w.x >> 16), a2 = bf2f(w.y & 0xffff), a3 = bf2f(w.y >> 16);
          const float sq = wave_sum(a0 * a0 + a1 * a1 + a2 * a2 + a3 * a3);
          const unsigned w2 = *(const unsigned*)(pr + C_CKV + 2 * l); const float c0 = bf2f(w2 & 0xffff), c1 = bf2f(w2 >> 16);
          const float sk = wave_sum(c0 * c0 + c1 * c1);
          if (l == 0) { RS[t * 4 + 1] = 1.0f / sqrtf(sq * (1.0f / 256) + EPS); RS[t * 4 + 2] = 1.0f / sqrtf(sk * (1.0f / 128) + EPS); } }
        { float v[8]; unpack8(*(const u32x4*)(pr + C_QN + 8 * l), v); float ss = 0.f;
#pragma unroll
          for (int j = 0; j < 8; ++j) ss += v[j] * v[j];
          ss = grp8_sum(ss); const float rinv = 1.0f / sqrtf(ss * (1.0f / 64) + EPS) * (0.125f * LOG2E); float n2 = 0.f;
#pragma unroll
          for (int j = 0; j < 8; ++j) { v[j] = v[j] * rinv * gqv[j]; n2 += v[j] * v[j]; }
          n2 = grp8_sum(n2);
          const int h = l >> 3, g = h >> 2, hp = h & 3; const size_t ridx = (((size_t)(b * 2 + g) * S + s) * 4 + hp);
          *(u32x4*)(WSP(bf16, WS_QN) + ridx * 64 + (8 * l & 63)) = pack8f(v);
          if ((l & 7) == 0) WSP(float, WS_QBN)[ridx] = sqrtf(n2) * kbn + CF[CF_MAXB2 + h]; }
        { float v[8]; unpack8(*(const u32x4*)(pr + C_KS + 8 * l), v); const int seg = l >> 4, i = l & 15, g = i >> 3, d0 = (i & 7) * 8;
          float ss = 0.f;
#pragma unroll
          for (int j = 0; j < 8; ++j) ss += v[j] * v[j];
          ss = grp8_sum(ss);
          if ((seg & 1) == 0) { const float rinv = 1.0f / sqrtf(ss * (1.0f / 64) + EPS);
#pragma unroll
              for (int j = 0; j < 8; ++j) v[j] = v[j] * rinv * gkv[j]; }
          bf16* dst = WSP(bf16, seg == 0 ? WS_KS : seg == 1 ? WS_VS : seg == 2 ? WS_KW : WS_VW);
          *(u32x4*)(dst + ((size_t)(b * 2 + g) * S + s) * 64 + d0) = pack8f(v); }
        if (l < 24) { const float x = bf2f(pr[C_GT + l]); WSP(float, WS_GATE)[t * 24 + l] = 1.0f / (1.0f + __expf(-x)); }
    }
}

__device__ __forceinline__ void compress_phase(Frame& F) {
    const float* CF = WSP(float, WS_CONST);
    const bf16* PB = WSP(bf16, WS_PB);
    LAS float* red = (LAS float*)F.lds;
    LAS float* hid = (LAS float*)(F.lds + 65536);
    LAS float* ob = (LAS float*)(F.lds + 65536 + 8192);
    const int lane = F.lane, row = lane & 15, kq = lane >> 4;
    LAS float* cps = (LAS float*)(F.lds + 65536 + 8192 + 4096);
    __syncthreads();
    if (F.tid < 256) { float a = 0.f; const float* cp = CF + CF_CPP + (F.tid >> 7) * 64 * 128 + (F.tid & 127);
#pragma unroll 8
        for (int p = 0; p < 64; ++p) a += cp[p * 128];
        cps[F.tid] = a; }
    for (int it = F.bid; it < 256; it += F.G) {
        const int kv = it >> 7, slab = (it >> 5) & 3, n0 = (it & 31) * 16, b = slab >> 1, g = slab & 1;
        const int n = n0 + row;
        int tok0 = 16 * n + 4 * F.wave; if (tok0 > S - 4) tok0 = S - 4;
        const bf16* ap = PB + (size_t)(b * S + tok0) * NINP + (kv ? C_VC : C_KC) + g * 64 + 8 * kq;
        const bf16* bp = WSP(bf16, WS_W1T) + (size_t)kv * 128 * 2048 + (size_t)row * 2048 + 256 * F.wave + 8 * kq;
        f32x4 acc[8];
#pragma unroll
        for (int i = 0; i < 8; ++i) acc[i] = (f32x4){0.f, 0.f, 0.f, 0.f};
#pragma unroll
        for (int hb = 0; hb < 2; ++hb) {
            bf16x8 af[4], bf[4][8];
#pragma unroll
            for (int s = 0; s < 4; ++s) { const int ks = hb * 4 + s;
                af[s] = *(const bf16x8*)(ap + (size_t)(ks >> 1) * NINP + 32 * (ks & 1));
#pragma unroll
                for (int fb = 0; fb < 8; ++fb) bf[s][fb] = *(const bf16x8*)(bp + (size_t)fb * 16 * 2048 + 32 * ks); }
#pragma unroll
            for (int s = 0; s < 4; ++s)
#pragma unroll
                for (int fb = 0; fb < 8; ++fb) acc[fb] = __builtin_amdgcn_mfma_f32_16x16x32_bf16(af[s], bf[s][fb], acc[fb], 0, 0, 0);
        }
        __syncthreads();
#pragma unroll
        for (int fb = 0; fb < 8; ++fb)
#pragma unroll
            for (int i = 0; i < 4; ++i) red[(F.wave * 16 + 4 * kq + i) * 128 + fb * 16 + row] = acc[fb][i];
        __syncthreads();
        { const float c0 = 0.7978845608028654f, c1 = 0.044715f;
#pragma unroll
          for (int q = 0; q < 4; ++q) { const int idx = F.tid + 512 * q; float a = cps[kv * 128 + (idx & 127)];
#pragma unroll
              for (int ww = 0; ww < 8; ++ww) a += red[ww * 2048 + idx];
              hid[idx] = 0.5f * a * (1.f + tanhf(c0 * (a + c1 * a * a * a))); } }
        __syncthreads();
        { const float* w2 = F.in[kv ? 15 : 12];
#pragma unroll
          for (int q = 0; q < 2; ++q) { const int idx = F.tid + 512 * q, r = idx >> 6, d = idx & 63; float o = 0.f;
              for (int f = 0; f < 128; ++f) o += hid[r * 128 + f] * w2[f * 64 + d];
              if (kv == 0) { const float ss = wave_sum(o * o); o = o * (1.0f / sqrtf(ss * (1.0f / 64) + EPS)) * F.in[17][d]; }
              const int nn = n0 + r; if (nn >= 511) o = 0.f;
              WSP(bf16, kv ? WS_VCMP : WS_KCMP)[((size_t)slab * 512 + nn) * 64 + d] = (bf16)(cvtpk(o, 0.f) & 0xffff); } }
    }
    __syncthreads();
}

__device__ __forceinline__ void tp_b(Frame& F) {
    const float* CF = WSP(float, WS_CONST); const float kbm = CF[CF_KBM];
    const bf16* PB = WSP(bf16, WS_PB); const bf16* QR = WSP(bf16, WS_QRAW); const bf16* KVR = WSP(bf16, WS_KVRAW);
    const int l = F.lane, h = l >> 3, c = l & 7;
    const float* gq = F.in[8]; const float* gk = F.in[9];
    float gqn[8], gkn[8], gqr[4], gkr[4];
#pragma unroll
    for (int j = 0; j < 8; ++j) { gqn[j] = gq[8 * c + j]; gkn[j] = gk[8 * c + j]; }
    gqr[0] = gq[64 + 2 * c]; gqr[1] = gq[65 + 2 * c]; gqr[2] = gq[80 + 2 * c]; gqr[3] = gq[81 + 2 * c];
    gkr[0] = gk[64 + 2 * c]; gkr[1] = gk[65 + 2 * c]; gkr[2] = gk[80 + 2 * c]; gkr[3] = gk[81 + 2 * c];
    const float if0 = exp2f(-(float)(2 * c) * (13.287712379549449f / 16.0f)), if1 = exp2f(-(float)(2 * c + 1) * (13.287712379549449f / 16.0f));
    const float cq = 0.10206207261596575f * LOG2E;
    for (int t = F.gw; t < NTOK; t += F.ngw) {
        const int b = t >> 13, s = t & 8191; const size_t hrow = ((size_t)(b * 8 + h) * S + s);
        const float rcq = WSP(float, WS_RS)[t * 4 + 1], rckv = WSP(float, WS_RS)[t * 4 + 2];
        const float rv0 = __builtin_amdgcn_fractf((float)s * if0 * 0.15915494309189535f), rv1 = __builtin_amdgcn_fractf((float)s * if1 * 0.15915494309189535f);
        const float sn0 = __builtin_amdgcn_sinf(rv0), cs0 = __builtin_amdgcn_cosf(rv0), sn1 = __builtin_amdgcn_sinf(rv1), cs1 = __builtin_amdgcn_cosf(rv1);
        {
          float v[8]; unpack8(*(const u32x4*)(QR + (size_t)t * 768 + h * 96 + 8 * c), v);
          const unsigned wa = *(const unsigned*)(QR + (size_t)t * 768 + h * 96 + 64 + 2 * c), wb = *(const unsigned*)(QR + (size_t)t * 768 + h * 96 + 80 + 2 * c);
          float r0 = bf2f(wa & 0xffff), r1 = bf2f(wa >> 16), r2 = bf2f(wb & 0xffff), r3 = bf2f(wb >> 16);
          float ss = r0 * r0 + r1 * r1 + r2 * r2 + r3 * r3;
#pragma unroll
          for (int j = 0; j < 8; ++j) ss += v[j] * v[j];
          ss = grp8_sum(ss) * rcq * rcq; const float rinv = rcq / sqrtf(ss * (1.0f / 96) + EPS) * cq; float n2 = 0.f;
#pragma unroll
          for (int j = 0; j < 8; ++j) { v[j] = v[j] * rinv * gqn[j]; n2 += v[j] * v[j]; }
          r0 *= rinv * gqr[0]; r1 *= rinv * gqr[1]; r2 *= rinv * gqr[2]; r3 *= rinv * gqr[3];
          const float y0 = r0 * cs0 - r2 * sn0, y2 = r2 * cs0 + r0 * sn0, y1 = r1 * cs1 - r3 * sn1, y3 = r3 * cs1 + r1 * sn1;
          n2 += y0 * y0 + y1 * y1 + y2 * y2 + y3 * y3; n2 = grp8_sum(n2);
          bf16* dst = WSP(bf16, WS_QM) + hrow * 96;
          *(u32x4*)(dst + 8 * c) = pack8f(v); *(unsigned*)(dst + 64 + 2 * c) = cvtpk(y0, y1); *(unsigned*)(dst + 80 + 2 * c) = cvtpk(y2, y3);
          if (c == 0) WSP(float, WS_QBM)[hrow] = sqrtf(n2) * kbm; }
        {
          float v[8]; unpack8(*(const u32x4*)(KVR + (size_t)t * 1024 + h * 128 + 8 * c), v);
          const unsigned wa = *(const unsigned*)(PB + (size_t)t * NINP + C_KR + 2 * c), wb = *(const unsigned*)(PB + (size_t)t * NINP + C_KR + 16 + 2 * c);
          float r0 = bf2f(wa & 0xffff), r1 = bf2f(wa >> 16), r2 = bf2f(wb & 0xffff), r3 = bf2f(wb >> 16);
          float ss = r0 * r0 + r1 * r1 + r2 * r2 + r3 * r3;
#pragma unroll
          for (int j = 0; j < 8; ++j) { v[j] *= rckv; ss += v[j] * v[j]; }
          ss = grp8_sum(ss); const float rinv = 1.0f / sqrtf(ss * (1.0f / 96) + EPS);
#pragma unroll
          for (int j = 0; j < 8; ++j) v[j] = v[j] * rinv * gkn[j];
          r0 *= rinv * gkr[0]; r1 *= rinv * gkr[1]; r2 *= rinv * gkr[2]; r3 *= rinv * gkr[3];
          const float y0 = r0 * cs0 - r2 * sn0, y2 = r2 * cs0 + r0 * sn0, y1 = r1 * cs1 - r3 * sn1, y3 = r3 * cs1 + r1 * sn1;
          bf16* dst = WSP(bf16, WS_KM) + hrow * 96;
          *(u32x4*)(dst + 8 * c) = pack8f(v); *(unsigned*)(dst + 64 + 2 * c) = cvtpk(y0, y1); *(unsigned*)(dst + 80 + 2 * c) = cvtpk(y2, y3); }
        { float vv[8]; unpack8(*(const u32x4*)(KVR + (size_t)t * 1024 + h * 128 + 64 + 8 * c), vv);
#pragma unroll
          for (int j = 0; j < 8; ++j) vv[j] *= rckv;
          *(u32x4*)(WSP(bf16, WS_VM) + hrow * 64 + 8 * c) = pack8f(vv); }
    }
}

__device__ __forceinline__ void tp_c0(Frame& F) {
    bf16* Y = WSP(bf16, WS_Y); const int l = F.lane;
    for (int t = F.gw; t < NTOK; t += F.ngw) {
        u32x4* p = (u32x4*)(Y + (size_t)t * 1024 + 16 * l); float v0[8], v1[8]; unpack8(p[0], v0); unpack8(p[1], v1); float ss = 0.f;
#pragma unroll
        for (int j = 0; j < 8; ++j) ss += v0[j] * v0[j] + v1[j] * v1[j];
        ss += shx<1>(ss); ss += shx<2>(ss); ss += shx<4>(ss); ss += shx<8>(ss); ss += shx<16>(ss);
        const float rinv = 1.0f / sqrtf(ss * (1.0f / 512) + EPS);
#pragma unroll
        for (int j = 0; j < 8; ++j) { v0[j] *= rinv; v1[j] *= rinv; }
        p[0] = pack8f(v0); p[1] = pack8f(v1);
    }
}
__device__ __forceinline__ void tp_c(Frame& F) {
    float* RS = WSP(float, WS_RS); bf16* XB = WSP(bf16, WS_XB);
    for (int m = F.gw; m < NTOK; m += F.ngw) {
        const f32x4* xr = (const f32x4*)(F.out + (size_t)m * D) + F.lane; f32x4 v[4]; float s = 0.f;
#pragma unroll
        for (int j = 0; j < 4; ++j) { v[j] = xr[64 * j]; s += (v[j].x * v[j].x + v[j].y * v[j].y) + (v[j].z * v[j].z + v[j].w * v[j].w); }
        s = wave_sum(s); if (F.lane == 0) RS[m * 4 + 3] = 1.0f / sqrtf(s * (1.0f / D) + EPS);
        u32x2* o8 = (u32x2*)(XB + (size_t)m * D) + F.lane;
#pragma unroll
        for (int j = 0; j < 4; ++j) { u32x2 w; w.x = cvtpk(v[j].x, v[j].y); w.y = cvtpk(v[j].z, v[j].w); o8[64 * j] = w; }
    }
}

__device__ __forceinline__ int crow(int r, int hi) { return (r & 3) + 8 * (r >> 2) + 4 * hi; }
typedef short v4i16_t __attribute__((ext_vector_type(4)));
__device__ __forceinline__ s16x4 vtr(const LAS char* p) { return __builtin_bit_cast(s16x4, __builtin_amdgcn_ds_read_tr16_b64_v4i16((LAS v4i16_t*)p)); }

template <int ROWB> struct TileRegs { u32x4 r[(64 * ROWB / 16 + 511) / 512]; };
__device__ __forceinline__ const GAS char* uni_ptr(const char* p) { const unsigned long long v = (unsigned long long)p; const unsigned lo = __builtin_amdgcn_readfirstlane((unsigned)v), hi = __builtin_amdgcn_readfirstlane((unsigned)(v >> 32)); return (const GAS char*)(((unsigned long long)hi << 32) | lo); }
template <int ROWB> __device__ __forceinline__ void tile_load(TileRegs<ROWB>& T, const char* g_, int tid) {
    constexpr int NCH = 64 * ROWB / 16; const GAS char* g = uni_ptr(g_);
#pragma unroll
    for (int i = 0; i < (NCH + 511) / 512; ++i) { const int c = tid + 512 * i; const unsigned off = (unsigned)c * 16u; if (c < NCH) T.r[i] = *(const GAS u32x4*)(g + off); }
}
template <int ROWB, int STR> __device__ __forceinline__ void tile_store(const TileRegs<ROWB>& T, LAS char* l, int tid) {
    constexpr int NCH = 64 * ROWB / 16, CPR = ROWB / 16;
#pragma unroll
    for (int i = 0; i < (NCH + 511) / 512; ++i) { const int c = tid + 512 * i; if (c < NCH) *(LAS u32x4*)(l + (c / CPR) * STR + (c % CPR) * 16) = T.r[i]; }
}
template <int DK, int KSTR> __device__ __forceinline__ void qk_tile(f32x16& p0, f32x16& p1, const LAS char* Kt, const bf16x8* q, int lane, float cinit = 0.f) {
    const LAS char* kb = Kt + (lane & 31) * KSTR + (lane >> 5) * 16;
#pragma unroll
    for (int r = 0; r < 16; ++r) { p0[r] = cinit; p1[r] = cinit; }
#pragma unroll
    for (int s = 0; s < DK / 16; ++s) {
        const bf16x8 a0 = *(const LAS bf16x8*)(kb + s * 32), a1 = *(const LAS bf16x8*)(kb + 32 * KSTR + s * 32);
        p0 = __builtin_amdgcn_mfma_f32_32x32x16_bf16(a0, q[s], p0, 0, 0, 0);
        p1 = __builtin_amdgcn_mfma_f32_32x32x16_bf16(a1, q[s], p1, 0, 0, 0);
    }
    __builtin_amdgcn_sched_barrier(0);
}
__device__ __forceinline__ bf16x8 packp(const f32x16& p, int b) {
    u32x4 w; w.x = cvtpk(p[b], p[b + 1]); w.y = cvtpk(p[b + 2], p[b + 3]); w.z = cvtpk(p[b + 4], p[b + 5]); w.w = cvtpk(p[b + 6], p[b + 7]); return __builtin_bit_cast(bf16x8, w);
}
template <int VSTR> __device__ __forceinline__ void pv_tile(f32x16 (&o)[2], const LAS char* Vt, const f32x16& p0, const f32x16& p1, int lane) {
    const int i = lane & 15, g16 = lane >> 4, hi = g16 >> 1, dblk = (g16 & 1) * 16, q_ = i >> 2, p_ = i & 3;
    const LAS char* vb = Vt + (4 * hi + q_) * VSTR + (dblk + 4 * p_) * 2;
    __builtin_amdgcn_sched_barrier(0);
#pragma unroll
    for (int s = 0; s < 4; ++s) {
        const bf16x8 pa = packp(s < 2 ? p0 : p1, (s & 1) * 8);
#pragma unroll
        for (int d0 = 0; d0 < 2; ++d0) {
            const s16x4 lo = vtr(vb + (16 * s) * VSTR + d0 * 64), h8 = vtr(vb + (16 * s + 8) * VSTR + d0 * 64);
            const bf16x8 bv = {lo[0], lo[1], lo[2], lo[3], h8[0], h8[1], h8[2], h8[3]};
            o[d0] = __builtin_amdgcn_mfma_f32_32x32x16_bf16(pa, bv, o[d0], 0, 0, 0);
        }
        __builtin_amdgcn_sched_barrier(0);
    }
}
template <int DK, int KSTR> __device__ __forceinline__ void qk_half(f32x16& p, const LAS char* Kt, const bf16x8* q, int lane, float cinit, int hf) {
    const LAS char* kb = Kt + ((lane & 31) + 32 * hf) * KSTR + (lane >> 5) * 16;
#pragma unroll
    for (int r = 0; r < 16; ++r) p[r] = cinit;
#pragma unroll
    for (int s = 0; s < DK / 16; ++s) { const bf16x8 a = *(const LAS bf16x8*)(kb + s * 32); p = __builtin_amdgcn_mfma_f32_32x32x16_bf16(a, q[s], p, 0, 0, 0); }
    __builtin_amdgcn_sched_barrier(0);
}
template <int VSTR> __device__ __forceinline__ void pv_half(f32x16 (&o)[2], const LAS char* Vt, const f32x16& p, int lane, int hf) {
    const int i = lane & 15, g16 = lane >> 4, hi = g16 >> 1, dblk = (g16 & 1) * 16, q_ = i >> 2, p_ = i & 3;
    const LAS char* vb = Vt + (32 * hf + 4 * hi + q_) * VSTR + (dblk + 4 * p_) * 2;
    __builtin_amdgcn_sched_barrier(0);
#pragma unroll
    for (int s = 0; s < 2; ++s) {
        const bf16x8 pa = packp(p, s * 8);
#pragma unroll
        for (int d0 = 0; d0 < 2; ++d0) {
            const s16x4 lo = vtr(vb + (16 * s) * VSTR + d0 * 64), h8 = vtr(vb + (16 * s + 8) * VSTR + d0 * 64);
            const bf16x8 bv = {lo[0], lo[1], lo[2], lo[3], h8[0], h8[1], h8[2], h8[3]};
            o[d0] = __builtin_amdgcn_mfma_f32_32x32x16_bf16(pa, bv, o[d0], 0, 0, 0);
        }
        __builtin_amdgcn_sched_barrier(0);
    }
}
__device__ __forceinline__ float sum16(const f32x16& p) {
    const float a = (p[0] + p[1]) + (p[2] + p[3]), b = (p[4] + p[5]) + (p[6] + p[7]), c = (p[8] + p[9]) + (p[10] + p[11]), d = (p[12] + p[13]) + (p[14] + p[15]); return (a + b) + (c + d);
}
template <int DK, int KSTR> __device__ __forceinline__ void kf_load(bf16x8 (&kf)[DK / 16], const LAS char* Kt, int lane, int hf) {
    const LAS char* kb = Kt + ((lane & 31) + 32 * hf) * KSTR + (lane >> 5) * 16;
#pragma unroll
    for (int s = 0; s < DK / 16; ++s) kf[s] = *(const LAS bf16x8*)(kb + s * 32);
}
template <int VSTR> __device__ __forceinline__ void vf_load(bf16x8 (&vf)[2][2], const LAS char* Vt, int lane, int hf) {
    const int i = lane & 15, g16 = lane >> 4, hi = g16 >> 1, dblk = (g16 & 1) * 16, q_ = i >> 2, p_ = i & 3;
    const LAS char* vb = Vt + (32 * hf + 4 * hi + q_) * VSTR + (dblk + 4 * p_) * 2;
#pragma unroll
    for (int s = 0; s < 2; ++s)
#pragma unroll
        for (int d0 = 0; d0 < 2; ++d0) { const s16x4 lo = vtr(vb + (16 * s) * VSTR + d0 * 64), h8 = vtr(vb + (16 * s + 8) * VSTR + d0 * 64);
            vf[s][d0] = (bf16x8){lo[0], lo[1], lo[2], lo[3], h8[0], h8[1], h8[2], h8[3]}; }
}
template <int DK, int KSTR, int VSTR, class CI, class EF>
__device__ __forceinline__ void attn_tile(const LAS char* Kb, const LAS char* Vb, const bf16x8* q, f32x16 (&o)[2], int lane, CI cinit, EF elem, bool act0 = true, bool act1 = true) {
    bf16x8 kf[DK / 16];
    if (act0) kf_load<DK, KSTR>(kf, Kb, lane, 0); else if (act1) kf_load<DK, KSTR>(kf, Kb, lane, 1);
#pragma unroll
    for (int hf = 0; hf < 2; ++hf) {
        if (!(hf ? act1 : act0)) continue;
        f32x16 p; const float ci = cinit(hf);
#pragma unroll
        for (int r = 0; r < 16; ++r) p[r] = ci;
        __builtin_amdgcn_sched_barrier(0);
#pragma unroll
        for (int s = 0; s < DK / 16; ++s) p = __builtin_amdgcn_mfma_f32_32x32x16_bf16(kf[s], q[s], p, 0, 0, 0);
        __builtin_amdgcn_sched_barrier(0);
        bf16x8 vf[2][2]; vf_load<VSTR>(vf, Vb, lane, hf);
        if (hf == 0 && act1) kf_load<DK, KSTR>(kf, Kb, lane, 1);
        __builtin_amdgcn_sched_barrier(0);
        elem(p, hf);
        __builtin_amdgcn_sched_barrier(0);
#pragma unroll
        for (int s = 0; s < 2; ++s) { const bf16x8 pa = packp(p, s * 8);
#pragma unroll
            for (int d0 = 0; d0 < 2; ++d0) o[d0] = __builtin_amdgcn_mfma_f32_32x32x16_bf16(pa, vf[s][d0], o[d0], 0, 0, 0); }
        __builtin_amdgcn_sched_barrier(0);
    }
}
constexpr int BCAST_OFF = LDSX_OFF + 4096;
__device__ __forceinline__ void bcast_rows(float v, LAS unsigned char* lds, int wave, int lane, float (&out)[16]) {
    LAS float* wsf = (LAS float*)(lds + BCAST_OFF) + wave * 32;
    wsf[lane & 31] = v;
    LDS_WAIT(); asm volatile("" ::: "memory");
    const LAS float* rp = wsf + 4 * (lane >> 5);
#pragma unroll
    for (int r = 0; r < 16; ++r) out[r] = rp[(r & 3) + 8 * (r >> 2)];
    LDS_WAIT(); asm volatile("" ::: "memory");
}
constexpr int KSTR64 = 144, KSTR96 = 208, VSTR64 = 192;

__device__ __forceinline__ void mla_unit(Frame& F, int bh, int qb) {
    const int lane = F.lane, hi = lane >> 5, w = F.wave;
    const int q0 = qb * 256, qpos = q0 + 32 * w + (lane & 31);
    const bf16* Qm = WSP(bf16, WS_QM) + ((size_t)bh * S + qpos) * 96;
    const char* Kg = (const char*)(WSP(bf16, WS_KM) + (size_t)bh * S * 96); const char* Vg = (const char*)(WSP(bf16, WS_VM) + (size_t)bh * S * 64);
    bf16x8 qf[6];
#pragma unroll
    for (int s = 0; s < 6; ++s) qf[s] = *(const bf16x8*)(Qm + 16 * s + 8 * hi);
    const float bound = WSP(float, WS_QBM)[(size_t)bh * S + qpos];
    LAS char* KT[2] = {(LAS char*)F.lds, (LAS char*)F.lds + 64 * KSTR96}; LAS char* VT[2] = {(LAS char*)F.lds + 2 * 64 * KSTR96, (LAS char*)F.lds + 2 * 64 * KSTR96 + 64 * VSTR64};
    f32x16 o[2]; float lsum = 0.f;
#pragma unroll
    for (int r = 0; r < 16; ++r) { o[0][r] = 0.f; o[1][r] = 0.f; }
    const int NT = (q0 + 256) / 64; const int wq0 = q0 + 32 * w;
    TileRegs<192> krA; TileRegs<128> vrA;
    auto mla_compute = [&](int t, const LAS char* Kb, const LAS char* Vb) {
        if (64 * t <= wq0 + 31) {
            const bool diag = (64 * t + 63 > wq0);
            if (diag) {
                attn_tile<96, KSTR96, VSTR64>(Kb, Vb, qf, o, lane, [&](int) { return -bound; },
                    [&](f32x16& p, int hf) {
                        const int dl = qpos - 64 * t - 32 * hf - 4 * hi;
#pragma unroll
                        for (int r = 0; r < 16; ++r) { float e = __builtin_amdgcn_exp2f(p[r]); if ((r & 3) + 8 * (r >> 2) > dl) e = 0.f; p[r] = e; }
                        lsum += sum16(p); },
                    true, 64 * t + 32 <= wq0 + 31);
            } else {
                attn_tile<96, KSTR96, VSTR64>(Kb, Vb, qf, o, lane, [&](int) { return -bound; },
                    [&](f32x16& p, int) {
#pragma unroll
                        for (int r = 0; r < 16; ++r) p[r] = __builtin_amdgcn_exp2f(p[r]);
                        lsum += sum16(p); });
            }
        } };
    __syncthreads();
    tile_load<192>(krA, Kg, F.tid); tile_load<128>(vrA, Vg, F.tid);
    tile_store<192, KSTR96>(krA, KT[0], F.tid); tile_store<128, VSTR64>(vrA, VT[0], F.tid);
    __syncthreads();
    for (int t = 0; t < NT; ++t) {
        if (t + 1 < NT) { tile_load<192>(krA, Kg + (size_t)(t + 1) * 64 * 192, F.tid); tile_load<128>(vrA, Vg + (size_t)(t + 1) * 64 * 128, F.tid); }
        mla_compute(t, KT[t & 1], VT[t & 1]);
        if (t + 1 < NT) { tile_store<192, KSTR96>(krA, KT[(t + 1) & 1], F.tid); tile_store<128, VSTR64>(vrA, VT[(t + 1) & 1], F.tid); }
        __syncthreads();
    }
    lsum = sum32x(lsum); const float linv = lsum > 0.f ? 1.0f / lsum : 0.f;
    bf16* Y = WSP(bf16, WS_Y); const int b = bh >> 3, h = bh & 7;
    float fr_[16]; bcast_rows(linv, F.lds, w, lane, fr_);
#pragma unroll
    for (int r = 0; r < 16; ++r) { const int row = crow(r, hi); const float f = fr_[r]; bf16* yp = Y + ((size_t)b * S + wq0 + row) * 1024 + h * 64 + (lane & 31);
        yp[0] = (bf16)(cvtpk(o[0][r] * f, 0.f) & 0xffff); yp[32] = (bf16)(cvtpk(o[1][r] * f, 0.f) & 0xffff); }
}

__device__ __forceinline__ void nsa_unit(Frame& F, int bg, int cur, bool build_tables) {
    const int lane = F.lane, hi = lane >> 5, w = F.wave, hp = w & 3, qs = w >> 2;
    const int b = bg >> 1, g = bg & 1, h = g * 4 + hp;
    const int q0 = 64 * cur, qi = 32 * qs + (lane & 31), qpos = q0 + qi;
    const float* CF = WSP(float, WS_CONST);
    constexpr int TBL = 712; constexpr float NEGB = -3.0e38f;
    LAS char* KT[2] = {(LAS char*)F.lds, (LAS char*)F.lds + 64 * KSTR64}; LAS char* VT[2] = {(LAS char*)F.lds + 2 * 64 * KSTR64, (LAS char*)F.lds + 2 * 64 * KSTR64 + 64 * VSTR64};
    LAS float* TW = (LAS float*)(F.lds + 43008);
    LAS float* TS = TW + 4 * TBL;
    LAS unsigned* MSK = (LAS unsigned*)(F.lds + 43008 + 2 * 4 * TBL * 4);
    LAS float* PL = (LAS float*)(F.lds + 66816);
    LAS float* IMP = (LAS float*)(F.lds + 66816 + 17408);
    LAS float* PARK = (LAS float*)(F.lds + 66816) + w * 2048 + lane;
    __syncthreads();
    if (build_tables)
    for (int i = F.tid; i < 4 * TBL; i += 512) { const int hh = i / TBL, x = i - hh * TBL, dist = 639 - x; const bool in = dist >= 0 && dist < 512;
        const float bv = CF[CF_BIAS2 + (in ? (int)CF[CF_LUT + dist] : 31) * 8 + g * 4 + hh];
        TW[i] = in ? bv : NEGB; TS[i] = dist < 0 ? NEGB : bv; }
    const float bias31 = CF[CF_BIAS2 + 31 * 8 + h];
    const size_t qrow = ((size_t)bg * S + qpos) * 4 + hp;
    bf16x8 qf[4];
    { const GAS char* qb = uni_ptr((const char*)(F.ws + WS_QN)); const unsigned qoff = (unsigned)qrow * 128u + 16u * hi;
#pragma unroll
      for (int s = 0; s < 4; ++s) qf[s] = *(const GAS bf16x8*)(qb + qoff + 32 * s); }
    const float bound = *(const GAS float*)(uni_ptr((const char*)(F.ws + WS_QBN)) + (unsigned)qrow * 4u);
    const float* GT = WSP(float, WS_GATE); const int gto = (b * S + qpos) * 24 + h * 3;
    const LAS float* tsl = TS + hp * TBL; const LAS float* twl = TW + hp * TBL;
    const float cfar = bias31 - bound;
    TileRegs<128> kr, vr;
    f32x16 ocmp[2];
    const int ncmp = 4 * cur + 3 < 511 ? 4 * cur + 3 : 511, nct = (ncmp + 63) / 64;
    const char* Kc = (const char*)(WSP(bf16, WS_KCMP) + (size_t)bg * 512 * 64); const char* Vc = (const char*)(WSP(bf16, WS_VCMP) + (size_t)bg * 512 * 64);
#define NSA_CMP_EXP(T_, HF_, P_, SCALE_) do { \
        if (q0 - (16 * (64 * (T_) + 63) + 31) >= 512) { \
            _Pragma("unroll") for (int r = 0; r < 16; ++r) P_[r] = __builtin_amdgcn_exp2f(P_[r]) * (SCALE_); \
        } else { \
            _Pragma("unroll") for (int r = 0; r < 16; ++r) { const int n = 64 * (T_) + 32 * (HF_) + crow(r, hi); const int dist = qpos - (16 * n + 31); \
                const float bs = dist < 512 ? tsl[639 - (dist < 0 ? 0 : dist)] - bias31 : 0.f; const float sv = P_[r] + bs; \
                P_[r] = dist >= 0 ? __builtin_amdgcn_exp2f(sv) * (SCALE_) : 0.f; \
                if ((r & 3) == 3) __builtin_amdgcn_sched_barrier(0); } \
        } } while (0)
    float lc = 0.f;
    __syncthreads();
    for (int t = 0; t < nct; ++t) {
        tile_load<128>(kr, Kc + (size_t)t * 8192, F.tid); tile_store<128, KSTR64>(kr, KT[0], F.tid); __syncthreads();
        { bf16x8 kf[4]; kf_load<64, KSTR64>(kf, KT[0], lane, 0);
#pragma unroll
          for (int hf = 0; hf < 2; ++hf) { f32x16 p;
#pragma unroll
            for (int r = 0; r < 16; ++r) p[r] = cfar;
#pragma unroll
            for (int s = 0; s < 4; ++s) p = __builtin_amdgcn_mfma_f32_32x32x16_bf16(kf[s], qf[s], p, 0, 0, 0);
            __builtin_amdgcn_sched_barrier(0);
            if (hf == 0) kf_load<64, KSTR64>(kf, KT[0], lane, 1);
            NSA_CMP_EXP(t, hf, p, 1.0f);
            lc += sum16(p); } }
        __syncthreads();
    }
    lc = sum32x(lc); const float lcinv = lc > 0.f ? 1.0f / lc : 0.f;
    {
        f32x16 o[2];
#pragma unroll
        for (int r = 0; r < 16; ++r) { o[0][r] = 0.f; o[1][r] = 0.f; }
        float carry = 0.f;
        for (int t = 0; t < nct; ++t) {
            tile_load<128>(kr, Kc + (size_t)t * 8192, F.tid); tile_load<128>(vr, Vc + (size_t)t * 8192, F.tid);
            tile_store<128, KSTR64>(kr, KT[0], F.tid); tile_store<128, VSTR64>(vr, VT[0], F.tid); __syncthreads();
            float yprev = carry; f32x16 ph[2];
            bf16x8 kf[4]; kf_load<64, KSTR64>(kf, KT[0], lane, 0);
#pragma unroll
            for (int hf = 0; hf < 2; ++hf) {
#pragma unroll
                for (int r = 0; r < 16; ++r) ph[hf][r] = cfar;
#pragma unroll
                for (int s = 0; s < 4; ++s) ph[hf] = __builtin_amdgcn_mfma_f32_32x32x16_bf16(kf[s], qf[s], ph[hf], 0, 0, 0);
                __builtin_amdgcn_sched_barrier(0);
                if (hf == 0) kf_load<64, KSTR64>(kf, KT[0], lane, 1);
                NSA_CMP_EXP(t, hf, ph[hf], lcinv);
#pragma unroll
                for (int gi = 0; gi < 4; ++gi) { const f32x16& P = ph[hf]; const float x = P[4 * gi + 3]; const float y = shx<32>(x);
                    const float prev = hi ? y : yprev; PL[(hp * 64 + qi) * 17 + 8 * hf + 2 * gi + hi] = (P[4 * gi] + P[4 * gi + 1]) + (P[4 * gi + 2] + x) + prev; yprev = y; } }
            carry = yprev;
            __syncthreads();
#pragma unroll
            for (int q2 = 0; q2 < 2; ++q2) { const int idx = F.tid + 512 * q2, qq = idx >> 4, jl = idx & 15;
                IMP[qq * 128 + 16 * t + jl] = (PL[(0 * 64 + qq) * 17 + jl] + PL[(1 * 64 + qq) * 17 + jl]) + (PL[(2 * 64 + qq) * 17 + jl] + PL[(3 * 64 + qq) * 17 + jl]); }
#pragma unroll
            for (int hf = 0; hf < 2; ++hf) { bf16x8 vf[2][2]; vf_load<VSTR64>(vf, VT[0], lane, hf);
#pragma unroll
                for (int s = 0; s < 2; ++s) { const bf16x8 pa = packp(ph[hf], s * 8);
#pragma unroll
                    for (int d0 = 0; d0 < 2; ++d0) o[d0] = __builtin_amdgcn_mfma_f32_32x32x16_bf16(pa, vf[s][d0], o[d0], 0, 0, 0); } }
            __syncthreads();
        }
        const float g0 = GT[gto];
        float fr_[16]; bcast_rows(g0, F.lds, w, lane, fr_);
#pragma unroll
        for (int r = 0; r < 16; ++r) { const float f = fr_[r]; ocmp[0][r] = o[0][r] * f; ocmp[1][r] = o[1][r] * f; }
    }
#undef NSA_CMP_EXP
    {
        for (int i8 = 0; i8 < 8; i8 += 4) {
            unsigned long long mlo[4], mhi[4];
            if (cur < 16) {
#pragma unroll
                for (int k = 0; k < 4; ++k) { mlo[k] = (1ull << (cur + 1)) - 1ull; mhi[k] = 0ull; }
            } else {
                const int ja = lane, jb = lane + 64; const bool va = ja >= 1 && ja <= cur - 2, vb = jb <= cur - 2;
                unsigned ua[4], ub[4], thr[4];
#pragma unroll
                for (int k = 0; k < 4; ++k) { const int q = w * 8 + i8 + k; ua[k] = __float_as_uint(IMP[q * 128 + lane]); ub[k] = __float_as_uint(IMP[q * 128 + 64 + lane]); thr[k] = 0u; }
                for (int bit = 30; bit >= 0; --bit) {
#pragma unroll
                    for (int k = 0; k < 4; ++k) { const unsigned trial = thr[k] | (1u << bit);
                        const int cnt = __popcll(__ballot(va && ua[k] >= trial)) + __popcll(__ballot(vb && ub[k] >= trial)); if (cnt >= 13) thr[k] = trial; } }
#pragma unroll
                for (int k = 0; k < 4; ++k) {
                    const bool ga = va && ua[k] > thr[k], gb = vb && ub[k] > thr[k], ea = va && ua[k] == thr[k], eb = vb && ub[k] == thr[k];
                    const int need = 13 - (__popcll(__ballot(ga)) + __popcll(__ballot(gb)));
                    const unsigned long long ma = __ballot(ea), mb = __ballot(eb);
                    const int ra = (int)__builtin_amdgcn_mbcnt_hi((unsigned)(ma >> 32), __builtin_amdgcn_mbcnt_lo((unsigned)ma, 0u));
                    const int rb = __popcll(ma) + (int)__builtin_amdgcn_mbcnt_hi((unsigned)(mb >> 32), __builtin_amdgcn_mbcnt_lo((unsigned)mb, 0u));
                    const bool sa = ga || (ea && ra < need) || ja == 0 || ja == cur || ja == cur - 1;
                    const bool sb = gb || (eb && rb < need) || jb == cur || jb == cur - 1;
                    mlo[k] = __ballot(sa); mhi[k] = __ballot(sb); }
            }
            if (lane == 0) {
#pragma unroll
                for (int k = 0; k < 4; ++k) { const int q = w * 8 + i8 + k; MSK[q * 4 + 0] = (unsigned)mlo[k]; MSK[q * 4 + 1] = (unsigned)(mlo[k] >> 32); MSK[q * 4 + 2] = (unsigned)mhi[k]; MSK[q * 4 + 3] = (unsigned)(mhi[k] >> 32); } }
        }
        __syncthreads();
    }
#pragma unroll
    for (int r = 0; r < 16; ++r) { PARK[r * 64] = ocmp[0][r]; PARK[(16 + r) * 64] = ocmp[1][r]; }
    {
        const char* Kg = (const char*)(WSP(bf16, WS_KS) + (size_t)bg * S * 64); const char* Vg = (const char*)(WSP(bf16, WS_VS) + (size_t)bg * S * 64);
        f32x16 o[2]; float ls = 0.f;
#pragma unroll
        for (int r = 0; r < 16; ++r) { o[0][r] = 0.f; o[1][r] = 0.f; }
        const int NT = cur + 1;
        auto slc_compute = [&](int j, const LAS char* Kb, const LAS char* Vb) {
            const unsigned mw = MSK[qi * 4 + (j >> 5)]; const bool sel = (mw >> (j & 31)) & 1u;
            if (__ballot(sel) != 0ull) {
                if (cur - j >= 9) {
                    const float ci = sel ? cfar : NEGB;
                    attn_tile<64, KSTR64, VSTR64>(Kb, Vb, qf, o, lane, [&](int) { return ci; },
                        [&](f32x16& p, int) {
#pragma unroll
                            for (int r = 0; r < 16; ++r) p[r] = __builtin_amdgcn_exp2f(p[r]);
                            ls += sum16(p); });
                } else {
                    const float ci = sel ? -bound : NEGB;
                    const LAS float* tp = tsl + (639 - (qpos - 64 * j - 4 * hi));
                    attn_tile<64, KSTR64, VSTR64>(Kb, Vb, qf, o, lane, [&](int) { return ci; },
                        [&](f32x16& p, int hf) {
#pragma unroll
                            for (int r = 0; r < 16; ++r) { const int c = (r & 3) + 8 * (r >> 2) + 32 * hf; p[r] = __builtin_amdgcn_exp2f(p[r] + tp[c]); }
                            ls += sum16(p); });
                }
            } };
        TileRegs<128> krB, vrB;
        tile_load<128>(kr, Kg, F.tid); tile_load<128>(vr, Vg, F.tid);
        if (NT > 1) { tile_load<128>(krB, Kg + (size_t)8192, F.tid); tile_load<128>(vrB, Vg + (size_t)8192, F.tid); }
        tile_store<128, KSTR64>(kr, KT[0], F.tid); tile_store<128, VSTR64>(vr, VT[0], F.tid);
        __syncthreads();
        for (int j = 0; j < NT; j += 2) {
            if (j + 2 < NT) { tile_load<128>(kr, Kg + (size_t)(j + 2) * 8192, F.tid); tile_load<128>(vr, Vg + (size_t)(j + 2) * 8192, F.tid); }
            slc_compute(j, KT[0], VT[0]);
            if (j + 1 < NT) { tile_store<128, KSTR64>(krB, KT[1], F.tid); tile_store<128, VSTR64>(vrB, VT[1], F.tid); }
            __syncthreads();
            if (j + 1 >= NT) break;
            if (j + 3 < NT) { tile_load<128>(krB, Kg + (size_t)(j + 3) * 8192, F.tid); tile_load<128>(vrB, Vg + (size_t)(j + 3) * 8192, F.tid); }
            slc_compute(j + 1, KT[1], VT[1]);
            if (j + 2 < NT) { tile_store<128, KSTR64>(kr, KT[0], F.tid); tile_store<128, VSTR64>(vr, VT[0], F.tid); }
            __syncthreads();
        }
        ls = sum32x(ls); const float fs = ls > 0.f ? GT[gto + 1] / ls : 0.f;
        float fr_[16]; bcast_rows(fs, F.lds, w, lane, fr_);
#pragma unroll
        for (int r = 0; r < 16; ++r) { const float f = fr_[r]; PARK[r * 64] += o[0][r] * f; PARK[(16 + r) * 64] += o[1][r] * f; }
    }
    {
        const char* Kg = (const char*)(WSP(bf16, WS_KW) + (size_t)bg * S * 64); const char* Vg = (const char*)(WSP(bf16, WS_VW) + (size_t)bg * S * 64);
        f32x16 o[2]; float ls = 0.f;
#pragma unroll
        for (int r = 0; r < 16; ++r) { o[0][r] = 0.f; o[1][r] = 0.f; }
        const int j0 = cur >= 8 ? cur - 8 : 0;
        tile_load<128>(kr, Kg + (size_t)j0 * 8192, F.tid); tile_load<128>(vr, Vg + (size_t)j0 * 8192, F.tid);
        tile_store<128, KSTR64>(kr, KT[0], F.tid); tile_store<128, VSTR64>(vr, VT[0], F.tid);
        __syncthreads();
        for (int j = j0; j <= cur; ++j) { const int bi = (j - j0) & 1;
            if (j < cur) { tile_load<128>(kr, Kg + (size_t)(j + 1) * 8192, F.tid); tile_load<128>(vr, Vg + (size_t)(j + 1) * 8192, F.tid); }
            const LAS float* tp = twl + (639 - (qpos - 64 * j - 4 * hi));
            attn_tile<64, KSTR64, VSTR64>(KT[bi], VT[bi], qf, o, lane, [&](int) { return -bound; },
                [&](f32x16& p, int hf) {
#pragma unroll
                    for (int r = 0; r < 16; ++r) { const int c = (r & 3) + 8 * (r >> 2) + 32 * hf; p[r] = __builtin_amdgcn_exp2f(p[r] + tp[c]); }
                    ls += sum16(p); });
            if (j < cur) { tile_store<128, KSTR64>(kr, KT[bi ^ 1], F.tid); tile_store<128, VSTR64>(vr, VT[bi ^ 1], F.tid); }
            __syncthreads();
        }
        ls = sum32x(ls); const float fs = ls > 0.f ? GT[gto + 2] / ls : 0.f;
        float fr_[16]; bcast_rows(fs, F.lds, w, lane, fr_);
#pragma unroll
        for (int r = 0; r < 16; ++r) { const float f = fr_[r]; PARK[r * 64] += o[0][r] * f; PARK[(16 + r) * 64] += o[1][r] * f; }
    }
    bf16* Y = WSP(bf16, WS_Y);
#pragma unroll
    for (int r = 0; r < 16; ++r) { const int row = crow(r, hi); bf16* yp = Y + ((size_t)b * S + q0 + 32 * qs + row) * 1024 + 512 + h * 64 + (lane & 31);
        yp[0] = (bf16)(cvtpk(PARK[r * 64], 0.f) & 0xffff); yp[32] = (bf16)(cvtpk(PARK[(16 + r) * 64], 0.f) & 0xffff); }
}

__device__ __forceinline__ void mem_unit(Frame& F, int bh, int qb) {
    const int lane = F.lane, hi = lane >> 5, w = F.wave; const int b = bh >> 2, hm = bh & 3;
    const int tok = b * S + qb * 256 + 32 * w + (lane & 31);
    const float* CF = WSP(float, WS_CONST);
    const bf16* qp = WSP(bf16, WS_QMEM) + (size_t)tok * 256 + hm * 64; float qv[4][8]; float ss = 0.f;
#pragma unroll
    for (int s = 0; s < 4; ++s) { unpack8(*(const u32x4*)(qp + 16 * s + 8 * hi), qv[s]);
#pragma unroll
        for (int j = 0; j < 8; ++j) ss += qv[s][j] * qv[s][j]; }
    ss = sum32x(ss); const float rinv = 1.0f / sqrtf(ss * (1.0f / 64) + EPS) * (0.125f * LOG2E); float n2 = 0.f;
    bf16x8 qf[4];
#pragma unroll
    for (int s = 0; s < 4; ++s) {
#pragma unroll
        for (int j = 0; j < 8; ++j) { qv[s][j] *= rinv * F.in[26][16 * s + 8 * hi + j]; n2 += qv[s][j] * qv[s][j]; }
        qf[s] = __builtin_bit_cast(bf16x8, pack8f(qv[s])); }
    n2 = sum32x(n2); const float bound = sqrtf(n2) * CF[CF_KBMEM];
    LAS char* KT = (LAS char*)F.lds; LAS char* VT = (LAS char*)F.lds + 64 * KSTR64;
    const GAS char* Kg = uni_ptr((const char*)(WSP(bf16, WS_KVMR) + (size_t)b * 256 * 512 + hm * 64)); const GAS char* Vg = Kg + 512;
    const int trow = F.tid >> 3, tch = F.tid & 7; float gmk[8];
#pragma unroll
    for (int j = 0; j < 8; ++j) gmk[j] = F.in[27][8 * tch + j];
    f32x16 o[2]; float ls = 0.f;
#pragma unroll
    for (int r = 0; r < 16; ++r) { o[0][r] = 0.f; o[1][r] = 0.f; }
    TileRegs<128> kr, vr;
    for (int t = 0; t < 4; ++t) {
        __syncthreads();
        { const unsigned goff = (unsigned)(64 * t + trow) * 1024u + 16u * tch;
          kr.r[0] = *(const GAS u32x4*)(Kg + goff); vr.r[0] = *(const GAS u32x4*)(Vg + goff);
          float kv8[8]; unpack8(kr.r[0], kv8); float ssk = 0.f;
#pragma unroll
          for (int j = 0; j < 8; ++j) ssk += kv8[j] * kv8[j];
          ssk = grp8_sum(ssk); const float rk = 1.0f / sqrtf(ssk * (1.0f / 64) + EPS);
#pragma unroll
          for (int j = 0; j < 8; ++j) kv8[j] *= rk * gmk[j];
          kr.r[0] = pack8f(kv8); }
        tile_store<128, KSTR64>(kr, KT, F.tid); tile_store<128, VSTR64>(vr, VT, F.tid);
        __syncthreads();
        attn_tile<64, KSTR64, VSTR64>(KT, VT, qf, o, lane, [&](int) { return -bound; },
            [&](f32x16& p, int) {
#pragma unroll
                for (int r = 0; r < 16; ++r) p[r] = __builtin_amdgcn_exp2f(p[r]);
                ls += sum16(p); });
    }
    ls = sum32x(ls); const float linv = 1.0f / ls;
    bf16* O = WSP(bf16, WS_OMEM);
    float fr_[16]; bcast_rows(linv, F.lds, w, lane, fr_);
#pragma unroll
    for (int r = 0; r < 16; ++r) { const int row = crow(r, hi); const float f = fr_[r]; bf16* yp = O + ((size_t)b * S + qb * 256 + 32 * w + row) * 256 + hm * 64 + (lane & 31);
        yp[0] = (bf16)(cvtpk(o[0][r] * f, 0.f) & 0xffff); yp[32] = (bf16)(cvtpk(o[1][r] * f, 0.f) & 0xffff); }
}

__device__ __forceinline__ void tp_d(Frame& F) {
    LAS float* WT = (LAS float*)F.lds;
    LAS float* LG = (LAS float*)(F.lds + LDSX_OFF);
    LAS unsigned* lcnt = (LAS unsigned*)(F.lds + LDSX_OFF + 64 * 33 * 4);
    LAS unsigned* lbase = lcnt + 32;
    const float* rw = F.in[30]; const float* gm = F.in[29]; const float* rb = F.in[31];
    __syncthreads();
    for (int i = F.tid; i < 32768; i += 512) { const int k = i >> 5, e = i & 31; WT[e * 1028 + k] = rw[i] * gm[k]; }
    float* RS = WSP(float, WS_RS); bf16* XB = WSP(bf16, WS_XB); unsigned* cnt = (unsigned*)(F.ws + WS_CTL) + CW_CNT;
    int* ASG = WSP(int, WS_ASG);
    const int l = F.lane;
    for (int m0 = F.bid * 64; m0 < NTOK; m0 += F.G * 64) {
        if (F.tid < 32) lcnt[F.tid] = 0u;
        __syncthreads();
        for (int ti = 0; ti < 8; ++ti) { const int tl = F.wave * 8 + ti, m = m0 + tl;
            const u32x2* xr = (const u32x2*)(XB + (size_t)m * D) + l; f32x4 v[4]; float s = 0.f;
#pragma unroll
            for (int j = 0; j < 4; ++j) { const u32x2 w = xr[64 * j]; v[j] = (f32x4){bf2f(w.x & 0xffff), bf2f(w.x >> 16), bf2f(w.y & 0xffff), bf2f(w.y >> 16)}; s += (v[j].x * v[j].x + v[j].y * v[j].y) + (v[j].z * v[j].z + v[j].w * v[j].w); }
            s = wave_sum(s); const float rinv = 1.0f / sqrtf(s * (1.0f / D) + EPS);
            u32x2* o8 = (u32x2*)(WSP(bf16, WS_Y) + (size_t)m * D) + l;
#pragma unroll
            for (int j = 0; j < 4; ++j) { u32x2 w; w.x = cvtpk(v[j].x * rinv, v[j].y * rinv); w.y = cvtpk(v[j].z * rinv, v[j].w * rinv); o8[64 * j] = w; }
            float p[32];
#pragma unroll
            for (int e = 0; e < 32; ++e) { float a = 0.f;
#pragma unroll
                for (int j = 0; j < 4; ++j) { const f32x4 wv = *(const LAS f32x4*)(WT + e * 1028 + 256 * j + 4 * l); a += (v[j].x * wv.x + v[j].y * wv.y) + (v[j].z * wv.z + v[j].w * wv.w); }
                p[e] = a; }
#pragma unroll
            for (int e = 0; e < 16; ++e) { const bool up = (l & 32) != 0; const float keep = up ? p[e + 16] : p[e], send = up ? p[e] : p[e + 16]; p[e] = keep + shx<32>(send); }
#pragma unroll
            for (int e = 0; e < 8; ++e) { const bool up = (l & 16) != 0; const float keep = up ? p[e + 8] : p[e], send = up ? p[e] : p[e + 8]; p[e] = keep + shx<16>(send); }
#pragma unroll
            for (int e = 0; e < 4; ++e) { const bool up = (l & 8) != 0; const float keep = up ? p[e + 4] : p[e], send = up ? p[e] : p[e + 4]; p[e] = keep + shx<8>(send); }
#pragma unroll
            for (int e = 0; e < 2; ++e) { const bool up = (l & 4) != 0; const float keep = up ? p[e + 2] : p[e], send = up ? p[e] : p[e + 2]; p[e] = keep + shx<4>(send); }
            { const bool up = (l & 2) != 0; const float keep = up ? p[1] : p[0], send = up ? p[0] : p[1]; p[0] = keep + shx<2>(send); }
            p[0] += shx<1>(p[0]);
            const int e = ((l >> 5) & 1) * 16 + ((l >> 4) & 1) * 8 + ((l >> 3) & 1) * 4 + ((l >> 2) & 1) * 2 + ((l >> 1) & 1);
            if ((l & 1) == 0) LG[tl * 33 + e] = p[0] * rinv + rb[e];
        }
        __syncthreads();
        if (F.wave == 0) {
            const int m = m0 + l; float lg[32];
#pragma unroll
            for (int e = 0; e < 32; ++e) lg[e] = LG[l * 33 + e];
            int idx[4]; float val[4];
#pragma unroll
            for (int k = 0; k < 4; ++k) { float bv = -3.0e38f; int bi = 0;
#pragma unroll
                for (int e = 0; e < 32; ++e) { const bool taken = (k > 0 && idx[0] == e) || (k > 1 && idx[1] == e) || (k > 2 && idx[2] == e); if (!taken && lg[e] > bv) { bv = lg[e]; bi = e; } }
                idx[k] = bi; val[k] = bv; }
            const float e1 = __expf(val[1] - val[0]), e2 = __expf(val[2] - val[0]), e3 = __expf(val[3] - val[0]); const float inv = 1.0f / (1.0f + e1 + e2 + e3);
            const float ge[4] = {inv, e1 * inv, e2 * inv, e3 * inv};
            unsigned lp[4];
#pragma unroll
            for (int k = 0; k < 4; ++k) lp[k] = atomicAdd((unsigned*)&lcnt[idx[k]], 1u);
            LDS_WAIT(); asm volatile("" ::: "memory");
            if (l < 32) { const unsigned c = lcnt[l]; lbase[l] = c ? atomicAdd(&cnt[l], c) : 0u; }
            LDS_WAIT(); asm volatile("" ::: "memory");
#pragma unroll
            for (int k = 0; k < 4; ++k) { ASG[(m * 4 + k) * 2 + 0] = idx[k] | ((int)(lbase[idx[k]] + lp[k]) << 8); ASG[(m * 4 + k) * 2 + 1] = __float_as_int(ge[k]); }
        }
        __syncthreads();
    }
}
__device__ __forceinline__ void moe_tables(Frame& F, LAS int* mt, LAS int* ro) {
    __syncthreads();
    if (F.tid == 0) { unsigned* cnt = (unsigned*)(F.ws + WS_CTL) + CW_CNT; int acc = 0;
        for (int e = 0; e < 32; ++e) { const int c = (int)__hip_atomic_load(cnt + e, __ATOMIC_RELAXED, __HIP_MEMORY_SCOPE_AGENT); const int t = (c + 255) >> 8; mt[e] = t; ro[e] = acc; acc += t * 256; } }
    __syncthreads();
}
__device__ __forceinline__ void moe_gather(Frame& F) {
    LAS int* mt = (LAS int*)(F.lds + LDSX_OFF + 1024); LAS int* ro = mt + 32;
    moe_tables(F, mt, ro);
    const int* ASG = WSP(int, WS_ASG); const bf16* XB = WSP(bf16, WS_Y); bf16* A1 = WSP(bf16, WS_A1);
    for (int m = F.gw; m < NTOK; m += F.ngw) {
        const u32x4* src = (const u32x4*)(XB + (size_t)m * D) + F.lane; const u32x4 a = src[0], b = src[64];
#pragma unroll
        for (int k = 0; k < 4; ++k) { const int pe = ASG[(m * 4 + k) * 2]; const int e = pe & 255, pos = pe >> 8; const size_t row = (size_t)ro[e] + pos;
            u32x4* dst = (u32x4*)(A1 + row * D) + F.lane; dst[0] = a; dst[64] = b; }
    }
}
__device__ __forceinline__ void moe_combine(Frame& F) {
    LAS int* mt = (LAS int*)(F.lds + LDSX_OFF + 1024); LAS int* ro = mt + 32;
    moe_tables(F, mt, ro);
    const int* ASG = WSP(int, WS_ASG); const bf16* Yb = WSP(bf16, WS_A1);
    for (int m = F.gw; m < NTOK; m += F.ngw) {
        f32x4* op = (f32x4*)(F.out + (size_t)m * D) + 4 * F.lane; f32x4 o[4];
        { const u32x4* xp = (const u32x4*)(WSP(bf16, WS_XB) + (size_t)m * D + 16 * F.lane); float x0[8], x1[8]; unpack8(xp[0], x0); unpack8(xp[1], x1);
          o[0] = (f32x4){x0[0], x0[1], x0[2], x0[3]}; o[1] = (f32x4){x0[4], x0[5], x0[6], x0[7]}; o[2] = (f32x4){x1[0], x1[1], x1[2], x1[3]}; o[3] = (f32x4){x1[4], x1[5], x1[6], x1[7]}; }
#pragma unroll
        for (int k = 0; k < 4; ++k) { const int pe = ASG[(m * 4 + k) * 2]; const float gw = __int_as_float(ASG[(m * 4 + k) * 2 + 1]); const int e = pe & 255, pos = pe >> 8; const size_t row = (size_t)ro[e] + pos;
            const u32x4* yp = (const u32x4*)(Yb + row * D + 16 * F.lane); float y0[8], y1[8]; unpack8(yp[0], y0); unpack8(yp[1], y1);
            o[0] += gw * (f32x4){y0[0], y0[1], y0[2], y0[3]}; o[1] += gw * (f32x4){y0[4], y0[5], y0[6], y0[7]};
            o[2] += gw * (f32x4){y1[0], y1[1], y1[2], y1[3]}; o[3] += gw * (f32x4){y1[4], y1[5], y1[6], y1[7]}; }
#pragma unroll
        for (int j = 0; j < 4; ++j) op[j] = o[j];
    }
}

#ifndef LB
#define LB 512
#endif
__global__ void __launch_bounds__(LB) fwd_kernel(Args args) {
    extern __shared__ __attribute__((aligned(16))) unsigned char lds_raw[];
    Frame F;
    F.lds = (LAS unsigned char*)lds_raw; F.tid = threadIdx.x; F.lane = F.tid & 63; F.wave = __builtin_amdgcn_readfirstlane(F.tid >> 6);
    F.G = gridDim.x; F.bid = blockIdx.x; F.gw = F.bid * 8 + F.wave; F.ngw = F.G * 8;
    F.in = args.in; F.out = args.out; F.ws = args.ws;
    for (int u = F.tid; u < 128; u += 512) ((LAS unsigned*)(F.lds + LDSCTL_OFF))[u] = 0u;
    __syncthreads();
    unsigned* ctl = (unsigned*)(F.ws + WS_CTL);
    XcdBarrier bar = xcd_barrier_post(ctl + CW_BAR, (volatile LAS unsigned*)(F.lds + LDSCTL_OFF) + 8);
#ifndef PHM
#define PHM 0xFFFFFFFFu
#endif
#define RELAUNDER() do { int t_ = F.wave * 64 + (int)lane_id_opaque(); F.tid = t_; F.lane = t_ & 63; } while (0)
#define PH(n) RELAUNDER(); if (PHM & (1u << (n)))
#ifndef PRB_A
#define PRB_A -1
#endif
#ifndef PRB_B
#define PRB_B -1
#endif
    volatile LAS unsigned long long* TS = (volatile LAS unsigned long long*)(F.lds + LDSCTL_OFF + 128);
#define STAMP(k) do { if (PRB_A >= 0 && blockIdx.x == 0 && F.tid == 0) TS[k] = __builtin_amdgcn_s_memrealtime(); } while (0)
#define GRID_BAR() do { RELAUNDER(); xcd_barrier(bar, F.tid == 0); } while (0)
    float* RS = WSP(float, WS_RS);
    STAMP(0); PH(0) { FSTAMP(F, 30); FSTAMP(F, 31); PH(21) p0_prologue(F); FSTAMP(F, 34); } GRID_BAR(); STAMP(1); FSTAMP(F, 35);
#ifdef DUMMY_STREAM
    STAMP(30);
    { f32x4 acc4 = {0.f, 0.f, 0.f, 0.f}; const f32x4* p1 = (const f32x4*)F.in[32]; const f32x4* p2 = (const f32x4*)F.in[34];
      const size_t n1 = (size_t)32 * 1024 * 2048 / 4, n2 = (size_t)32 * 1024 * 1024 / 4; const size_t gt = (size_t)F.bid * 512 + F.tid, gs_ = (size_t)F.G * 512;
      for (size_t i = gt; i < n1; i += 4 * gs_) { acc4 += p1[i]; if (i + gs_ < n1) acc4 += p1[i + gs_]; if (i + 2 * gs_ < n1) acc4 += p1[i + 2 * gs_]; if (i + 3 * gs_ < n1) acc4 += p1[i + 3 * gs_]; }
      for (size_t i = gt; i < n2; i += 4 * gs_) { acc4 += p2[i]; if (i + gs_ < n2) acc4 += p2[i + gs_]; if (i + 2 * gs_ < n2) acc4 += p2[i + 2 * gs_]; if (i + 3 * gs_ < n2) acc4 += p2[i + 3 * gs_]; }
      WSP(float, WS_CONST)[4096 + (F.bid * 512 + F.tid) % 2048] = acc4.x + acc4.y + acc4.z + acc4.w; }
    GRID_BAR(); STAMP(31);
#endif
    PH(1) { pg8::Gemm g{WSP(bf16, WS_XB), WSP(bf16, WS_WIN), 1024, 1024, 1024}; pg8::StaticOrder So; So.init(NTOK, NINP, F.G, F.bid);
      pg8::EpiScaleBf16 E{WSP(bf16, WS_PB), NINP, RS + 0, 4}; pg8::gemm_phase(F.lds, g, So, E, F.tid); }
    PH(1) if (F.bid >= F.G - 4) { pg8::Gemm g{WSP(bf16, WS_MEMB), WSP(bf16, WS_WMKVT), 1024, 1024, 1024}; pg8::StaticOrder So; So.init(512, 512, 4, F.bid - (F.G - 4));
      pg8::EpiScaleBf16 E{WSP(bf16, WS_KVMR), 512, WSP(float, WS_RSM), 1}; pg8::gemm_phase(F.lds, g, So, E, F.tid); }
    GRID_BAR(); STAMP(2);
    PH(3) { pg8::Gemm g{WSP(bf16, WS_PB) + C_CQ, WSP(bf16, WS_WUQ), NINP, 256, 256}; pg8::StaticOrder So; So.init(NTOK, 768, F.G, F.bid);
      pg8::EpiScaleBf16 E{WSP(bf16, WS_QRAW), 768, nullptr, 0}; pg8::gemm_phase(F.lds, g, So, E, F.tid); }
    PH(3) { pg8::Gemm g{WSP(bf16, WS_PB) + C_CKV, WSP(bf16, WS_WUKV), NINP, 256, 256}; pg8::StaticOrder So; So.init(NTOK, 1024, F.G, F.bid);
      pg8::EpiScaleBf16 E{WSP(bf16, WS_KVRAW), 1024, nullptr, 0}; pg8::gemm_phase(F.lds, g, So, E, F.tid); }
    STAMP(3);
    PH(2) tp_a(F); PH(17) compress_phase(F); GRID_BAR(); STAMP(4); STAMP(5);
    PH(4) tp_b(F); GRID_BAR(); STAMP(6);
    { const int vcu = (F.G % 8 == 0) ? (F.bid % 8) * (F.G / 8) + F.bid / 8 : F.bid;
      PH(5) for (int v = vcu; v < 256; v += F.G) { const int bh = v >> 4, sidx = v & 15; mla_unit(F, bh, 31 - sidx); mla_unit(F, bh, sidx); }
      STAMP(7);
      PH(18) for (int v = vcu; v < 256; v += F.G) { const int bg = v >> 6, sidx = v & 63; nsa_unit(F, bg, 127 - sidx, true); nsa_unit(F, bg, sidx, false); } }
    GRID_BAR(); STAMP(8);
    PH(6) tp_c0(F); GRID_BAR(); STAMP(9);
    PH(7) { pg8::Gemm g{WSP(bf16, WS_Y), WSP(bf16, WS_WOUT), 1024, 1024, 1024}; pg8::StaticOrder So; So.init(NTOK, 1024, F.G, F.bid);
      pg8::EpiAddBf16Ssq E{WSP(bf16, WS_XB), 1024, WSP(float, WS_KMEM)}; pg8::gemm_phase(F.lds, g, So, E, F.tid); }
    GRID_BAR(); STAMP(10); STAMP(11);
    PH(9) { pg8::Gemm g{WSP(bf16, WS_XB), WSP(bf16, WS_WMQ), 1024, 1024, 1024}; pg8::StaticOrder So; So.init(NTOK, 256, F.G, F.bid);
      pg8::EpiSsqScaleBf16 E{WSP(bf16, WS_QMEM), 256, WSP(float, WS_KMEM)}; pg8::gemm_phase(F.lds, g, So, E, F.tid); }
    GRID_BAR(); STAMP(12);
    PH(10) for (int v = F.bid; v < 256; v += F.G) mem_unit(F, v >> 5, v & 31);
    GRID_BAR(); STAMP(13);
    PH(11) { pg8::Gemm g{WSP(bf16, WS_OMEM), WSP(bf16, WS_WMO), 256, 256, 256}; pg8::StaticOrder So; So.init(NTOK, 1024, F.G, F.bid);
      pg8::EpiAddBf16 E{WSP(bf16, WS_XB), 1024}; pg8::gemm_phase(F.lds, g, So, E, F.tid); }
    GRID_BAR(); STAMP(14);
    PH(12) tp_d(F); GRID_BAR(); STAMP(15);
    PH(13) moe_gather(F); GRID_BAR(); STAMP(16);
    { LAS int* mt = (LAS int*)(F.lds + LDSX_OFF + 1024); LAS int* ro = mt + 32;
      pg8::MoeOrder Mo; Mo.xl = F.bid & 7; Mo.cl = F.bid >> 3; Mo.nl = F.G >> 3;
#pragma unroll
      for (int s = 0; s < 4; ++s) { Mo.mt[s] = mt[Mo.xl + 8 * s]; Mo.tp[s] = ro[Mo.xl + 8 * s] >> 8; }
      PH(14) { Mo.ntn = 8; pg8::Gemm g{WSP(bf16, WS_A1), WSP(bf16, WS_WGU), 1024, 1024, 1024}; pg8::EpiSwiglu E{WSP(bf16, WS_ACT), F.in[33]}; pg8::gemm_phase(F.lds, g, Mo, E, F.tid); }
      GRID_BAR(); STAMP(17);
      PH(15) { Mo.ntn = 4; pg8::Gemm g{WSP(bf16, WS_ACT), WSP(bf16, WS_WD), 1024, 1024, 1024}; pg8::EpiDown E{WSP(bf16, WS_A1), F.in[35]}; pg8::gemm_phase(F.lds, g, Mo, E, F.tid); }
      GRID_BAR(); STAMP(18); }
    PH(16) moe_combine(F);
    STAMP(19);
    if (PRB_A >= 0 && blockIdx.x == 0 && F.tid == 0) {
        const unsigned long long ta = TS[PRB_A + 1] - TS[PRB_A];
        unsigned long long extra = 8ull * ta;
        if (PRB_B >= 0) { const unsigned long long tb = TS[PRB_B + 1] - TS[PRB_B]; extra += ((tb + 500ull) / 1000ull) * 200000ull; }
        const unsigned long long t0 = __builtin_amdgcn_s_memrealtime();
        while (__builtin_amdgcn_s_memrealtime() - t0 < extra) __builtin_amdgcn_s_sleep(8);
    }
}

extern "C" void kernel_launch(void* const* d_in, const int* in_sizes, int n_in, void* d_out, int out_size, void* d_ws, size_t ws_size, hipStream_t stream) {
    static int grid = 0;
    if (grid == 0) {
        if (n_in != 36 || out_size != NTOK * D || ws_size < WS_END) { fprintf(stderr, "kernel_launch: unexpected shapes (n_in %d out %d ws %zu need %zu)\n", n_in, out_size, ws_size, (size_t)WS_END); grid = -1; return; }
        int dev = 0, cus = 0;
        if (hipGetDevice(&dev) != hipSuccess || hipDeviceGetAttribute(&cus, hipDeviceAttributeMultiprocessorCount, dev) != hipSuccess) { grid = -1; return; }
        if (hipFuncSetAttribute((const void*)fwd_kernel, hipFuncAttributeMaxDynamicSharedMemorySize, LDS_BYTES) != hipSuccess) { fprintf(stderr, "kernel_launch: hipFuncSetAttribute failed\n"); grid = -1; return; }
        (void)hipGetLastError();
        grid = cus >= 256 ? 256 : (cus / 8) * 8;
    }
    if (grid <= 0) return;
    (void)hipMemsetAsync((char*)d_ws + WS_CTL, 0, CTL_BYTES, stream);
    Args a{};
    for (int i = 0; i < 36; ++i) a.in[i] = (const float*)d_in[i];
    a.out = (float*)d_out; a.ws = (unsigned char*)d_ws;
    hipLaunchKernelGGL(fwd_kernel, dim3(grid), dim3(512), LDS_BYTES, stream, a);
}
```

```cpp
#include <hip/hip_runtime.h>
#include <cstdint>
#include <cstdio>

#define GAS __attribute__((address_space(1)))
#define LAS __attribute__((address_space(3)))
typedef unsigned short bf16;
typedef short bf16x8 __attribute__((ext_vector_type(8)));
typedef short s16x4 __attribute__((ext_vector_type(4)));
typedef float f32x4 __attribute__((ext_vector_type(4)));
typedef float f32x16 __attribute__((ext_vector_type(16)));
typedef unsigned u32x4 __attribute__((ext_vector_type(4)));
typedef unsigned u32x2 __attribute__((ext_vector_type(2)));
typedef float f32x2_t __attribute__((ext_vector_type(2)));
typedef __bf16 bf16x2_t __attribute__((ext_vector_type(2)));

constexpr int NB = 2, S = 8192, D = 1024, NTOK = NB * S;
constexpr int NINP = 1792;
constexpr int C_CQ = 0, C_CKV = 256, C_KR = 384, C_QN = 416, C_KC = 928, C_VC = 1056, C_KS = 1184, C_VS = 1312, C_KW = 1440, C_VW = 1568, C_GT = 1696;
constexpr float EPS = 1e-6f;
constexpr float LOG2E = 1.4426950408889634f;
constexpr int NEXP = 32, MROWS = 65536 + 32 * 256;

constexpr size_t MiB = 1u << 20;
constexpr size_t al256(size_t x) { return (x + 255) & ~(size_t)255; }
constexpr size_t WS_CTL = 0, CTL_BYTES = 1 * MiB;
constexpr size_t WS_CONST = 1 * MiB;
constexpr size_t WS_WIN = 2 * MiB;
constexpr size_t WS_WUQ = WS_WIN + al256((size_t)NINP * 1024 * 2);
constexpr size_t WS_WUKV = WS_WUQ + al256((size_t)768 * 256 * 2);
constexpr size_t WS_WOUT = WS_WUKV + al256((size_t)1024 * 256 * 2);
constexpr size_t WS_WMQ = WS_WOUT + al256((size_t)1024 * 1024 * 2);
constexpr size_t WS_WMO = WS_WMQ + al256((size_t)256 * 1024 * 2);
constexpr size_t WS_W1T = WS_WMO + al256((size_t)1024 * 256 * 2);
constexpr size_t WS_WMKVT = WS_W1T + al256((size_t)2 * 128 * 2048 * 2);
constexpr size_t WS_MEMB = WS_WMKVT + al256((size_t)512 * 1024 * 2);
constexpr size_t WS_KVMR = WS_MEMB + al256((size_t)512 * 1024 * 2);
constexpr size_t WS_RSM = WS_KVMR + al256((size_t)512 * 512 * 2);
constexpr size_t WS_WRH = WS_RSM + 4096;
constexpr size_t WS_WRL = WS_WRH + 65536;
static_assert(WS_WRL + 65536 <= 16 * MiB, "small-weight region");
constexpr size_t WS_WGU = 16 * MiB;
constexpr size_t WS_WD = WS_WGU + 128 * MiB;
constexpr size_t WS_XB = WS_WD + 64 * MiB;
constexpr size_t WS_PB = WS_XB + 32 * MiB;
constexpr size_t WS_QRAW = WS_PB + 56 * MiB;
constexpr size_t WS_KVRAW = WS_QRAW + 24 * MiB;
constexpr size_t WS_QM = WS_KVRAW + 32 * MiB;
constexpr size_t WS_KM = WS_QM + 24 * MiB;
constexpr size_t WS_VM = WS_KM + 24 * MiB;
constexpr size_t WS_QN = WS_VM + 16 * MiB;
constexpr size_t WS_KS = WS_QN + 16 * MiB;
constexpr size_t WS_VS = WS_KS + 4 * MiB;
constexpr size_t WS_KW = WS_VS + 4 * MiB;
constexpr size_t WS_VW = WS_KW + 4 * MiB;
constexpr size_t WS_KCMP = WS_VW + 4 * MiB;
constexpr size_t WS_VCMP = WS_KCMP + 1 * MiB;
constexpr size_t WS_KMEM = WS_VCMP + 1 * MiB;
constexpr size_t WS_VMEM = WS_KMEM + 1 * MiB;
constexpr size_t WS_QBM = WS_VMEM + 1 * MiB;
constexpr size_t WS_QBN = WS_QBM + 1 * MiB;
constexpr size_t WS_RS = WS_QBN + 1 * MiB;
constexpr size_t WS_GATE = WS_RS + 1 * MiB;
constexpr size_t WS_ASG = WS_GATE + 2 * MiB;
constexpr size_t WS_Y = WS_ASG + 1 * MiB;
constexpr size_t WS_QMEM = WS_Y + 32 * MiB;
constexpr size_t WS_OMEM = WS_QMEM + 8 * MiB;
constexpr size_t WS_A1 = WS_OMEM + 8 * MiB;
constexpr size_t WS_ACT = WS_A1 + 144 * MiB;
constexpr size_t WS_END = WS_ACT + 144 * MiB;
constexpr int CW_BAR = 4096;
constexpr int CW_CNT = 16384;
constexpr int CF_CPP = 4096;
constexpr int CF_KBM = 0, CF_KBN = 1, CF_KBMEM = 2, CF_MAXB2 = 8  , CF_BIAS2 = 64  , CF_LUT = 512  , CF_CPOSK = 1024  , CF_CPOSV = 1152  ;

constexpr int RING_BYTES = 131072;
constexpr int LDS_BYTES = 147456;
constexpr int LDSX_OFF = RING_BYTES + 1024;
constexpr int LDSCTL_OFF = LDS_BYTES - 1024;

__device__ __forceinline__ float bf2f(unsigned v) { return __uint_as_float(v << 16); }
__device__ __forceinline__ unsigned cvtpk(float lo, float hi) { f32x2_t v = {lo, hi}; bf16x2_t b = __builtin_convertvector(v, bf16x2_t); return __builtin_bit_cast(unsigned, b); }
__device__ __forceinline__ unsigned lane_id_opaque() { unsigned r; asm volatile("v_mbcnt_lo_u32_b32 %0, -1, 0\n\tv_mbcnt_hi_u32_b32 %0, -1, %0" : "=v"(r)); return r; }
template <int M> __device__ __forceinline__ float shx(float v) {
    if constexpr (M < 32) { return __int_as_float(__builtin_amdgcn_ds_swizzle(__float_as_int(v), (M << 10) | 0x1f)); }
    else { auto r = __builtin_amdgcn_permlane32_swap(__float_as_uint(v), __float_as_uint(v), false, false);
           const bool lo = lane_id_opaque() < 32u; return __uint_as_float(lo ? r[1] : r[0]); }
}
template <int M> __device__ __forceinline__ int shxi(int v) { return __float_as_int(shx<M>(__int_as_float(v))); }
__device__ __forceinline__ float sum32x(float v) { auto r = __builtin_amdgcn_permlane32_swap(__float_as_uint(v), __float_as_uint(v), false, false); return __uint_as_float(r[0]) + __uint_as_float(r[1]); }
__device__ __forceinline__ float wave_sum(float v) {
    v += shx<1>(v); v += shx<2>(v); v += shx<4>(v); v += shx<8>(v); v += shx<16>(v); return sum32x(v);
}
__device__ __forceinline__ float wave_max(float v) {
    v = fmaxf(v, shx<1>(v)); v = fmaxf(v, shx<2>(v)); v = fmaxf(v, shx<4>(v)); v = fmaxf(v, shx<8>(v)); v = fmaxf(v, shx<16>(v)); return fmaxf(v, shx<32>(v));
}
__device__ __forceinline__ float grp8_sum(float v) { v += shx<1>(v); v += shx<2>(v); v += shx<4>(v); return v; }
#define LDS_WAIT() asm volatile("s_waitcnt lgkmcnt(0)" ::: "memory")
#define VM_WAIT() asm volatile("s_waitcnt vmcnt(0)" ::: "memory")

namespace pg8 {
constexpr int BM = 256, BK = 64, HALF = 128, HTB = HALF * BK * 2, STAGE_BYTES = 8 * HTB, NXCD = 8, WGM = 8;
__host__ __device__ __forceinline__ int lds_byte(int r, int c) { const int st = (r >> 4) * 2 + (c >> 5), rr = r & 15, cc = c & 31, ob = rr * 64 + cc * 2; return st * 1024 + (ob ^ (((ob >> 9) & 1) << 5)); }
__host__ __device__ __forceinline__ void stage_rc(int b, int& R, int& C) { const int st = b / 1024, sb = b % 1024, swz = sb ^ (((sb >> 9) & 1) << 5); R = (st >> 1) * 16 + swz / 64; C = (st & 1) * 32 + (swz % 64) / 2; }
__host__ __device__ __forceinline__ int perm32(int rho) { const int n = rho >> 4, i = rho & 15; return 8 * (i >> 2) + 4 * n + (i & 3); }
struct Unit { int pm, pn, aux; };
struct Gemm { const bf16* A; const bf16* Bt; int lda, ldb, K; };
struct StaticOrder {
    int nM, nN, nwg, G, c;
    __device__ void init(int M, int N, int G_, int c_) { nM = M / BM; nN = N / BM; nwg = nM * nN; G = G_; c = c_; }
    __device__ bool next(int i, Unit& u) const {
        const long L = (long)i * G + c; if (L >= nwg) return false;
        int wgid = (int)L; { const int q = nwg / NXCD, r = nwg % NXCD, xcd = wgid % NXCD, off = wgid / NXCD; wgid = (xcd < r ? xcd * (q + 1) : r * (q + 1) + (xcd - r) * q) + off; }
        const int nig = WGM * nN, gid = wgid / nig, fm = gid * WGM, gsz = (nM - fm) < WGM ? (nM - fm) : WGM;
        u.pm = fm + ((wgid % nig) % gsz); u.pn = (wgid % nig) / gsz; u.aux = 0; return true;
    }
};
struct MoeOrder {
    int ntn, xl, cl, nl; int mt[4], tp[4];
    __device__ bool next(int i, Unit& u) const {
        int L = i * nl + cl;
#pragma unroll
        for (int s = 0; s < 4; ++s) { const int nu = mt[s] * ntn; if (L < nu) { const int e = xl + 8 * s; u.pm = tp[s] + L % mt[s]; u.pn = e * ntn + L / mt[s]; u.aux = e; return true; } L -= nu; }
        return false;
    }
};
template <class Epi, class Sched>
__device__ __forceinline__ void gemm_phase(LAS unsigned char* lds, const Gemm g, const Sched& S, const Epi& E, int tid_in) {
    int tid_ = tid_in; asm volatile("" : "+v"(tid_));
    const int tid = tid_, wid = __builtin_amdgcn_readfirstlane(tid >> 6), lane = tid & 63, wr = wid >> 2, wc = wid & 3, fr = lane & 15, fq = lane >> 4;
    const int K = g.K, nt = K / BK;
    unsigned voffA[2], voffB[2];
#pragma unroll
    for (int i = 0; i < 2; ++i) { int R, C; stage_rc(tid * 16 + i * 8192, R, C); const int Rb = Epi::PERM ? ((R & ~31) + perm32(R & 31)) : R;
        voffA[i] = (unsigned)(R * g.lda + C) * 2u; voffB[i] = (unsigned)(Rb * g.ldb + C) * 2u; }
    const size_t kstep = (size_t)(BK * 2);
    const size_t hstepA = (size_t)HALF * g.lda * 2, hstepB = (size_t)HALF * g.ldb * 2;
    const size_t tstepA = 2 * hstepA, tstepB = 2 * hstepB;
    const unsigned ldsw = (unsigned)wid * 1024u;
    const int aoff = lds_byte(wr * 64 + fr, fq * 8), boff = lds_byte(wc * 32 + fr, fq * 8);
#define PG8_SA(b, h) (((b) * 2 + (h)) * HTB)
#define PG8_SB(b, h) ((4 + (b) * 2 + (h)) * HTB)
#define PG8_STAGE(bufoff, gbase, voff) do { _Pragma("unroll") for (int _i = 0; _i < 2; ++_i) \
        __builtin_amdgcn_global_load_lds((const unsigned*)((const char*)(gbase) + (voff)[_i]), (LAS unsigned*)(lds + (bufoff) + ldsw + _i * 8192), 16, 0, 0); } while (0)
#define PG8_LDA(dst, b, h) do { _Pragma("unroll") for (int m = 0; m < 4; ++m) _Pragma("unroll") for (int k = 0; k < 2; ++k) dst[m][k] = *(const LAS bf16x8*)(lds + PG8_SA(b, h) + aoff + m * 2048 + k * 1024); } while (0)
#define PG8_LDB(dst, b, h) do { _Pragma("unroll") for (int n = 0; n < 2; ++n) _Pragma("unroll") for (int k = 0; k < 2; ++k) dst[n][k] = *(const LAS bf16x8*)(lds + PG8_SB(b, h) + boff + n * 2048 + k * 1024); } while (0)
#define PG8_MMA(ai, bj, At, Bt) do { __builtin_amdgcn_s_setprio(1); _Pragma("unroll") for (int m = 0; m < 4; ++m) _Pragma("unroll") for (int n = 0; n < 2; ++n) _Pragma("unroll") for (int k = 0; k < 2; ++k) \
        acc[ai][bj][m][n] = __builtin_amdgcn_mfma_f32_16x16x32_bf16(Bt[n][k], At[m][k], acc[ai][bj][m][n], 0, 0, 0); __builtin_amdgcn_s_setprio(0); } while (0)
#define PG8_WAIT_V(n) asm volatile("s_waitcnt vmcnt(" #n ")" ::: "memory")
#define PG8_WAIT_L(n) asm volatile("s_waitcnt lgkmcnt(" #n ")" ::: "memory")
#define PG8_BAR __builtin_amdgcn_s_barrier()
#define PG8_SCHED __builtin_amdgcn_sched_barrier(0)
    Unit cur, nxt; int ui = 0;
    if (!S.next(0, cur)) return;
    f32x4 acc[2][2][4][2];
#pragma unroll
    for (int a = 0; a < 2; ++a)
#pragma unroll
        for (int b = 0; b < 2; ++b)
#pragma unroll
            for (int m = 0; m < 4; ++m)
#pragma unroll
                for (int n = 0; n < 2; ++n) acc[a][b][m][n] = (f32x4){0.f, 0.f, 0.f, 0.f};
    bf16x8 At[4][2], B0[2][2], B1[2][2];
    const char* cA = (const char*)g.A + (size_t)cur.pm * tstepA; const char* cB = (const char*)g.Bt + (size_t)cur.pn * tstepB;
    PG8_STAGE(PG8_SB(0, 0), cB, voffB); PG8_STAGE(PG8_SB(0, 1), cB + hstepB, voffB); PG8_STAGE(PG8_SA(0, 0), cA, voffA); PG8_STAGE(PG8_SA(0, 1), cA + hstepA, voffA);
    if (wr == 1) PG8_BAR;
    PG8_WAIT_V(2); PG8_BAR;
    PG8_STAGE(PG8_SB(1, 0), cB + kstep, voffB); PG8_STAGE(PG8_SA(1, 0), cA + kstep, voffA); PG8_STAGE(PG8_SB(1, 1), cB + hstepB + kstep, voffB);
    PG8_WAIT_V(6); PG8_BAR;
    for (;;) {
        const bool has_next = S.next(ui + 1, nxt);
        const char* nA = has_next ? (const char*)g.A + (size_t)nxt.pm * tstepA : cA; const char* nB = has_next ? (const char*)g.Bt + (size_t)nxt.pn * tstepB : cB;
#pragma unroll 1
        for (int t = 0; t < nt; t += 2) {
            const bool last = (t == nt - 2);
            const char* a1 = cA + (size_t)(t + 1) * kstep;
            const char* a2 = last ? nA : cA + (size_t)(t + 2) * kstep; const char* b2 = last ? nB : cB + (size_t)(t + 2) * kstep;
            const char* a3 = a2 + kstep; const char* b3 = b2 + kstep;
            PG8_LDB(B0, 0, 0); PG8_LDB(B1, 0, 1); PG8_SCHED; PG8_LDA(At, 0, 0); PG8_STAGE(PG8_SA(1, 1), a1 + hstepA, voffA);
            PG8_WAIT_V(8); PG8_WAIT_L(0); PG8_BAR; PG8_MMA(0, 0, At, B0); PG8_MMA(0, 1, At, B1); PG8_BAR; PG8_SCHED;
            PG8_LDA(At, 0, 1); PG8_STAGE(PG8_SB(0, 0), b2, voffB); PG8_STAGE(PG8_SB(0, 1), b2 + hstepB, voffB); PG8_STAGE(PG8_SA(0, 0), a2, voffA);
            PG8_WAIT_V(8); PG8_WAIT_L(0); PG8_BAR; PG8_MMA(1, 0, At, B0); PG8_MMA(1, 1, At, B1); PG8_BAR; PG8_SCHED;
            PG8_LDB(B0, 1, 0); PG8_LDB(B1, 1, 1); PG8_SCHED; PG8_LDA(At, 1, 0); PG8_STAGE(PG8_SA(0, 1), a2 + hstepA, voffA);
            PG8_WAIT_V(8); PG8_WAIT_L(0); PG8_BAR; PG8_MMA(0, 0, At, B0); PG8_MMA(0, 1, At, B1); PG8_BAR; PG8_SCHED;
            PG8_LDA(At, 1, 1); PG8_STAGE(PG8_SB(1, 0), b3, voffB); PG8_STAGE(PG8_SB(1, 1), b3 + hstepB, voffB); PG8_STAGE(PG8_SA(1, 0), a3, voffA);
            PG8_WAIT_V(8); PG8_WAIT_L(0); PG8_BAR; PG8_MMA(1, 0, At, B0); PG8_MMA(1, 1, At, B1); PG8_BAR; PG8_SCHED;
        }
        if (wr == 0) PG8_BAR;
        E(acc, cur, wr, wc, fr, fq);
        if (!has_next) break;
#pragma unroll
        for (int a = 0; a < 2; ++a)
#pragma unroll
            for (int b = 0; b < 2; ++b)
#pragma unroll
                for (int m = 0; m < 4; ++m)
#pragma unroll
                    for (int n = 0; n < 2; ++n) acc[a][b][m][n] = (f32x4){0.f, 0.f, 0.f, 0.f};
        cur = nxt; cA = nA; cB = nB; ++ui;
        if (wr == 1) PG8_BAR;
    }
    PG8_WAIT_V(0);
    PG8_BAR;
#undef PG8_SA
#undef PG8_SB
#undef PG8_STAGE
#undef PG8_LDA
#undef PG8_LDB
#undef PG8_MMA
#undef PG8_WAIT_V
#undef PG8_WAIT_L
#undef PG8_BAR
#undef PG8_SCHED
}
struct EpiScaleBf16 {
    static constexpr bool PERM = true;
    bf16* O; int ldc; const float* rs; int rs_stride;
    __device__ __forceinline__ void operator()(const f32x4 (&acc)[2][2][4][2], const Unit& u, int wr, int wc, int fr, int fq) const {
        const int row0 = u.pm * BM + wr * 64 + fr, col0 = u.pn * BM + wc * 32 + 8 * fq;
#pragma unroll
        for (int ai = 0; ai < 2; ++ai)
#pragma unroll
            for (int m = 0; m < 4; ++m) { const int row = row0 + ai * HALF + m * 16; const float sc = rs ? rs[(size_t)row * rs_stride] : 1.0f; bf16* rowp = O + (size_t)row * ldc + col0;
#pragma unroll
                for (int bj = 0; bj < 2; ++bj) { const f32x4 v0 = acc[ai][bj][m][0] * sc, v1 = acc[ai][bj][m][1] * sc;
                    u32x4 w; w.x = cvtpk(v0[0], v0[1]); w.y = cvtpk(v0[2], v0[3]); w.z = cvtpk(v1[0], v1[1]); w.w = cvtpk(v1[2], v1[3]);
                    *(u32x4*)(rowp + bj * HALF) = w; } }
    }
};
struct EpiResF32 {
    static constexpr bool PERM = false;
    const float* base; float* out; int ldc;
    __device__ __forceinline__ void operator()(const f32x4 (&acc)[2][2][4][2], const Unit& u, int wr, int wc, int fr, int fq) const {
        const int row0 = u.pm * BM + wr * 64 + fr, col0 = u.pn * BM + wc * 32 + 4 * fq;
#pragma unroll
        for (int ai = 0; ai < 2; ++ai)
#pragma unroll
            for (int m = 0; m < 4; ++m) { const size_t off = (size_t)(row0 + ai * HALF + m * 16) * ldc + col0;
#pragma unroll
                for (int bj = 0; bj < 2; ++bj)
#pragma unroll
                    for (int n = 0; n < 2; ++n) { const f32x4 bs = *(const f32x4*)(base + off + bj * HALF + n * 16); *(f32x4*)(out + off + bj * HALF + n * 16) = bs + acc[ai][bj][m][n]; } }
    }
};
struct EpiResF32Bf16 {
    static constexpr bool PERM = false;
    const float* base; float* out; bf16* xb; float* ssq; int ldc;
    __device__ __forceinline__ void operator()(const f32x4 (&acc)[2][2][4][2], const Unit& u, int wr, int wc, int fr, int fq) const {
        const int row0 = u.pm * BM + wr * 64 + fr, col0 = u.pn * BM + wc * 32 + 4 * fq;
#pragma unroll
        for (int ai = 0; ai < 2; ++ai)
#pragma unroll
            for (int m = 0; m < 4; ++m) { const int row = row0 + ai * HALF + m * 16; const size_t off = (size_t)row * ldc + col0; float ss = 0.f;
#pragma unroll
                for (int bj = 0; bj < 2; ++bj)
#pragma unroll
                    for (int n = 0; n < 2; ++n) { const f32x4 v = *(const f32x4*)(base + off + bj * HALF + n * 16) + acc[ai][bj][m][n];
                        ss += (v[0] * v[0] + v[1] * v[1]) + (v[2] * v[2] + v[3] * v[3]);
                        u32x2 w; w.x = cvtpk(v[0], v[1]); w.y = cvtpk(v[2], v[3]); *(u32x2*)(xb + off + bj * HALF + n * 16) = w; }
                ss += shx<16>(ss); ss = sum32x(ss);
                if (fq == 0) ssq[(size_t)row * 16 + u.pn * 4 + wc] = ss; }
    }
};
struct EpiAddBf16 {
    static constexpr bool PERM = true;
    bf16* xb; int ldc;
    __device__ __forceinline__ void operator()(const f32x4 (&acc)[2][2][4][2], const Unit& u, int wr, int wc, int fr, int fq) const {
        const int row0 = u.pm * BM + wr * 64 + fr, col0 = u.pn * BM + wc * 32 + 8 * fq;
#pragma unroll
        for (int ai = 0; ai < 2; ++ai)
#pragma unroll
            for (int m = 0; m < 4; ++m) { bf16* rowp = xb + (size_t)(row0 + ai * HALF + m * 16) * ldc + col0;
#pragma unroll
                for (int bj = 0; bj < 2; ++bj) { const u32x4 o = *(const u32x4*)(rowp + bj * HALF); const f32x4 a0 = acc[ai][bj][m][0], a1 = acc[ai][bj][m][1];
                    u32x4 w; w.x = cvtpk(__uint_as_float(o.x << 16) + a0[0], __uint_as_float(o.x & 0xffff0000u) + a0[1]); w.y = cvtpk(__uint_as_float(o.y << 16) + a0[2], __uint_as_float(o.y & 0xffff0000u) + a0[3]);
                    w.z = cvtpk(__uint_as_float(o.z << 16) + a1[0], __uint_as_float(o.z & 0xffff0000u) + a1[1]); w.w = cvtpk(__uint_as_float(o.w << 16) + a1[2], __uint_as_float(o.w & 0xffff0000u) + a1[3]);
                    *(u32x4*)(rowp + bj * HALF) = w; } }
    }
};
struct EpiAddBf16Ssq {
    static constexpr bool PERM = true;
    bf16* xb; int ldc; float* ssq;
    __device__ __forceinline__ void operator()(const f32x4 (&acc)[2][2][4][2], const Unit& u, int wr, int wc, int fr, int fq) const {
        const int row0 = u.pm * BM + wr * 64 + fr, col0 = u.pn * BM + wc * 32 + 8 * fq;
#pragma unroll
        for (int ai = 0; ai < 2; ++ai)
#pragma unroll
            for (int m = 0; m < 4; ++m) { const int row = row0 + ai * HALF + m * 16; bf16* rowp = xb + (size_t)row * ldc + col0; float ss = 0.f;
#pragma unroll
                for (int bj = 0; bj < 2; ++bj) { const u32x4 o = *(const u32x4*)(rowp + bj * HALF); const f32x4 a0 = acc[ai][bj][m][0], a1 = acc[ai][bj][m][1];
                    const float v0 = __uint_as_float(o.x << 16) + a0[0], v1 = __uint_as_float(o.x & 0xffff0000u) + a0[1], v2 = __uint_as_float(o.y << 16) + a0[2], v3 = __uint_as_float(o.y & 0xffff0000u) + a0[3];
                    const float v4 = __uint_as_float(o.z << 16) + a1[0], v5 = __uint_as_float(o.z & 0xffff0000u) + a1[1], v6 = __uint_as_float(o.w << 16) + a1[2], v7 = __uint_as_float(o.w & 0xffff0000u) + a1[3];
                    ss += ((v0 * v0 + v1 * v1) + (v2 * v2 + v3 * v3)) + ((v4 * v4 + v5 * v5) + (v6 * v6 + v7 * v7));
                    u32x4 w; w.x = cvtpk(v0, v1); w.y = cvtpk(v2, v3); w.z = cvtpk(v4, v5); w.w = cvtpk(v6, v7);
                    *(u32x4*)(rowp + bj * HALF) = w; }
                ss += shx<16>(ss); ss = sum32x(ss);
                if (fq == 0) ssq[(size_t)row * 16 + u.pn * 4 + wc] = ss; }
    }
};
struct EpiSsqScaleBf16 {
    static constexpr bool PERM = true;
    bf16* O; int ldc; const float* ssq;
    __device__ __forceinline__ void operator()(const f32x4 (&acc)[2][2][4][2], const Unit& u, int wr, int wc, int fr, int fq) const {
        const int row0 = u.pm * BM + wr * 64 + fr, col0 = u.pn * BM + wc * 32 + 8 * fq;
#pragma unroll
        for (int ai = 0; ai < 2; ++ai)
#pragma unroll
            for (int m = 0; m < 4; ++m) { const int row = row0 + ai * HALF + m * 16; const f32x4* sp = (const f32x4*)(ssq + (size_t)row * 16);
                const f32x4 s0 = sp[0], s1 = sp[1], s2 = sp[2], s3 = sp[3];
                const float tot = ((s0[0] + s0[1]) + (s0[2] + s0[3])) + ((s1[0] + s1[1]) + (s1[2] + s1[3])) + ((s2[0] + s2[1]) + (s2[2] + s2[3])) + ((s3[0] + s3[1]) + (s3[2] + s3[3]));
                const float sc = 1.0f / sqrtf(tot * (1.0f / 1024) + EPS); bf16* rowp = O + (size_t)row * ldc + col0;
#pragma unroll
                for (int bj = 0; bj < 2; ++bj) { const f32x4 v0 = acc[ai][bj][m][0] * sc, v1 = acc[ai][bj][m][1] * sc;
                    u32x4 w; w.x = cvtpk(v0[0], v0[1]); w.y = cvtpk(v0[2], v0[3]); w.z = cvtpk(v1[0], v1[1]); w.w = cvtpk(v1[2], v1[3]);
                    *(u32x4*)(rowp + bj * HALF) = w; } }
    }
};
struct EpiSwiglu {
    static constexpr bool PERM = true;
    bf16* act; const float* bgu;
    __device__ __forceinline__ void operator()(const f32x4 (&acc)[2][2][4][2], const Unit& u, int wr, int wc, int fr, int fq) const {
        const int e = u.aux, pnl = u.pn - e * 8;
        const int row0 = u.pm * BM + wr * 64 + fr, c0 = pnl * BM + wc * 32 + 8 * fq;
#pragma unroll
        for (int bj = 0; bj < 2; ++bj) { const f32x4 b0 = *(const f32x4*)(bgu + (size_t)e * 2048 + c0 + bj * HALF), b1 = *(const f32x4*)(bgu + (size_t)e * 2048 + c0 + bj * HALF + 4);
#pragma unroll
            for (int ai = 0; ai < 2; ++ai)
#pragma unroll
                for (int m = 0; m < 4; ++m) { const int row = row0 + ai * HALF + m * 16; const f32x4 v0 = acc[ai][bj][m][0] + b0, v1 = acc[ai][bj][m][1] + b1; float o[4];
#pragma unroll
                    for (int j = 0; j < 4; ++j) { float gt = j < 2 ? v0[2 * j] : v1[2 * j - 4], up = j < 2 ? v0[2 * j + 1] : v1[2 * j - 3];
                        gt = fminf(gt, 7.0f); up = fminf(fmaxf(up, -7.0f), 7.0f);
                        const float sg = __builtin_amdgcn_rcpf(1.0f + __builtin_amdgcn_exp2f(-1.702f * LOG2E * gt));
                        o[j] = (up + 1.0f) * gt * sg; }
                    u32x2 w; w.x = cvtpk(o[0], o[1]); w.y = cvtpk(o[2], o[3]);
                    *(u32x2*)(act + (size_t)row * 1024 + ((c0 + bj * HALF) >> 1)) = w; } }
    }
};
struct EpiDown {
    static constexpr bool PERM = true;
    bf16* Y; const float* bd;
    __device__ __forceinline__ void operator()(const f32x4 (&acc)[2][2][4][2], const Unit& u, int wr, int wc, int fr, int fq) const {
        const int e = u.aux, pnl = u.pn - e * 4;
        const int row0 = u.pm * BM + wr * 64 + fr, c0 = pnl * BM + wc * 32 + 8 * fq;
#pragma unroll
        for (int bj = 0; bj < 2; ++bj) { const f32x4 b0 = *(const f32x4*)(bd + (size_t)e * 1024 + c0 + bj * HALF), b1 = *(const f32x4*)(bd + (size_t)e * 1024 + c0 + bj * HALF + 4);
#pragma unroll
            for (int ai = 0; ai < 2; ++ai)
#pragma unroll
                for (int m = 0; m < 4; ++m) { const int row = row0 + ai * HALF + m * 16; const f32x4 v0 = acc[ai][bj][m][0] + b0, v1 = acc[ai][bj][m][1] + b1;
                    u32x4 w; w.x = cvtpk(v0[0], v0[1]); w.y = cvtpk(v0[2], v0[3]); w.z = cvtpk(v1[0], v1[1]); w.w = cvtpk(v1[2], v1[3]);
                    *(u32x4*)(Y + (size_t)row * 1024 + c0 + bj * HALF) = w; } }
    }
};
}

#define XB_TMO      128
#define XB_XCNT(j)  (256  + 64 * (j))
#define XB_XSUB(j)  (1280 + 64 * (j))
#define XB_XGEN(j)  (2304 + 64 * (j))
#define XB_TOP      3328
#define XB_TOPGEN   3392
#define XCD_BAR_WORDS 3456
#define XB_SPIN_CAP (1u << 18)
__device__ __forceinline__ unsigned xb_ld(unsigned* p)              { return __hip_atomic_load(p, __ATOMIC_RELAXED, __HIP_MEMORY_SCOPE_AGENT); }
__device__ __forceinline__ unsigned xb_add(unsigned* p, unsigned v) { return __hip_atomic_fetch_add(p, v, __ATOMIC_RELAXED, __HIP_MEMORY_SCOPE_AGENT); }
__device__ __forceinline__ unsigned xb_xcc_id() { return (unsigned)__builtin_amdgcn_s_getreg((3 << 11) | 20) & 0xFu; }
#define XB_SPIN(cond, bar) do { unsigned _sp = 0; while (cond) { __builtin_amdgcn_s_sleep(1); \
    if ((++_sp & 255u) == 0u) { if (xb_ld(&(bar)[XB_TMO])) break; if (_sp > XB_SPIN_CAP) { atomicAdd(&(bar)[XB_TMO], 1u); break; } } } } while (0)
struct XcdBarrier { unsigned* bar; unsigned x; volatile LAS unsigned* st; };
__device__ __forceinline__ XcdBarrier xcd_barrier_post(unsigned* bar, volatile LAS unsigned* st) {
    XcdBarrier b; b.bar = bar; b.x = xb_xcc_id(); b.st = st;
    if (threadIdx.x == 0) (void)xb_add(&bar[XB_XCNT(b.x)], 1u);
    return b;
}
__device__ __forceinline__ void xcd_barrier_complete(unsigned* bar, unsigned x, unsigned& nloc, unsigned& nx) {
    const unsigned G = gridDim.x * gridDim.y * gridDim.z;
    unsigned sum, cnt, mine, sp = 0u;
    for (;;) {
        sum = 0u; cnt = 0u; mine = 0u;
#pragma unroll
        for (unsigned j = 0; j < 16; ++j) { const unsigned c = xb_ld(&bar[XB_XCNT(j)]); sum += c; cnt += (c > 0u) ? 1u : 0u; mine = (j == x) ? c : mine; }
        if (sum == G) break;
        __builtin_amdgcn_s_sleep(1);
        if ((++sp & 255u) == 0u) { if (xb_ld(&bar[XB_TMO])) break; if (sp > XB_SPIN_CAP) { atomicAdd(&bar[XB_TMO], 1u); break; } }
    }
    nloc = mine > 0u ? mine : 1u; nx = cnt > 0u ? cnt : 1u;
}
__device__ __forceinline__ void xcd_barrier(const XcdBarrier& b, bool leader) {
    asm volatile("s_waitcnt vmcnt(0)" ::: "memory");
    __syncthreads();
    if (leader) {
        unsigned* bar = b.bar;
        __builtin_amdgcn_s_waitcnt(0);
        unsigned nloc = b.st[0], nx = b.st[1];
        if (nloc == 0u) { xcd_barrier_complete(bar, b.x, nloc, nx); b.st[0] = nloc; b.st[1] = nx; }
        const unsigned old = xb_add(&bar[XB_XSUB(b.x)], 1u);
        const unsigned gen = old / nloc;
        if (old + 1u == (gen + 1u) * nloc) {
            __builtin_amdgcn_fence(__ATOMIC_RELEASE, "agent");
            asm volatile("s_waitcnt vmcnt(0)" ::: "memory");
            const unsigned og = xb_add(&bar[XB_TOP], 1u);
            const unsigned tg = og / nx;
            if (og + 1u == (tg + 1u) * nx) xb_add(&bar[XB_TOPGEN], 1u);
            else XB_SPIN(xb_ld(&bar[XB_TOPGEN]) == tg, bar);
            __builtin_amdgcn_fence(__ATOMIC_ACQUIRE, "agent");
            xb_add(&bar[XB_XGEN(b.x)], 1u);
            asm volatile("s_waitcnt vmcnt(0)" ::: "memory");
        } else {
            XB_SPIN(xb_ld(&bar[XB_XGEN(b.x)]) == gen, bar);
            __builtin_amdgcn_fence(__ATOMIC_ACQUIRE, "agent");
            asm volatile("s_waitcnt vmcnt(0)" ::: "memory");
        }
    }
    __syncthreads();
}

struct Args { const float* in[36]; float* out; unsigned char* ws; };
struct Frame {
    LAS unsigned char* lds; int tid, lane, wave, G, bid, gw, ngw;
    const float* const* in; float* out; unsigned char* ws;
};
#ifndef PRB_A
#define PRB_A -1
#endif
#ifndef PRB_B
#define PRB_B -1
#endif
#define FSTAMP(F, k) do { if (PRB_A >= 0 && (F).bid == 0 && (F).tid == 0) ((volatile LAS unsigned long long*)((F).lds + LDSCTL_OFF + 128))[k] = __builtin_amdgcn_s_memrealtime(); } while (0)
#define WSP(T, off) ((T*)(F.ws + (off)))

struct TrItem { const float* wp; const float* gp; bf16* dst; int ldw, ldd; float msk; };
__device__ __forceinline__ void tr_decode(Frame& F, int it, TrItem& d) {
    const float* const* in = F.in; const float* nog = nullptr;
    constexpr int I0 = 16 * 28, I1 = 4 * 12, I2 = 4 * 16, I3 = 16 * 16, I4 = 16 * 4, I5 = 4 * 16, I6 = 32 * 16 * 32, I7 = 32 * 16 * 16;
    int r = it; const float* W; int ldw, kvalid, nvalid, gsplit = 1 << 30, ldd, kb, nb; const float* g1 = nog; const float* g2 = nog; bf16* WT;
    if (r < I0) { kb = r / 28; nb = r % 28; W = in[3]; ldw = 1720; kvalid = 1024; nvalid = 1720; g1 = in[2]; g2 = in[2]; WT = WSP(bf16, WS_WIN); ldd = 1024; }
    else if ((r -= I0) < I1) { kb = r / 12; nb = r % 12; W = in[5]; ldw = 768; kvalid = 256; nvalid = 768; g1 = in[4]; g2 = in[4]; WT = WSP(bf16, WS_WUQ); ldd = 256; }
    else if ((r -= I1) < I2) { kb = r / 16; nb = r % 16; W = in[7]; ldw = 1024; kvalid = 128; nvalid = 1024; g1 = in[6]; g2 = in[6]; WT = WSP(bf16, WS_WUKV); ldd = 256; }
    else if ((r -= I2) < I3) { kb = r / 16; nb = r % 16; W = in[21]; ldw = 1024; kvalid = 1024; nvalid = 1024; g1 = in[19]; g2 = in[20]; gsplit = 512; WT = WSP(bf16, WS_WOUT); ldd = 1024; }
    else if ((r -= I3) < I4) { kb = r / 4; nb = r % 4; W = in[24]; ldw = 256; kvalid = 1024; nvalid = 256; g1 = in[22]; g2 = in[22]; WT = WSP(bf16, WS_WMQ); ldd = 1024; }
    else if ((r -= I4) < I5) { kb = r / 16; nb = r % 16; W = in[28]; ldw = 1024; kvalid = 256; nvalid = 1024; WT = WSP(bf16, WS_WMO); ldd = 256; }
    else if ((r -= I5) < I6) { const int e = r / 512, q = r % 512; kb = q / 32; nb = q % 32; W = in[32] + (size_t)e * 1024 * 2048; ldw = 2048; kvalid = 1024; nvalid = 2048; g1 = in[29]; g2 = in[29]; WT = WSP(bf16, WS_WGU) + (size_t)e * 2048 * 1024; ldd = 1024; }
    else if ((r -= I6) < I7) { const int e = r / 256, q = r % 256; kb = q / 16; nb = q % 16; W = in[34] + (size_t)e * 1024 * 1024; ldw = 1024; kvalid = 1024; nvalid = 1024; WT = WSP(bf16, WS_WD) + (size_t)e * 1024 * 1024; ldd = 1024; }
    else if ((r -= I7) < 128) { const int kv = r / 64, q = r % 64; kb = q / 2; nb = q % 2; W = in[kv ? 14 : 11]; ldw = 128; kvalid = 2048; nvalid = 128; WT = WSP(bf16, WS_W1T) + (size_t)kv * 128 * 2048; ldd = 2048; }
    else { r -= 128; kb = r / 8; nb = r % 8; W = in[25]; ldw = 512; kvalid = 1024; nvalid = 512; g1 = in[23]; g2 = in[23]; WT = WSP(bf16, WS_WMKVT); ldd = 1024; }
    const int k0 = 64 * kb, n0 = 64 * nb, cg = F.lane & 15, rp = F.lane >> 4, nc = n0 + 4 * cg;
    const bool ok = (nc < nvalid) && (k0 < kvalid);
    d.gp = g1 ? ((k0 < gsplit ? g1 + k0 : g2 + (k0 - gsplit)) + 2 * rp) : nullptr;
    d.wp = W + (ok ? (size_t)(k0 + 2 * rp) * ldw + nc : (size_t)0);
    d.msk = ok ? 1.0f : 0.0f; d.ldw = ldw; d.ldd = ldd; d.dst = WT + (size_t)n0 * ldd + k0;
}
__device__ __forceinline__ void tr_load(const TrItem& d, f32x4 (&a)[8], f32x4 (&b)[8]) {
#pragma unroll
    for (int j = 0; j < 8; ++j) { a[j] = __builtin_nontemporal_load((const f32x4*)(d.wp + (size_t)(8 * j) * d.ldw)); b[j] = __builtin_nontemporal_load((const f32x4*)(d.wp + (size_t)(8 * j + 1) * d.ldw)); }
}
__device__ __forceinline__ void tr_finish(const TrItem& d, f32x4 (&a)[8], f32x4 (&b)[8], LAS unsigned* scr, int lane) {
    const int cg = lane & 15, rp = lane >> 4;
#pragma unroll
    for (int j = 0; j < 8; ++j) {
        float ga = d.msk, gb = d.msk;
        if (d.gp) { const f32x2_t g2v = *(const f32x2_t*)(d.gp + 8 * j); ga *= g2v.x; gb *= g2v.y; }
        a[j] = a[j] * ga; b[j] = b[j] * gb;
        LAS unsigned* q = scr + (4 * cg) * 36 + 4 * j + rp;
        q[0] = cvtpk(a[j].x, b[j].x); q[36] = cvtpk(a[j].y, b[j].y); q[72] = cvtpk(a[j].z, b[j].z); q[108] = cvtpk(a[j].w, b[j].w); }
    LDS_WAIT(); asm volatile("" ::: "memory");
#pragma unroll
    for (int i = 0; i < 8; ++i) { const int n = 8 * i + (lane >> 3), c = lane & 7;
        const u32x4 v = *(const LAS u32x4*)(scr + n * 36 + 4 * c);
        *(u32x4*)(d.dst + (size_t)n * d.ldd + 8 * c) = v; }
    LDS_WAIT(); asm volatile("" ::: "memory");
}

__device__ __forceinline__ void p0_prologue(Frame& F) {
    LAS unsigned* scr = (LAS unsigned*)(F.lds + F.wave * 16384);
    const float* const* in = F.in;
    constexpr int NITEMS = 16 * 28 + 4 * 12 + 4 * 16 + 16 * 16 + 16 * 4 + 4 * 16 + 32 * 16 * 32 + 32 * 16 * 16 + 2 * 32 * 2 + 16 * 8;
    { TrItem d0, d1; f32x4 a0[8], b0[8], a1[8], b1[8];
      int it = F.gw; if (it < NITEMS) { tr_decode(F, it, d0); tr_load(d0, a0, b0); }
#pragma unroll 1
      while (it < NITEMS) {
          const int it1 = it + F.ngw; if (it1 < NITEMS) { tr_decode(F, it1, d1); tr_load(d1, a1, b1); }
          tr_finish(d0, a0, b0, scr, F.lane);
          if (it1 >= NITEMS) break;
          const int it2 = it1 + F.ngw; if (it2 < NITEMS) { tr_decode(F, it2, d0); tr_load(d0, a0, b0); }
          tr_finish(d1, a1, b1, scr, F.lane);
          it = it2;
      } }
    FSTAMP(F, 32);
    { float* RS = WSP(float, WS_RS); bf16* XB = WSP(bf16, WS_XB);
      for (int m = F.gw; m < NTOK; m += F.ngw) {
        const f32x4* xr = (const f32x4*)(in[0] + (size_t)m * D) + F.lane; f32x4 v[4]; float s = 0.f;
#pragma unroll
        for (int j = 0; j < 4; ++j) { v[j] = xr[64 * j]; s += (v[j].x * v[j].x + v[j].y * v[j].y) + (v[j].z * v[j].z + v[j].w * v[j].w); }
        s = wave_sum(s); if (F.lane == 0) RS[m * 4 + 0] = 1.0f / sqrtf(s * (1.0f / D) + EPS);
        u32x2* o8 = (u32x2*)(XB + (size_t)m * D) + F.lane;
#pragma unroll
        for (int j = 0; j < 4; ++j) { u32x2 w; w.x = cvtpk(v[j].x, v[j].y); w.y = cvtpk(v[j].z, v[j].w); o8[64 * j] = w; }
      } }
    { float* RSM = WSP(float, WS_RSM); bf16* MB = WSP(bf16, WS_MEMB);
      for (int m = F.gw; m < 512; m += F.ngw) {
        const f32x4* xr = (const f32x4*)(in[1] + (size_t)m * D) + F.lane; f32x4 v[4]; float s = 0.f;
#pragma unroll
        for (int j = 0; j < 4; ++j) { v[j] = xr[64 * j]; s += (v[j].x * v[j].x + v[j].y * v[j].y) + (v[j].z * v[j].z + v[j].w * v[j].w); }
        s = wave_sum(s); if (F.lane == 0) RSM[m] = 1.0f / sqrtf(s * (1.0f / D) + EPS);
        u32x2* o8 = (u32x2*)(MB + (size_t)m * D) + F.lane;
#pragma unroll
        for (int j = 0; j < 4; ++j) { u32x2 w; w.x = cvtpk(v[j].x, v[j].y); w.y = cvtpk(v[j].z, v[j].w); o8[64 * j] = w; }
      } }
    FSTAMP(F, 33);
    if (F.bid < 32) { const int kv = F.bid >> 4, part = (F.bid & 15) * 4 + (F.tid >> 7), f = F.tid & 127;
        const float* pos = in[kv ? 13 : 10] + 32 * part; const float* w1 = in[kv ? 14 : 11] + (size_t)(32 * part) * 128 + f; float wv[32], acc = 0.f;
#pragma unroll
        for (int k = 0; k < 32; ++k) wv[k] = w1[(size_t)k * 128];
#pragma unroll
        for (int k = 0; k < 32; ++k) acc += pos[k] * wv[k];
        WSP(float, WS_CONST)[CF_CPP + (kv * 64 + part) * 128 + f] = acc; }
    if (F.bid >= 64 && F.bid < 128) { const float* rw = in[30]; const float* gm = in[29]; bf16* WH = WSP(bf16, WS_WRH); bf16* WL = WSP(bf16, WS_WRL);
        { const int i = (F.bid - 64) * 512 + F.tid; const int k = i >> 5, e = i & 31; const float v = rw[i] * gm[k];
            const unsigned hb = cvtpk(v, 0.f) & 0xffffu; const float lo = v - bf2f(hb);
            WH[e * 1024 + k] = (bf16)hb; WL[e * 1024 + k] = (bf16)(cvtpk(lo, 0.f) & 0xffffu); } }
    float* CF = WSP(float, WS_CONST);
    if (F.bid == 0 && F.wave == 1) {
        const int l = F.lane;
        float m1 = 0.f; for (int i = l; i < 96; i += 64) m1 = fmaxf(m1, fabsf(in[9][i])); m1 = wave_max(m1);
        float m2 = wave_max(fabsf(in[17][l])); float m3 = wave_max(fabsf(in[27][l]));
        if (l == 0) { CF[CF_KBM] = sqrtf(96.f) * m1; CF[CF_KBN] = 8.f * m2; CF[CF_KBMEM] = 8.f * m3; }
        if (l < 8) { float mb = -1e30f; for (int b = 0; b < 32; ++b) mb = fmaxf(mb, in[18][b * 8 + l]); CF[CF_MAXB2 + l] = mb * LOG2E; }
        for (int i = l; i < 256; i += 64) CF[CF_BIAS2 + i] = in[18][i] * LOG2E;
        for (int n = l; n < 512; n += 64) { int bk; if (n < 16) bk = n; else { bk = 16 + (int)(logf((float)n / 16.0f) / logf(32.0f) * 16.0f); bk = bk < 31 ? bk : 31; } CF[CF_LUT + n] = (float)bk; }
    }
}
__device__ __forceinline__ void unpack8(const u32x4 w, float (&v)[8]) {
    v[0] = bf2f(w.x & 0xffff); v[1] = bf2f(w.x >> 16); v[2] = bf2f(w.y & 0xffff); v[3] = bf2f(w.y >> 16);
    v[4] = bf2f(w.z & 0xffff); v[5] = bf2f(w.z >> 16); v[6] = bf2f(w.w & 0xffff); v[7] = bf2f(w.w >> 16);
}
__device__ __forceinline__ u32x4 pack8f(const float (&v)[8]) { u32x4 w; w.x = cvtpk(v[0], v[1]); w.y = cvtpk(v[2], v[3]); w.z = cvtpk(v[4], v[5]); w.w = cvtpk(v[6], v[7]); return w; }

__device__ __forceinline__ void tp_a(Frame& F) {
    const float* CF = WSP(float, WS_CONST); const float kbn = CF[CF_KBN];
    const bf16* PB = WSP(bf16, WS_PB); float* RS = WSP(float, WS_RS);
    const int l = F.lane;
    const float* gq = F.in[16]; const float* gk = F.in[17];
    float gqv[8], gkv[8];
#pragma unroll
    for (int j = 0; j < 8; ++j) { gqv[j] = gq[(8 * l + j) & 63]; gkv[j] = gk[(8 * l + j) & 63]; }
    for (int t = F.gw; t < NTOK; t += F.ngw) {
        const bf16* pr = PB + (size_t)t * NINP; const int b = t >> 13, s = t & 8191;
        { const u32x2 w = *(const u32x2*)(pr + C_CQ + 4 * l); const float a0 = bf2f(w.x & 0xffff), a1 = bf2f(w.x >> 16), a2 = bf2f(w.y & 0xffff), a3 = bf2f(w.y >> 16);
          const float sq = wave_sum(a0 * a0 + a1 * a1 + a2 * a2 + a3 * a3);
          const unsigned w2 = *(const unsigned*)(pr + C_CKV + 2 * l); const float c0 = bf2f(w2 & 0xffff), c1 = bf2f(w2 >> 16);
          const float sk = wave_sum(c0 * c0 + c1 * c1);
          if (l == 0) { RS[t * 4 + 1] = 1.0f / sqrtf(sq * (1.0f / 256) + EPS); RS[t * 4 + 2] = 1.0f / sqrtf(sk * (1.0f / 128) + EPS); } }
        { float v[8]; unpack8(*(const u32x4*)(pr + C_QN + 8 * l), v); float ss = 0.f;
#pragma unroll
          for (int j = 0; j < 8; ++j) ss += v[j] * v[j];
          ss = grp8_sum(ss); const float rinv = 1.0f / sqrtf(ss * (1.0f / 64) + EPS) * (0.125f * LOG2E); float n2 = 0.f;
#pragma unroll
          for (int j = 0; j < 8; ++j) { v[j] = v[j] * rinv * gqv[j]; n2 += v[j] * v[j]; }
          n2 = grp8_sum(n2);
          const int h = l >> 3, g = h >> 2, hp = h & 3; const size_t ridx = (((size_t)(b * 2 + g) * S + s) * 4 + hp);
          *(u32x4*)(WSP(bf16, WS_QN) + ridx * 64 + (8 * l & 63)) = pack8f(v);
          if ((l & 7) == 0) WSP(float, WS_QBN)[ridx] = sqrtf(n2) * kbn + CF[CF_MAXB2 + h]; }
        { float v[8]; unpack8(*(const u32x4*)(pr + C_KS + 8 * l), v); const int seg = l >> 4, i = l & 15, g = i >> 3, d0 = (i & 7) * 8;
          float ss = 0.f;
#pragma unroll
          for (int j = 0; j < 8; ++j) ss += v[j] * v[j];
          ss = grp8_sum(ss);
          if ((seg & 1) == 0) { const float rinv = 1.0f / sqrtf(ss * (1.0f / 64) + EPS);
#pragma unroll
              for (int j = 0; j < 8; ++j) v[j] = v[j] * rinv * gkv[j]; }
          bf16* dst = WSP(bf16, seg == 0 ? WS_KS : seg == 1 ? WS_VS : seg == 2 ? WS_KW : WS_VW);
          *(u32x4*)(dst + ((size_t)(b * 2 + g) * S + s) * 64 + d0) = pack8f(v); }
        if (l < 24) { const float x = bf2f(pr[C_GT + l]); WSP(float, WS_GATE)[t * 24 + l] = 1.0f / (1.0f + __expf(-x)); }
    }
}

__device__ __forceinline__ void compress_phase(Frame& F) {
    const float* CF = WSP(float, WS_CONST);
    const bf16* PB = WSP(bf16, WS_PB);
    LAS float* red = (LAS float*)F.lds;
    LAS float* hid = (LAS float*)(F.lds + 65536);
    LAS float* ob = (LAS float*)(F.lds + 65536 + 8192);
    const int lane = F.lane, row = lane & 15, kq = lane >> 4;
    LAS float* cps = (LAS float*)(F.lds + 65536 + 8192 + 4096);
    __syncthreads();
    if (F.tid < 256) { float a = 0.f; const float* cp = CF + CF_CPP + (F.tid >> 7) * 64 * 128 + (F.tid & 127);
#pragma unroll 8
        for (int p = 0; p < 64; ++p) a += cp[p * 128];
        cps[F.tid] = a; }
    for (int it = F.bid; it < 256; it += F.G) {
        const int kv = it >> 7, slab = (it >> 5) & 3, n0 = (it & 31) * 16, b = slab >> 1, g = slab & 1;
        const int n = n0 + row;
        int tok0 = 16 * n + 4 * F.wave; if (tok0 > S - 4) tok0 = S - 4;
        const bf16* ap = PB + (size_t)(b * S + tok0) * NINP + (kv ? C_VC : C_KC) + g * 64 + 8 * kq;
        const bf16* bp = WSP(bf16, WS_W1T) + (size_t)kv * 128 * 2048 + (size_t)row * 2048 + 256 * F.wave + 8 * kq;
        f32x4 acc[8];
#pragma unroll
        for (int i = 0; i < 8; ++i) acc[i] = (f32x4){0.f, 0.f, 0.f, 0.f};
#pragma unroll
        for (int hb = 0; hb < 2; ++hb) {
            bf16x8 af[4], bf[4][8];
#pragma unroll
            for (int s = 0; s < 4; ++s) { const int ks = hb * 4 + s;
                af[s] = *(const bf16x8*)(ap + (size_t)(ks >> 1) * NINP + 32 * (ks & 1));
#pragma unroll
                for (int fb = 0; fb < 8; ++fb) bf[s][fb] = *(const bf16x8*)(bp + (size_t)fb * 16 * 2048 + 32 * ks); }
#pragma unroll
            for (int s = 0; s < 4; ++s)
#pragma unroll
                for (int fb = 0; fb < 8; ++fb) acc[fb] = __builtin_amdgcn_mfma_f32_16x16x32_bf16(af[s], bf[s][fb], acc[fb], 0, 0, 0);
        }
        __syncthreads();
#pragma unroll
        for (int fb = 0; fb < 8; ++fb)
#pragma unroll
            for (int i = 0; i < 4; ++i) red[(F.wave * 16 + 4 * kq + i) * 128 + fb * 16 + row] = acc[fb][i];
        __syncthreads();
        { const float c0 = 0.7978845608028654f, c1 = 0.044715f;
#pragma unroll
          for (int q = 0; q < 4; ++q) { const int idx = F.tid + 512 * q; float a = cps[kv * 128 + (idx & 127)];
#pragma unroll
              for (int ww = 0; ww < 8; ++ww) a += red[ww * 2048 + idx];
              hid[idx] = 0.5f * a * (1.f + tanhf(c0 * (a + c1 * a * a * a))); } }
        __syncthreads();
        { const float* w2 = F.in[kv ? 15 : 12];
#pragma unroll
          for (int q = 0; q < 2; ++q) { const int idx = F.tid + 512 * q, r = idx >> 6, d = idx & 63; float o = 0.f;
              for (int f = 0; f < 128; ++f) o += hid[r * 128 + f] * w2[f * 64 + d];
              if (kv == 0) { const float ss = wave_sum(o * o); o = o * (1.0f / sqrtf(ss * (1.0f / 64) + EPS)) * F.in[17][d]; }
              const int nn = n0 + r; if (nn >= 511) o = 0.f;
              WSP(bf16, kv ? WS_VCMP : WS_KCMP)[((size_t)slab * 512 + nn) * 64 + d] = (bf16)(cvtpk(o, 0.f) & 0xffff); } }
    }
    __syncthreads();
}

__device__ __forceinline__ void tp_b(Frame& F) {
    const float* CF = WSP(float, WS_CONST); const float kbm = CF[CF_KBM];
    const bf16* PB = WSP(bf16, WS_PB); const bf16* QR = WSP(bf16, WS_QRAW); const bf16* KVR = WSP(bf16, WS_KVRAW);
    const int l = F.lane, h = l >> 3, c = l & 7;
    const float* gq = F.in[8]; const float* gk = F.in[9];
    float gqn[8], gkn[8], gqr[4], gkr[4];
#pragma unroll
    for (int j = 0; j < 8; ++j) { gqn[j] = gq[8 * c + j]; gkn[j] = gk[8 * c + j]; }
    gqr[0] = gq[64 + 2 * c]; gqr[1] = gq[65 + 2 * c]; gqr[2] = gq[80 + 2 * c]; gqr[3] = gq[81 + 2 * c];
    gkr[0] = gk[64 + 2 * c]; gkr[1] = gk[65 + 2 * c]; gkr[2] = gk[80 + 2 * c]; gkr[3] = gk[81 + 2 * c];
    const float if0 = exp2f(-(float)(2 * c) * (13.287712379549449f / 16.0f)), if1 = exp2f(-(float)(2 * c + 1) * (13.287712379549449f / 16.0f));
    const float cq = 0.10206207261596575f * LOG2E;
    for (int t = F.gw; t < NTOK; t += F.ngw) {
        const int b = t >> 13, s = t & 8191; const size_t hrow = ((size_t)(b * 8 + h) * S + s);
        const float rcq = WSP(float, WS_RS)[t * 4 + 1], rckv = WSP(float, WS_RS)[t * 4 + 2];
        const float rv0 = __builtin_amdgcn_fractf((float)s * if0 * 0.15915494309189535f), rv1 = __builtin_amdgcn_fractf((float)s * if1 * 0.15915494309189535f);
        const float sn0 = __builtin_amdgcn_sinf(rv0), cs0 = __builtin_amdgcn_cosf(rv0), sn1 = __builtin_amdgcn_sinf(rv1), cs1 = __builtin_amdgcn_cosf(rv1);
        {
          float v[8]; unpack8(*(const u32x4*)(QR + (size_t)t * 768 + h * 96 + 8 * c), v);
          const unsigned wa = *(const unsigned*)(QR + (size_t)t * 768 + h * 96 + 64 + 2 * c), wb = *(const unsigned*)(QR + (size_t)t * 768 + h * 96 + 80 + 2 * c);
          float r0 = bf2f(wa & 0xffff), r1 = bf2f(wa >> 16), r2 = bf2f(wb & 0xffff), r3 = bf2f(wb >> 16);
          float ss = r0 * r0 + r1 * r1 + r2 * r2 + r3 * r3;
#pragma unroll
          for (int j = 0; j < 8; ++j) ss += v[j] * v[j];
          ss = grp8_sum(ss) * rcq * rcq; const float rinv = rcq / sqrtf(ss * (1.0f / 96) + EPS) * cq; float n2 = 0.f;
#pragma unroll
          for (int j = 0; j < 8; ++j) { v[j] = v[j] * rinv * gqn[j]; n2 += v[j] * v[j]; }
          r0 *= rinv * gqr[0]; r1 *= rinv * gqr[1]; r2 *= rinv * gqr[2]; r3 *= rinv * gqr[3];
          const float y0 = r0 * cs0 - r2 * sn0, y2 = r2 * cs0 + r0 * sn0, y1 = r1 * cs1 - r3 * sn1, y3 = r3 * cs1 + r1 * sn1;
          n2 += y0 * y0 + y1 * y1 + y2 * y2 + y3 * y3; n2 = grp8_sum(n2);
          bf16* dst = WSP(bf16, WS_QM) + hrow * 96;
          *(u32x4*)(dst + 8 * c) = pack8f(v); *(unsigned*)(dst + 64 + 2 * c) = cvtpk(y0, y1); *(unsigned*)(dst + 80 + 2 * c) = cvtpk(y2, y3);
          if (c == 0) WSP(float, WS_QBM)[hrow] = sqrtf(n2) * kbm; }
        {
          float v[8]; unpack8(*(const u32x4*)(KVR + (size_t)t * 1024 + h * 128 + 8 * c), v);
          const unsigned wa = *(const unsigned*)(PB + (size_t)t * NINP + C_KR + 2 * c), wb = *(const unsigned*)(PB + (size_t)t * NINP + C_KR + 16 + 2 * c);
          float r0 = bf2f(wa & 0xffff), r1 = bf2f(wa >> 16), r2 = bf2f(wb & 0xffff), r3 = bf2f(wb >> 16);
          float ss = r0 * r0 + r1 * r1 + r2 * r2 + r3 * r3;
#pragma unroll
          for (int j = 0; j < 8; ++j) { v[j] *= rckv; ss += v[j] * v[j]; }
          ss = grp8_sum(ss); const float rinv = 1.0f / sqrtf(ss * (1.0f / 96) + EPS);
#pragma unroll
          for (int j = 0; j < 8; ++j) v[j] = v[j] * rinv * gkn[j];
          r0 *= rinv * gkr[0]; r1 *= rinv * gkr[1]; r2 *= rinv * gkr[2]; r3 *= rinv * gkr[3];
          const float y0 = r0 * cs0 - r2 * sn0, y2 = r2 * cs0 + r0 * sn0, y1 = r1 * cs1 - r3 * sn1, y3 = r3 * cs1 + r1 * sn1;
          bf16* dst = WSP(bf16, WS_KM) + hrow * 96;
          *(u32x4*)(dst + 8 * c) = pack8f(v); *(unsigned*)(dst + 64 + 2 * c) = cvtpk(y0, y1); *(unsigned*)(dst + 80 + 2 * c) = cvtpk(y2, y3); }
        { float vv[8]; unpack8(*(const u32x4*)(KVR + (size_t)t * 1024 + h * 128 + 64 + 8 * c), vv);
#pragma unroll
          for (int j = 0; j < 8; ++j) vv[j] *= rckv;
          *(u32x4*)(WSP(bf16, WS_VM) + hrow * 64 + 8 * c) = pack8f(vv); }
    }
}

__device__ __forceinline__ void tp_c0(Frame& F) {
    bf16* Y = WSP(bf16, WS_Y); const int l = F.lane;
    for (int t = F.gw; t < NTOK; t += F.ngw) {
        u32x4* p = (u32x4*)(Y + (size_t)t * 1024 + 16 * l); float v0[8], v1[8]; unpack8(p[0], v0); unpack8(p[1], v1); float ss = 0.f;
#pragma unroll
        for (int j = 0; j < 8; ++j) ss += v0[j] * v0[j] + v1[j] * v1[j];
        ss += shx<1>(ss); ss += shx<2>(ss); ss += shx<4>(ss); ss += shx<8>(ss); ss += shx<16>(ss);
        const float rinv = 1.0f / sqrtf(ss * (1.0f / 512) + EPS);
#pragma unroll
        for (int j = 0; j < 8; ++j) { v0[j] *= rinv; v1[j] *= rinv; }
        p[0] = pack8f(v0); p[1] = pack8f(v1);
    }
}
__device__ __forceinline__ void tp_c(Frame& F) {
    float* RS = WSP(float, WS_RS); bf16* XB = WSP(bf16, WS_XB);
    for (int m = F.gw; m < NTOK; m += F.ngw) {
        const f32x4* xr = (const f32x4*)(F.out + (size_t)m * D) + F.lane; f32x4 v[4]; float s = 0.f;
#pragma unroll
        for (int j = 0; j < 4; ++j) { v[j] = xr[64 * j]; s += (v[j].x * v[j].x + v[j].y * v[j].y) + (v[j].z * v[j].z + v[j].w * v[j].w); }
        s = wave_sum(s); if (F.lane == 0) RS[m * 4 + 3] = 1.0f / sqrtf(s * (1.0f / D) + EPS);
        u32x2* o8 = (u32x2*)(XB + (size_t)m * D) + F.lane;
#pragma unroll
        for (int j = 0; j < 4; ++j) { u32x2 w; w.x = cvtpk(v[j].x, v[j].y); w.y = cvtpk(v[j].z, v[j].w); o8[64 * j] = w; }
    }
}

__device__ __forceinline__ int crow(int r, int hi) { return (r & 3) + 8 * (r >> 2) + 4 * hi; }
typedef short v4i16_t __attribute__((ext_vector_type(4)));
__device__ __forceinline__ s16x4 vtr(const LAS char* p) { return __builtin_bit_cast(s16x4, __builtin_amdgcn_ds_read_tr16_b64_v4i16((LAS v4i16_t*)p)); }

template <int ROWB> struct TileRegs { u32x4 r[(64 * ROWB / 16 + 511) / 512]; };
__device__ __forceinline__ const GAS char* uni_ptr(const char* p) { const unsigned long long v = (unsigned long long)p; const unsigned lo = __builtin_amdgcn_readfirstlane((unsigned)v), hi = __builtin_amdgcn_readfirstlane((unsigned)(v >> 32)); return (const GAS char*)(((unsigned long long)hi << 32) | lo); }
template <int ROWB> __device__ __forceinline__ void tile_load(TileRegs<ROWB>& T, const char* g_, int tid) {
    constexpr int NCH = 64 * ROWB / 16; const GAS char* g = uni_ptr(g_);
#pragma unroll
    for (int i = 0; i < (NCH + 511) / 512; ++i) { const int c = tid + 512 * i; const unsigned off = (unsigned)c * 16u; if (c < NCH) T.r[i] = *(const GAS u32x4*)(g + off); }
}
template <int ROWB, int STR> __device__ __forceinline__ void tile_store(const TileRegs<ROWB>& T, LAS char* l, int tid) {
    constexpr int NCH = 64 * ROWB / 16, CPR = ROWB / 16;
#pragma unroll
    for (int i = 0; i < (NCH + 511) / 512; ++i) { const int c = tid + 512 * i; if (c < NCH) *(LAS u32x4*)(l + (c / CPR) * STR + (c % CPR) * 16) = T.r[i]; }
}
template <int DK, int KSTR> __device__ __forceinline__ void qk_tile(f32x16& p0, f32x16& p1, const LAS char* Kt, const bf16x8* q, int lane, float cinit = 0.f) {
    const LAS char* kb = Kt + (lane & 31) * KSTR + (lane >> 5) * 16;
#pragma unroll
    for (int r = 0; r < 16; ++r) { p0[r] = cinit; p1[r] = cinit; }
#pragma unroll
    for (int s = 0; s < DK / 16; ++s) {
        const bf16x8 a0 = *(const LAS bf16x8*)(kb + s * 32), a1 = *(const LAS bf16x8*)(kb + 32 * KSTR + s * 32);
        p0 = __builtin_amdgcn_mfma_f32_32x32x16_bf16(a0, q[s], p0, 0, 0, 0);
        p1 = __builtin_amdgcn_mfma_f32_32x32x16_bf16(a1, q[s], p1, 0, 0, 0);
    }
    __builtin_amdgcn_sched_barrier(0);
}
__device__ __forceinline__ bf16x8 packp(const f32x16& p, int b) {
    u32x4 w; w.x = cvtpk(p[b], p[b + 1]); w.y = cvtpk(p[b + 2], p[b + 3]); w.z = cvtpk(p[b + 4], p[b + 5]); w.w = cvtpk(p[b + 6], p[b + 7]); return __builtin_bit_cast(bf16x8, w);
}
template <int VSTR> __device__ __forceinline__ void pv_tile(f32x16 (&o)[2], const LAS char* Vt, const f32x16& p0, const f32x16& p1, int lane) {
    const int i = lane & 15, g16 = lane >> 4, hi = g16 >> 1, dblk = (g16 & 1) * 16, q_ = i >> 2, p_ = i & 3;
    const LAS char* vb = Vt + (4 * hi + q_) * VSTR + (dblk + 4 * p_) * 2;
    __builtin_amdgcn_sched_barrier(0);
#pragma unroll
    for (int s = 0; s < 4; ++s) {
        const bf16x8 pa = packp(s < 2 ? p0 : p1, (s & 1) * 8);
#pragma unroll
        for (int d0 = 0; d0 < 2; ++d0) {
            const s16x4 lo = vtr(vb + (16 * s) * VSTR + d0 * 64), h8 = vtr(vb + (16 * s + 8) * VSTR + d0 * 64);
            const bf16x8 bv = {lo[0], lo[1], lo[2], lo[3], h8[0], h8[1], h8[2], h8[3]};
            o[d0] = __builtin_amdgcn_mfma_f32_32x32x16_bf16(pa, bv, o[d0], 0, 0, 0);
        }
        __builtin_amdgcn_sched_barrier(0);
    }
}
template <int DK, int KSTR> __device__ __forceinline__ void qk_half(f32x16& p, const LAS char* Kt, const bf16x8* q, int lane, float cinit, int hf) {
    const LAS char* kb = Kt + ((lane & 31) + 32 * hf) * KSTR + (lane >> 5) * 16;
#pragma unroll
    for (int r = 0; r < 16; ++r) p[r] = cinit;
#pragma unroll
    for (int s = 0; s < DK / 16; ++s) { const bf16x8 a = *(const LAS bf16x8*)(kb + s * 32); p = __builtin_amdgcn_mfma_f32_32x32x16_bf16(a, q[s], p, 0, 0, 0); }
    __builtin_amdgcn_sched_barrier(0);
}
template <int VSTR> __device__ __forceinline__ void pv_half(f32x16 (&o)[2], const LAS char* Vt, const f32x16& p, int lane, int hf) {
    const int i = lane & 15, g16 = lane >> 4, hi = g16 >> 1, dblk = (g16 & 1) * 16, q_ = i >> 2, p_ = i & 3;
    const LAS char* vb = Vt + (32 * hf + 4 * hi + q_) * VSTR + (dblk + 4 * p_) * 2;
    __builtin_amdgcn_sched_barrier(0);
#pragma unroll
    for (int s = 0; s < 2; ++s) {
        const bf16x8 pa = packp(p, s * 8);
#pragma unroll
        for (int d0 = 0; d0 < 2; ++d0) {
            const s16x4 lo = vtr(vb + (16 * s) * VSTR + d0 * 64), h8 = vtr(vb + (16 * s + 8) * VSTR + d0 * 64);
            const bf16x8 bv = {lo[0], lo[1], lo[2], lo[3], h8[0], h8[1], h8[2], h8[3]};
            o[d0] = __builtin_amdgcn_mfma_f32_32x32x16_bf16(pa, bv, o[d0], 0, 0, 0);
        }
        __builtin_amdgcn_sched_barrier(0);
    }
}
__device__ __forceinline__ float sum16(const f32x16& p) {
    const float a = (p[0] + p[1]) + (p[2] + p[3]), b = (p[4] + p[5]) + (p[6] + p[7]), c = (p[8] + p[9]) + (p[10] + p[11]), d = (p[12] + p[13]) + (p[14] + p[15]); return (a + b) + (c + d);
}
template <int DK, int KSTR> __device__ __forceinline__ void kf_load(bf16x8 (&kf)[DK / 16], const LAS char* Kt, int lane, int hf) {
    const LAS char* kb = Kt + ((lane & 31) + 32 * hf) * KSTR + (lane >> 5) * 16;
#pragma unroll
    for (int s = 0; s < DK / 16; ++s) kf[s] = *(const LAS bf16x8*)(kb + s * 32);
}
template <int VSTR> __device__ __forceinline__ void vf_load(bf16x8 (&vf)[2][2], const LAS char* Vt, int lane, int hf) {
    const int i = lane & 15, g16 = lane >> 4, hi = g16 >> 1, dblk = (g16 & 1) * 16, q_ = i >> 2, p_ = i & 3;
    const LAS char* vb = Vt + (32 * hf + 4 * hi + q_) * VSTR + (dblk + 4 * p_) * 2;
#pragma unroll
    for (int s = 0; s < 2; ++s)
#pragma unroll
        for (int d0 = 0; d0 < 2; ++d0) { const s16x4 lo = vtr(vb + (16 * s) * VSTR + d0 * 64), h8 = vtr(vb + (16 * s + 8) * VSTR + d0 * 64);
            vf[s][d0] = (bf16x8){lo[0], lo[1], lo[2], lo[3], h8[0], h8[1], h8[2], h8[3]}; }
}
template <int DK, int KSTR, int VSTR, class CI, class EF>
__device__ __forceinline__ void attn_tile(const LAS char* Kb, const LAS char* Vb, const bf16x8* q, f32x16 (&o)[2], int lane, CI cinit, EF elem, bool act0 = true, bool act1 = true) {
    bf16x8 kf[DK / 16];
    if (act0) kf_load<DK, KSTR>(kf, Kb, lane, 0); else if (act1) kf_load<DK, KSTR>(kf, Kb, lane, 1);
#pragma unroll
    for (int hf = 0; hf < 2; ++hf) {
        if (!(hf ? act1 : act0)) continue;
        f32x16 p; const float ci = cinit(hf);
#pragma unroll
        for (int r = 0; r < 16; ++r) p[r] = ci;
        __builtin_amdgcn_sched_barrier(0);
#pragma unroll
        for (int s = 0; s < DK / 16; ++s) p = __builtin_amdgcn_mfma_f32_32x32x16_bf16(kf[s], q[s], p, 0, 0, 0);
        __builtin_amdgcn_sched_barrier(0);
        bf16x8 vf[2][2]; vf_load<VSTR>(vf, Vb, lane, hf);
        if (hf == 0 && act1) kf_load<DK, KSTR>(kf, Kb, lane, 1);
        __builtin_amdgcn_sched_barrier(0);
        elem(p, hf);
        __builtin_amdgcn_sched_barrier(0);
#pragma unroll
        for (int s = 0; s < 2; ++s) { const bf16x8 pa = packp(p, s * 8);
#pragma unroll
            for (int d0 = 0; d0 < 2; ++d0) o[d0] = __builtin_amdgcn_mfma_f32_32x32x16_bf16(pa, vf[s][d0], o[d0], 0, 0, 0); }
        __builtin_amdgcn_sched_barrier(0);
    }
}
constexpr int BCAST_OFF = LDSX_OFF + 4096;
__device__ __forceinline__ void bcast_rows(float v, LAS unsigned char* lds, int wave, int lane, float (&out)[16]) {
    LAS float* wsf = (LAS float*)(lds + BCAST_OFF) + wave * 32;
    wsf[lane & 31] = v;
    LDS_WAIT(); asm volatile("" ::: "memory");
    const LAS float* rp = wsf + 4 * (lane >> 5);
#pragma unroll
    for (int r = 0; r < 16; ++r) out[r] = rp[(r & 3) + 8 * (r >> 2)];
    LDS_WAIT(); asm volatile("" ::: "memory");
}
constexpr int KSTR64 = 144, KSTR96 = 208, VSTR64 = 192;

__device__ __forceinline__ void mla_unit(Frame& F, int bh, int qb) {
    const int lane = F.lane, hi = lane >> 5, w = F.wave;
    const int q0 = qb * 256, qpos = q0 + 32 * w + (lane & 31);
    const bf16* Qm = WSP(bf16, WS_QM) + ((size_t)bh * S + qpos) * 96;
    const char* Kg = (const char*)(WSP(bf16, WS_KM) + (size_t)bh * S * 96); const char* Vg = (const char*)(WSP(bf16, WS_VM) + (size_t)bh * S * 64);
    bf16x8 qf[6];
#pragma unroll
    for (int s = 0; s < 6; ++s) qf[s] = *(const bf16x8*)(Qm + 16 * s + 8 * hi);
    const float bound = WSP(float, WS_QBM)[(size_t)bh * S + qpos];
    LAS char* KT[2] = {(LAS char*)F.lds, (LAS char*)F.lds + 64 * KSTR96}; LAS char* VT[2] = {(LAS char*)F.lds + 2 * 64 * KSTR96, (LAS char*)F.lds + 2 * 64 * KSTR96 + 64 * VSTR64};
    f32x16 o[2]; float lsum = 0.f;
#pragma unroll
    for (int r = 0; r < 16; ++r) { o[0][r] = 0.f; o[1][r] = 0.f; }
    const int NT = (q0 + 256) / 64; const int wq0 = q0 + 32 * w;
    TileRegs<192> krA; TileRegs<128> vrA;
    auto mla_compute = [&](int t, const LAS char* Kb, const LAS char* Vb) {
        if (64 * t <= wq0 + 31) {
            const bool diag = (64 * t + 63 > wq0);
            if (diag) {
                attn_tile<96, KSTR96, VSTR64>(Kb, Vb, qf, o, lane, [&](int) { return -bound; },
                    [&](f32x16& p, int hf) {
                        const int dl = qpos - 64 * t - 32 * hf - 4 * hi;
#pragma unroll
                        for (int r = 0; r < 16; ++r) { float e = __builtin_amdgcn_exp2f(p[r]); if ((r & 3) + 8 * (r >> 2) > dl) e = 0.f; p[r] = e; }
                        lsum += sum16(p); },
                    true, 64 * t + 32 <= wq0 + 31);
            } else {
                attn_tile<96, KSTR96, VSTR64>(Kb, Vb, qf, o, lane, [&](int) { return -bound; },
                    [&](f32x16& p, int) {
#pragma unroll
                        for (int r = 0; r < 16; ++r) p[r] = __builtin_amdgcn_exp2f(p[r]);
                        lsum += sum16(p); });
            }
        } };
    __syncthreads();
    tile_load<192>(krA, Kg, F.tid); tile_load<128>(vrA, Vg, F.tid);
    tile_store<192, KSTR96>(krA, KT[0], F.tid); tile_store<128, VSTR64>(vrA, VT[0], F.tid);
    __syncthreads();
    for (int t = 0; t < NT; ++t) {
        if (t + 1 < NT) { tile_load<192>(krA, Kg + (size_t)(t + 1) * 64 * 192, F.tid); tile_load<128>(vrA, Vg + (size_t)(t + 1) * 64 * 128, F.tid); }
        mla_compute(t, KT[t & 1], VT[t & 1]);
        if (t + 1 < NT) { tile_store<192, KSTR96>(krA, KT[(t + 1) & 1], F.tid); tile_store<128, VSTR64>(vrA, VT[(t + 1) & 1], F.tid); }
        __syncthreads();
    }
    lsum = sum32x(lsum); const float linv = lsum > 0.f ? 1.0f / lsum : 0.f;
    bf16* Y = WSP(bf16, WS_Y); const int b = bh >> 3, h = bh & 7;
    float fr_[16]; bcast_rows(linv, F.lds, w, lane, fr_);
#pragma unroll
    for (int r = 0; r < 16; ++r) { const int row = crow(r, hi); const float f = fr_[r]; bf16* yp = Y + ((size_t)b * S + wq0 + row) * 1024 + h * 64 + (lane & 31);
        yp[0] = (bf16)(cvtpk(o[0][r] * f, 0.f) & 0xffff); yp[32] = (bf16)(cvtpk(o[1][r] * f, 0.f) & 0xffff); }
}

__device__ __forceinline__ void nsa_unit(Frame& F, int bg, int cur, bool build_tables) {
    const int lane = F.lane, hi = lane >> 5, w = F.wave, hp = w & 3, qs = w >> 2;
    const int b = bg >> 1, g = bg & 1, h = g * 4 + hp;
    const int q0 = 64 * cur, qi = 32 * qs + (lane & 31), qpos = q0 + qi;
    const float* CF = WSP(float, WS_CONST);
    constexpr int TBL = 712; constexpr float NEGB = -3.0e38f;
    LAS char* KT[2] = {(LAS char*)F.lds, (LAS char*)F.lds + 64 * KSTR64}; LAS char* VT[2] = {(LAS char*)F.lds + 2 * 64 * KSTR64, (LAS char*)F.lds + 2 * 64 * KSTR64 + 64 * VSTR64};
    LAS float* TW = (LAS float*)(F.lds + 43008);
    LAS float* TS = TW + 4 * TBL;
    LAS unsigned* MSK = (LAS unsigned*)(F.lds + 43008 + 2 * 4 * TBL * 4);
    LAS float* PL = (LAS float*)(F.lds + 66816);
    LAS float* IMP = (LAS float*)(F.lds + 66816 + 17408);
    LAS float* PARK = (LAS float*)(F.lds + 66816) + w * 2048 + lane;
    __syncthreads();
    if (build_tables)
    for (int i = F.tid; i < 4 * TBL; i += 512) { const int hh = i / TBL, x = i - hh * TBL, dist = 639 - x; const bool in = dist >= 0 && dist < 512;
        const float bv = CF[CF_BIAS2 + (in ? (int)CF[CF_LUT + dist] : 31) * 8 + g * 4 + hh];
        TW[i] = in ? bv : NEGB; TS[i] = dist < 0 ? NEGB : bv; }
    const float bias31 = CF[CF_BIAS2 + 31 * 8 + h];
    const size_t qrow = ((size_t)bg * S + qpos) * 4 + hp;
    bf16x8 qf[4];
    { const GAS char* qb = uni_ptr((const char*)(F.ws + WS_QN)); const unsigned qoff = (unsigned)qrow * 128u + 16u * hi;
#pragma unroll
      for (int s = 0; s < 4; ++s) qf[s] = *(const GAS bf16x8*)(qb + qoff + 32 * s); }
    const float bound = *(const GAS float*)(uni_ptr((const char*)(F.ws + WS_QBN)) + (unsigned)qrow * 4u);
    const float* GT = WSP(float, WS_GATE); const int gto = (b * S + qpos) * 24 + h * 3;
    const LAS float* tsl = TS + hp * TBL; const LAS float* twl = TW + hp * TBL;
    const float cfar = bias31 - bound;
    TileRegs<128> kr, vr;
    f32x16 ocmp[2];
    const int ncmp = 4 * cur + 3 < 511 ? 4 * cur + 3 : 511, nct = (ncmp + 63) / 64;
    const char* Kc = (const char*)(WSP(bf16, WS_KCMP) + (size_t)bg * 512 * 64); const char* Vc = (const char*)(WSP(bf16, WS_VCMP) + (size_t)bg * 512 * 64);
#define NSA_CMP_EXP(T_, HF_, P_, SCALE_) do { \
        if (q0 - (16 * (64 * (T_) + 63) + 31) >= 512) { \
            _Pragma("unroll") for (int r = 0; r < 16; ++r) P_[r] = __builtin_amdgcn_exp2f(P_[r]) * (SCALE_); \
        } else { \
            _Pragma("unroll") for (int r = 0; r < 16; ++r) { const int n = 64 * (T_) + 32 * (HF_) + crow(r, hi); const int dist = qpos - (16 * n + 31); \
                const float bs = dist < 512 ? tsl[639 - (dist < 0 ? 0 : dist)] - bias31 : 0.f; const float sv = P_[r] + bs; \
                P_[r] = dist >= 0 ? __builtin_amdgcn_exp2f(sv) * (SCALE_) : 0.f; \
                if ((r & 3) == 3) __builtin_amdgcn_sched_barrier(0); } \
        } } while (0)
    float lc = 0.f;
    __syncthreads();
    for (int t = 0; t < nct; ++t) {
        tile_load<128>(kr, Kc + (size_t)t * 8192, F.tid); tile_store<128, KSTR64>(kr, KT[0], F.tid); __syncthreads();
        { bf16x8 kf[4]; kf_load<64, KSTR64>(kf, KT[0], lane, 0);
#pragma unroll
          for (int hf = 0; hf < 2; ++hf) { f32x16 p;
#pragma unroll
            for (int r = 0; r < 16; ++r) p[r] = cfar;
#pragma unroll
            for (int s = 0; s < 4; ++s) p = __builtin_amdgcn_mfma_f32_32x32x16_bf16(kf[s], qf[s], p, 0, 0, 0);
            __builtin_amdgcn_sched_barrier(0);
            if (hf == 0) kf_load<64, KSTR64>(kf, KT[0], lane, 1);
            NSA_CMP_EXP(t, hf, p, 1.0f);
            lc += sum16(p); } }
        __syncthreads();
    }
    lc = sum32x(lc); const float lcinv = lc > 0.f ? 1.0f / lc : 0.f;
    {
        f32x16 o[2];
#pragma unroll
        for (int r = 0; r < 16; ++r) { o[0][r] = 0.f; o[1][r] = 0.f; }
        float carry = 0.f;
        for (int t = 0; t < nct; ++t) {
            tile_load<128>(kr, Kc + (size_t)t * 8192, F.tid); tile_load<128>(vr, Vc + (size_t)t * 8192, F.tid);
            tile_store<128, KSTR64>(kr, KT[0], F.tid); tile_store<128, VSTR64>(vr, VT[0], F.tid); __syncthreads();
            float yprev = carry; f32x16 ph[2];
            bf16x8 kf[4]; kf_load<64, KSTR64>(kf, KT[0], lane, 0);
#pragma unroll
            for (int hf = 0; hf < 2; ++hf) {
#pragma unroll
                for (int r = 0; r < 16; ++r) ph[hf][r] = cfar;
#pragma unroll
                for (int s = 0; s < 4; ++s) ph[hf] = __builtin_amdgcn_mfma_f32_32x32x16_bf16(kf[s], qf[s], ph[hf], 0, 0, 0);
                __builtin_amdgcn_sched_barrier(0);
                if (hf == 0) kf_load<64, KSTR64>(kf, KT[0], lane, 1);
                NSA_CMP_EXP(t, hf, ph[hf], lcinv);
#pragma unroll
                for (int gi = 0; gi < 4; ++gi) { const f32x16& P = ph[hf]; const float x = P[4 * gi + 3]; const float y = shx<32>(x);
                    const float prev = hi ? y : yprev; PL[(hp * 64 + qi) * 17 + 8 * hf + 2 * gi + hi] = (P[4 * gi] + P[4 * gi + 1]) + (P[4 * gi + 2] + x) + prev; yprev = y; } }
            carry = yprev;
            __syncthreads();
#pragma unroll
            for (int q2 = 0; q2 < 2; ++q2) { const int idx = F.tid + 512 * q2, qq = idx >> 4, jl = idx & 15;
                IMP[qq * 128 + 16 * t + jl] = (PL[(0 * 64 + qq) * 17 + jl] + PL[(1 * 64 + qq) * 17 + jl]) + (PL[(2 * 64 + qq) * 17 + jl] + PL[(3 * 64 + qq) * 17 + jl]); }
#pragma unroll
            for (int hf = 0; hf < 2; ++hf) { bf16x8 vf[2][2]; vf_load<VSTR64>(vf, VT[0], lane, hf);
#pragma unroll
                for (int s = 0; s < 2; ++s) { const bf16x8 pa = packp(ph[hf], s * 8);
#pragma unroll
                    for (int d0 = 0; d0 < 2; ++d0) o[d0] = __builtin_amdgcn_mfma_f32_32x32x16_bf16(pa, vf[s][d0], o[d0], 0, 0, 0); } }
            __syncthreads();
        }
        const float g0 = GT[gto];
        float fr_[16]; bcast_rows(g0, F.lds, w, lane, fr_);
#pragma unroll
        for (int r = 0; r < 16; ++r) { const float f = fr_[r]; ocmp[0][r] = o[0][r] * f; ocmp[1][r] = o[1][r] * f; }
    }
#undef NSA_CMP_EXP
    {
        for (int i8 = 0; i8 < 8; i8 += 4) {
            unsigned long long mlo[4], mhi[4];
            if (cur < 16) {
#pragma unroll
                for (int k = 0; k < 4; ++k) { mlo[k] = (1ull << (cur + 1)) - 1ull; mhi[k] = 0ull; }
            } else {
                const int ja = lane, jb = lane + 64; const bool va = ja >= 1 && ja <= cur - 2, vb = jb <= cur - 2;
                unsigned ua[4], ub[4], thr[4];
#pragma unroll
                for (int k = 0; k < 4; ++k) { const int q = w * 8 + i8 + k; ua[k] = __float_as_uint(IMP[q * 128 + lane]); ub[k] = __float_as_uint(IMP[q * 128 + 64 + lane]); thr[k] = 0u; }
                for (int bit = 30; bit >= 0; --bit) {
#pragma unroll
                    for (int k = 0; k < 4; ++k) { const unsigned trial = thr[k] | (1u << bit);
                        const int cnt = __popcll(__ballot(va && ua[k] >= trial)) + __popcll(__ballot(vb && ub[k] >= trial)); if (cnt >= 13) thr[k] = trial; } }
#pragma unroll
                for (int k = 0; k < 4; ++k) {
                    const bool ga = va && ua[k] > thr[k], gb = vb && ub[k] > thr[k], ea = va && ua[k] == thr[k], eb = vb && ub[k] == thr[k];
                    const int need = 13 - (__popcll(__ballot(ga)) + __popcll(__ballot(gb)));
                    const unsigned long long ma = __ballot(ea), mb = __ballot(eb);
                    const int ra = (int)__builtin_amdgcn_mbcnt_hi((unsigned)(ma >> 32), __builtin_amdgcn_mbcnt_lo((unsigned)ma, 0u));
                    const int rb = __popcll(ma) + (int)__builtin_amdgcn_mbcnt_hi((unsigned)(mb >> 32), __builtin_amdgcn_mbcnt_lo((unsigned)mb, 0u));
                    const bool sa = ga || (ea && ra < need) || ja == 0 || ja == cur || ja == cur - 1;
                    const bool sb = gb || (eb && rb < need) || jb == cur || jb == cur - 1;
                    mlo[k] = __ballot(sa); mhi[k] = __ballot(sb); }
            }
            if (lane == 0) {
#pragma unroll
                for (int k = 0; k < 4; ++k) { const int q = w * 8 + i8 + k; MSK[q * 4 + 0] = (unsigned)mlo[k]; MSK[q * 4 + 1] = (unsigned)(mlo[k] >> 32); MSK[q * 4 + 2] = (unsigned)mhi[k]; MSK[q * 4 + 3] = (unsigned)(mhi[k] >> 32); } }
        }
        __syncthreads();
    }
#pragma unroll
    for (int r = 0; r < 16; ++r) { PARK[r * 64] = ocmp[0][r]; PARK[(16 + r) * 64] = ocmp[1][r]; }
    {
        const char* Kg = (const char*)(WSP(bf16, WS_KS) + (size_t)bg * S * 64); const char* Vg = (const char*)(WSP(bf16, WS_VS) + (size_t)bg * S * 64);
        f32x16 o[2]; float ls = 0.f;
#pragma unroll
        for (int r = 0; r < 16; ++r) { o[0][r] = 0.f; o[1][r] = 0.f; }
        const int NT = cur + 1;
        auto slc_compute = [&](int j, const LAS char* Kb, const LAS char* Vb) {
            const unsigned mw = MSK[qi * 4 + (j >> 5)]; const bool sel = (mw >> (j & 31)) & 1u;
            if (__ballot(sel) != 0ull) {
                if (cur - j >= 9) {
                    const float ci = sel ? cfar : NEGB;
                    attn_tile<64, KSTR64, VSTR64>(Kb, Vb, qf, o, lane, [&](int) { return ci; },
                        [&](f32x16& p, int) {
#pragma unroll
                            for (int r = 0; r < 16; ++r) p[r] = __builtin_amdgcn_exp2f(p[r]);
                            ls += sum16(p); });
                } else {
                    const float ci = sel ? -bound : NEGB;
                    const LAS float* tp = tsl + (639 - (qpos - 64 * j - 4 * hi));
                    attn_tile<64, KSTR64, VSTR64>(Kb, Vb, qf, o, lane, [&](int) { return ci; },
                        [&](f32x16& p, int hf) {
#pragma unroll
                            for (int r = 0; r < 16; ++r) { const int c = (r & 3) + 8 * (r >> 2) + 32 * hf; p[r] = __builtin_amdgcn_exp2f(p[r] + tp[c]); }
                            ls += sum16(p); });
                }
            } };
        TileRegs<128> krB, vrB;
        tile_load<128>(kr, Kg, F.tid); tile_load<128>(vr, Vg, F.tid);
        if (NT > 1) { tile_load<128>(krB, Kg + (size_t)8192, F.tid); tile_load<128>(vrB, Vg + (size_t)8192, F.tid); }
        tile_store<128, KSTR64>(kr, KT[0], F.tid); tile_store<128, VSTR64>(vr, VT[0], F.tid);
        __syncthreads();
        for (int j = 0; j < NT; j += 2) {
            if (j + 2 < NT) { tile_load<128>(kr, Kg + (size_t)(j + 2) * 8192, F.tid); tile_load<128>(vr, Vg + (size_t)(j + 2) * 8192, F.tid); }
            slc_compute(j, KT[0], VT[0]);
            if (j + 1 < NT) { tile_store<128, KSTR64>(krB, KT[1], F.tid); tile_store<128, VSTR64>(vrB, VT[1], F.tid); }
            __syncthreads();
            if (j + 1 >= NT) break;
            if (j + 3 < NT) { tile_load<128>(krB, Kg + (size_t)(j + 3) * 8192, F.tid); tile_load<128>(vrB, Vg + (size_t)(j + 3) * 8192, F.tid); }
            slc_compute(j + 1, KT[1], VT[1]);
            if (j + 2 < NT) { tile_store<128, KSTR64>(kr, KT[0], F.tid); tile_store<128, VSTR64>(vr, VT[0], F.tid); }
            __syncthreads();
        }
        ls = sum32x(ls); const float fs = ls > 0.f ? GT[gto + 1] / ls : 0.f;
        float fr_[16]; bcast_rows(fs, F.lds, w, lane, fr_);
#pragma unroll
        for (int r = 0; r < 16; ++r) { const float f = fr_[r]; PARK[r * 64] += o[0][r] * f; PARK[(16 + r) * 64] += o[1][r] * f; }
    }
    {
        const char* Kg = (const char*)(WSP(bf16, WS_KW) + (size_t)bg * S * 64); const char* Vg = (const char*)(WSP(bf16, WS_VW) + (size_t)bg * S * 64);
        f32x16 o[2]; float ls = 0.f;
#pragma unroll
        for (int r = 0; r < 16; ++r) { o[0][r] = 0.f; o[1][r] = 0.f; }
        const int j0 = cur >= 8 ? cur - 8 : 0;
        tile_load<128>(kr, Kg + (size_t)j0 * 8192, F.tid); tile_load<128>(vr, Vg + (size_t)j0 * 8192, F.tid);
        tile_store<128, KSTR64>(kr, KT[0], F.tid); tile_store<128, VSTR64>(vr, VT[0], F.tid);
        __syncthreads();
        for (int j = j0; j <= cur; ++j) { const int bi = (j - j0) & 1;
            if (j < cur) { tile_load<128>(kr, Kg + (size_t)(j + 1) * 8192, F.tid); tile_load<128>(vr, Vg + (size_t)(j + 1) * 8192, F.tid); }
            const LAS float* tp = twl + (639 - (qpos - 64 * j - 4 * hi));
            attn_tile<64, KSTR64, VSTR64>(KT[bi], VT[bi], qf, o, lane, [&](int) { return -bound; },
                [&](f32x16& p, int hf) {
#pragma unroll
                    for (int r = 0; r < 16; ++r) { const int c = (r & 3) + 8 * (r >> 2) + 32 * hf; p[r] = __builtin_amdgcn_exp2f(p[r] + tp[c]); }
                    ls += sum16(p); });
            if (j < cur) { tile_store<128, KSTR64>(kr, KT[bi ^ 1], F.tid); tile_store<128, VSTR64>(vr, VT[bi ^ 1], F.tid); }
            __syncthreads();
        }
        ls = sum32x(ls); const float fs = ls > 0.f ? GT[gto + 2] / ls : 0.f;
        float fr_[16]; bcast_rows(fs, F.lds, w, lane, fr_);
#pragma unroll
        for (int r = 0; r < 16; ++r) { const float f = fr_[r]; PARK[r * 64] += o[0][r] * f; PARK[(16 + r) * 64] += o[1][r] * f; }
    }
    bf16* Y = WSP(bf16, WS_Y);
#pragma unroll
    for (int r = 0; r < 16; ++r) { const int row = crow(r, hi); bf16* yp = Y + ((size_t)b * S + q0 + 32 * qs + row) * 1024 + 512 + h * 64 + (lane & 31);
        yp[0] = (bf16)(cvtpk(PARK[r * 64], 0.f) & 0xffff); yp[32] = (bf16)(cvtpk(PARK[(16 + r) * 64], 0.f) & 0xffff); }
}

__device__ __forceinline__ void mem_unit(Frame& F, int bh, int qb) {
    const int lane = F.lane, hi = lane >> 5, w = F.wave; const int b = bh >> 2, hm = bh & 3;
    const int tok = b * S + qb * 256 + 32 * w + (lane & 31);
    const float* CF = WSP(float, WS_CONST);
    const bf16* qp = WSP(bf16, WS_QMEM) + (size_t)tok * 256 + hm * 64; float qv[4][8]; float ss = 0.f;
#pragma unroll
    for (int s = 0; s < 4; ++s) { unpack8(*(const u32x4*)(qp + 16 * s + 8 * hi), qv[s]);
#pragma unroll
        for (int j = 0; j < 8; ++j) ss += qv[s][j] * qv[s][j]; }
    ss = sum32x(ss); const float rinv = 1.0f / sqrtf(ss * (1.0f / 64) + EPS) * (0.125f * LOG2E); float n2 = 0.f;
    bf16x8 qf[4];
#pragma unroll
    for (int s = 0; s < 4; ++s) {
#pragma unroll
        for (int j = 0; j < 8; ++j) { qv[s][j] *= rinv * F.in[26][16 * s + 8 * hi + j]; n2 += qv[s][j] * qv[s][j]; }
        qf[s] = __builtin_bit_cast(bf16x8, pack8f(qv[s])); }
    n2 = sum32x(n2); const float bound = sqrtf(n2) * CF[CF_KBMEM];
    LAS char* KT = (LAS char*)F.lds; LAS char* VT = (LAS char*)F.lds + 64 * KSTR64;
    const GAS char* Kg = uni_ptr((const char*)(WSP(bf16, WS_KVMR) + (size_t)b * 256 * 512 + hm * 64)); const GAS char* Vg = Kg + 512;
    const int trow = F.tid >> 3, tch = F.tid & 7; float gmk[8];
#pragma unroll
    for (int j = 0; j < 8; ++j) gmk[j] = F.in[27][8 * tch + j];
    f32x16 o[2]; float ls = 0.f;
#pragma unroll
    for (int r = 0; r < 16; ++r) { o[0][r] = 0.f; o[1][r] = 0.f; }
    TileRegs<128> kr, vr;
    for (int t = 0; t < 4; ++t) {
        __syncthreads();
        { const unsigned goff = (unsigned)(64 * t + trow) * 1024u + 16u * tch;
          kr.r[0] = *(const GAS u32x4*)(Kg + goff); vr.r[0] = *(const GAS u32x4*)(Vg + goff);
          float kv8[8]; unpack8(kr.r[0], kv8); float ssk = 0.f;
#pragma unroll
          for (int j = 0; j < 8; ++j) ssk += kv8[j] * kv8[j];
          ssk = grp8_sum(ssk); const float rk = 1.0f / sqrtf(ssk * (1.0f / 64) + EPS);
#pragma unroll
          for (int j = 0; j < 8; ++j) kv8[j] *= rk * gmk[j];
          kr.r[0] = pack8f(kv8); }
        tile_store<128, KSTR64>(kr, KT, F.tid); tile_store<128, VSTR64>(vr, VT, F.tid);
        __syncthreads();
        attn_tile<64, KSTR64, VSTR64>(KT, VT, qf, o, lane, [&](int) { return -bound; },
            [&](f32x16& p, int) {
#pragma unroll
                for (int r = 0; r < 16; ++r) p[r] = __builtin_amdgcn_exp2f(p[r]);
                ls += sum16(p); });
    }
    ls = sum32x(ls); const float linv = 1.0f / ls;
    bf16* O = WSP(bf16, WS_OMEM);
    float fr_[16]; bcast_rows(linv, F.lds, w, lane, fr_);
#pragma unroll
    for (int r = 0; r < 16; ++r) { const int row = crow(r, hi); const float f = fr_[r]; bf16* yp = O + ((size_t)b * S + qb * 256 + 32 * w + row) * 256 + hm * 64 + (lane & 31);
        yp[0] = (bf16)(cvtpk(o[0][r] * f, 0.f) & 0xffff); yp[32] = (bf16)(cvtpk(o[1][r] * f, 0.f) & 0xffff); }
}

__device__ __forceinline__ void tp_d(Frame& F) {
    LAS float* part = (LAS float*)F.lds;
    LAS float* ssqp = part + 4 * 2 * 32 * 33;
    LAS float* rin = ssqp + 256;
    LAS float* LG = (LAS float*)(F.lds + LDSX_OFF);
    LAS unsigned* lcnt = (LAS unsigned*)(F.lds + LDSX_OFF + 64 * 33 * 4);
    LAS unsigned* lbase = lcnt + 32;
    const float* rb = F.in[31];
    const bf16* XB = WSP(bf16, WS_XB); const bf16* WH = WSP(bf16, WS_WRH); const bf16* WL = WSP(bf16, WS_WRL);
    unsigned* cnt = (unsigned*)(F.ws + WS_CTL) + CW_CNT; int* ASG = WSP(int, WS_ASG);
    const int l = F.lane, t = l & 31, hi = l >> 5, tg = F.wave & 1, kq = F.wave >> 1;
    for (int m0 = F.bid * 64; m0 < NTOK; m0 += F.G * 64) {
        __syncthreads();
        if (F.tid < 32) lcnt[F.tid] = 0u;
        { f32x16 acc; float ss = 0.f;
#pragma unroll
          for (int r = 0; r < 16; ++r) acc[r] = 0.f;
          const bf16* xp = XB + (size_t)(m0 + 32 * tg + t) * D + 256 * kq + 8 * hi; const bf16* hp_ = WH + t * 1024 + 256 * kq + 8 * hi; const bf16* lp_ = WL + t * 1024 + 256 * kq + 8 * hi;
#pragma unroll 4
          for (int s = 0; s < 16; ++s) { const u32x4 xw = *(const u32x4*)(xp + 16 * s); const bf16x8 xb = __builtin_bit_cast(bf16x8, xw);
              const bf16x8 ah = *(const bf16x8*)(hp_ + 16 * s), al = *(const bf16x8*)(lp_ + 16 * s);
              acc = __builtin_amdgcn_mfma_f32_32x32x16_bf16(ah, xb, acc, 0, 0, 0); acc = __builtin_amdgcn_mfma_f32_32x32x16_bf16(al, xb, acc, 0, 0, 0);
              float xv[8]; unpack8(xw, xv);
#pragma unroll
              for (int j = 0; j < 8; ++j) ss += xv[j] * xv[j]; }
#pragma unroll
          for (int r = 0; r < 16; ++r) part[((kq * 2 + tg) * 32 + crow(r, hi)) * 33 + t] = acc[r];
          ss = sum32x(ss); if (hi == 0) ssqp[kq * 64 + 32 * tg + t] = ss; }
        __syncthreads();
        if (F.tid < 64) rin[F.tid] = 1.0f / sqrtf(((ssqp[F.tid] + ssqp[64 + F.tid]) + (ssqp[128 + F.tid] + ssqp[192 + F.tid])) * (1.0f / D) + EPS);
        __syncthreads();
        { const int tt = F.tid & 63, e0 = (F.tid >> 6) * 4, g2 = tt >> 5, t2 = tt & 31; const float rv = rin[tt];
#pragma unroll
          for (int j = 0; j < 4; ++j) { const int e = e0 + j; const float a = (part[((0 * 2 + g2) * 32 + e) * 33 + t2] + part[((1 * 2 + g2) * 32 + e) * 33 + t2]) + (part[((2 * 2 + g2) * 32 + e) * 33 + t2] + part[((3 * 2 + g2) * 32 + e) * 33 + t2]);
              LG[tt * 33 + e] = a * rv + rb[e]; } }
#pragma unroll 4
        for (int q = 0; q < 16; ++q) { const int c = F.tid + 512 * q, row = c >> 7, ch = c & 127; float xv[8]; unpack8(*(const u32x4*)(XB + (size_t)(m0 + row) * D + 8 * ch), xv); const float rv = rin[row];
#pragma unroll
            for (int j = 0; j < 8; ++j) xv[j] *= rv;
            *(u32x4*)(WSP(bf16, WS_Y) + (size_t)(m0 + row) * D + 8 * ch) = pack8f(xv); }
        __syncthreads();
        if (F.wave == 0) {
            const int m = m0 + l; float lg[32];
#pragma unroll
            for (int e = 0; e < 32; ++e) lg[e] = LG[l * 33 + e];
            int idx[4]; float val[4];
#pragma unroll
            for (int k = 0; k < 4; ++k) { float bv = -3.0e38f; int bi = 0;
#pragma unroll
                for (int e = 0; e < 32; ++e) { const bool taken = (k > 0 && idx[0] == e) || (k > 1 && idx[1] == e) || (k > 2 && idx[2] == e); if (!taken && lg[e] > bv) { bv = lg[e]; bi = e; } }
                idx[k] = bi; val[k] = bv; }
            const float e1 = __expf(val[1] - val[0]), e2 = __expf(val[2] - val[0]), e3 = __expf(val[3] - val[0]); const float inv = 1.0f / (1.0f + e1 + e2 + e3);
            const float ge[4] = {inv, e1 * inv, e2 * inv, e3 * inv};
            unsigned lp[4];
#pragma unroll
            for (int k = 0; k < 4; ++k) lp[k] = atomicAdd((unsigned*)&lcnt[idx[k]], 1u);
            LDS_WAIT(); asm volatile("" ::: "memory");
            if (l < 32) { const unsigned c = lcnt[l]; lbase[l] = c ? atomicAdd(&cnt[l], c) : 0u; }
            LDS_WAIT(); asm volatile("" ::: "memory");
#pragma unroll
            for (int k = 0; k < 4; ++k) { ASG[(m * 4 + k) * 2 + 0] = idx[k] | ((int)(lbase[idx[k]] + lp[k]) << 8); ASG[(m * 4 + k) * 2 + 1] = __float_as_int(ge[k]); }
        }
    }
    __syncthreads();
}
__device__ __forceinline__ void moe_tables(Frame& F, LAS int* mt, LAS int* ro) {
    __syncthreads();
    if (F.tid == 0) { unsigned* cnt = (unsigned*)(F.ws + WS_CTL) + CW_CNT; int acc = 0;
        for (int e = 0; e < 32; ++e) { const int c = (int)__hip_atomic_load(cnt + e, __ATOMIC_RELAXED, __HIP_MEMORY_SCOPE_AGENT); const int t = (c + 255) >> 8; mt[e] = t; ro[e] = acc; acc += t * 256; } }
    __syncthreads();
}
__device__ __forceinline__ void moe_gather(Frame& F) {
    LAS int* mt = (LAS int*)(F.lds + LDSX_OFF + 1024); LAS int* ro = mt + 32;
    moe_tables(F, mt, ro);
    const int* ASG = WSP(int, WS_ASG); const bf16* XB = WSP(bf16, WS_Y); bf16* A1 = WSP(bf16, WS_A1);
    for (int m = F.gw; m < NTOK; m += F.ngw) {
        const u32x4* src = (const u32x4*)(XB + (size_t)m * D) + F.lane; const u32x4 a = src[0], b = src[64];
#pragma unroll
        for (int k = 0; k < 4; ++k) { const int pe = ASG[(m * 4 + k) * 2]; const int e = pe & 255, pos = pe >> 8; const size_t row = (size_t)ro[e] + pos;
            u32x4* dst = (u32x4*)(A1 + row * D) + F.lane; dst[0] = a; dst[64] = b; }
    }
}
__device__ __forceinline__ void moe_combine(Frame& F) {
    LAS int* mt = (LAS int*)(F.lds + LDSX_OFF + 1024); LAS int* ro = mt + 32;
    moe_tables(F, mt, ro);
    const int* ASG = WSP(int, WS_ASG); const bf16* Yb = WSP(bf16, WS_A1);
    for (int m = F.gw; m < NTOK; m += F.ngw) {
        f32x4* op = (f32x4*)(F.out + (size_t)m * D) + 4 * F.lane; f32x4 o[4];
        { const u32x4* xp = (const u32x4*)(WSP(bf16, WS_XB) + (size_t)m * D + 16 * F.lane); float x0[8], x1[8]; unpack8(xp[0], x0); unpack8(xp[1], x1);
          o[0] = (f32x4){x0[0], x0[1], x0[2], x0[3]}; o[1] = (f32x4){x0[4], x0[5], x0[6], x0[7]}; o[2] = (f32x4){x1[0], x1[1], x1[2], x1[3]}; o[3] = (f32x4){x1[4], x1[5], x1[6], x1[7]}; }
#pragma unroll
        for (int k = 0; k < 4; ++k) { const int pe = ASG[(m * 4 + k) * 2]; const float gw = __int_as_float(ASG[(m * 4 + k) * 2 + 1]); const int e = pe & 255, pos = pe >> 8; const size_t row = (size_t)ro[e] + pos;
            const u32x4* yp = (const u32x4*)(Yb + row * D + 16 * F.lane); float y0[8], y1[8]; unpack8(yp[0], y0); unpack8(yp[1], y1);
            o[0] += gw * (f32x4){y0[0], y0[1], y0[2], y0[3]}; o[1] += gw * (f32x4){y0[4], y0[5], y0[6], y0[7]};
            o[2] += gw * (f32x4){y1[0], y1[1], y1[2], y1[3]}; o[3] += gw * (f32x4){y1[4], y1[5], y1[6], y1[7]}; }
#pragma unroll
        for (int j = 0; j < 4; ++j) op[j] = o[j];
    }
}

#ifndef LB
#define LB 512
#endif
__global__ void __launch_bounds__(LB) fwd_kernel(Args args) {
    extern __shared__ __attribute__((aligned(16))) unsigned char lds_raw[];
    Frame F;
    F.lds = (LAS unsigned char*)lds_raw; F.tid = threadIdx.x; F.lane = F.tid & 63; F.wave = __builtin_amdgcn_readfirstlane(F.tid >> 6);
    F.G = gridDim.x; F.bid = blockIdx.x; F.gw = F.bid * 8 + F.wave; F.ngw = F.G * 8;
    F.in = args.in; F.out = args.out; F.ws = args.ws;
    for (int u = F.tid; u < 128; u += 512) ((LAS unsigned*)(F.lds + LDSCTL_OFF))[u] = 0u;
    __syncthreads();
    unsigned* ctl = (unsigned*)(F.ws + WS_CTL);
    XcdBarrier bar = xcd_barrier_post(ctl + CW_BAR, (volatile LAS unsigned*)(F.lds + LDSCTL_OFF) + 8);
#ifndef PHM
#define PHM 0xFFFFFFFFu
#endif
#define RELAUNDER() do { int t_ = F.wave * 64 + (int)lane_id_opaque(); F.tid = t_; F.lane = t_ & 63; } while (0)
#define PH(n) RELAUNDER(); if (PHM & (1u << (n)))
#ifndef PRB_A
#define PRB_A -1
#endif
#ifndef PRB_B
#define PRB_B -1
#endif
    volatile LAS unsigned long long* TS = (volatile LAS unsigned long long*)(F.lds + LDSCTL_OFF + 128);
#define STAMP(k) do { if (PRB_A >= 0 && blockIdx.x == 0 && F.tid == 0) TS[k] = __builtin_amdgcn_s_memrealtime(); } while (0)
#define GRID_BAR() do { RELAUNDER(); xcd_barrier(bar, F.tid == 0); } while (0)
    float* RS = WSP(float, WS_RS);
    STAMP(0); PH(0) { FSTAMP(F, 30); FSTAMP(F, 31); PH(21) p0_prologue(F); FSTAMP(F, 34); } GRID_BAR(); STAMP(1); FSTAMP(F, 35);
#ifdef DUMMY_STREAM
    STAMP(30);
    { f32x4 acc4 = {0.f, 0.f, 0.f, 0.f}; const f32x4* p1 = (const f32x4*)F.in[32]; const f32x4* p2 = (const f32x4*)F.in[34];
      const size_t n1 = (size_t)32 * 1024 * 2048 / 4, n2 = (size_t)32 * 1024 * 1024 / 4; const size_t gt = (size_t)F.bid * 512 + F.tid, gs_ = (size_t)F.G * 512;
      for (size_t i = gt; i < n1; i += 4 * gs_) { acc4 += p1[i]; if (i + gs_ < n1) acc4 += p1[i + gs_]; if (i + 2 * gs_ < n1) acc4 += p1[i + 2 * gs_]; if (i + 3 * gs_ < n1) acc4 += p1[i + 3 * gs_]; }
      for (size_t i = gt; i < n2; i += 4 * gs_) { acc4 += p2[i]; if (i + gs_ < n2) acc4 += p2[i + gs_]; if (i + 2 * gs_ < n2) acc4 += p2[i + 2 * gs_]; if (i + 3 * gs_ < n2) acc4 += p2[i + 3 * gs_]; }
      WSP(float, WS_CONST)[4096 + (F.bid * 512 + F.tid) % 2048] = acc4.x + acc4.y + acc4.z + acc4.w; }
    GRID_BAR(); STAMP(31);
#endif
    PH(1) { pg8::Gemm g{WSP(bf16, WS_XB), WSP(bf16, WS_WIN), 1024, 1024, 1024}; pg8::StaticOrder So; So.init(NTOK, NINP, F.G, F.bid);
      pg8::EpiScaleBf16 E{WSP(bf16, WS_PB), NINP, RS + 0, 4}; pg8::gemm_phase(F.lds, g, So, E, F.tid); }
    PH(1) if (F.bid >= F.G - 4) { pg8::Gemm g{WSP(bf16, WS_MEMB), WSP(bf16, WS_WMKVT), 1024, 1024, 1024}; pg8::StaticOrder So; So.init(512, 512, 4, F.bid - (F.G - 4));
      pg8::EpiScaleBf16 E{WSP(bf16, WS_KVMR), 512, WSP(float, WS_RSM), 1}; pg8::gemm_phase(F.lds, g, So, E, F.tid); }
    GRID_BAR(); STAMP(2);
    PH(3) { pg8::Gemm g{WSP(bf16, WS_PB) + C_CQ, WSP(bf16, WS_WUQ), NINP, 256, 256}; pg8::StaticOrder So; So.init(NTOK, 768, F.G, F.bid);
      pg8::EpiScaleBf16 E{WSP(bf16, WS_QRAW), 768, nullptr, 0}; pg8::gemm_phase(F.lds, g, So, E, F.tid); }
    PH(3) { pg8::Gemm g{WSP(bf16, WS_PB) + C_CKV, WSP(bf16, WS_WUKV), NINP, 256, 256}; pg8::StaticOrder So; So.init(NTOK, 1024, F.G, F.bid);
      pg8::EpiScaleBf16 E{WSP(bf16, WS_KVRAW), 1024, nullptr, 0}; pg8::gemm_phase(F.lds, g, So, E, F.tid); }
    STAMP(3);
    PH(2) tp_a(F); PH(17) compress_phase(F); GRID_BAR(); STAMP(4); STAMP(5);
    PH(4) tp_b(F); GRID_BAR(); STAMP(6);
    { const int vcu = (F.G % 8 == 0) ? (F.bid % 8) * (F.G / 8) + F.bid / 8 : F.bid;
      PH(5) for (int v = vcu; v < 256; v += F.G) { const int bh = v >> 4, sidx = v & 15; mla_unit(F, bh, 31 - sidx); mla_unit(F, bh, sidx); }
      STAMP(7);
      PH(18) for (int v = vcu; v < 256; v += F.G) { const int bg = v >> 6, sidx = v & 63; nsa_unit(F, bg, 127 - sidx, true); nsa_unit(F, bg, sidx, false); } }
    GRID_BAR(); STAMP(8);
    PH(6) tp_c0(F); GRID_BAR(); STAMP(9);
    PH(7) { pg8::Gemm g{WSP(bf16, WS_Y), WSP(bf16, WS_WOUT), 1024, 1024, 1024}; pg8::StaticOrder So; So.init(NTOK, 1024, F.G, F.bid);
      pg8::EpiAddBf16Ssq E{WSP(bf16, WS_XB), 1024, WSP(float, WS_KMEM)}; pg8::gemm_phase(F.lds, g, So, E, F.tid); }
    GRID_BAR(); STAMP(10); STAMP(11);
    PH(9) { pg8::Gemm g{WSP(bf16, WS_XB), WSP(bf16, WS_WMQ), 1024, 1024, 1024}; pg8::StaticOrder So; So.init(NTOK, 256, F.G, F.bid);
      pg8::EpiSsqScaleBf16 E{WSP(bf16, WS_QMEM), 256, WSP(float, WS_KMEM)}; pg8::gemm_phase(F.lds, g, So, E, F.tid); }
    GRID_BAR(); STAMP(12);
    PH(10) for (int v = F.bid; v < 256; v += F.G) mem_unit(F, v >> 5, v & 31);
    GRID_BAR(); STAMP(13);
    PH(11) { pg8::Gemm g{WSP(bf16, WS_OMEM), WSP(bf16, WS_WMO), 256, 256, 256}; pg8::StaticOrder So; So.init(NTOK, 1024, F.G, F.bid);
      pg8::EpiAddBf16 E{WSP(bf16, WS_XB), 1024}; pg8::gemm_phase(F.lds, g, So, E, F.tid); }
    GRID_BAR(); STAMP(14);
    PH(12) tp_d(F); GRID_BAR(); STAMP(15);
    PH(13) moe_gather(F); GRID_BAR(); STAMP(16);
    { LAS int* mt = (LAS int*)(F.lds + LDSX_OFF + 1024); LAS int* ro = mt + 32;
      pg8::MoeOrder Mo; Mo.xl = F.bid & 7; Mo.cl = F.bid >> 3; Mo.nl = F.G >> 3;
#pragma unroll
      for (int s = 0; s < 4; ++s) { Mo.mt[s] = mt[Mo.xl + 8 * s]; Mo.tp[s] = ro[Mo.xl + 8 * s] >> 8; }
      PH(14) { Mo.ntn = 8; pg8::Gemm g{WSP(bf16, WS_A1), WSP(bf16, WS_WGU), 1024, 1024, 1024}; pg8::EpiSwiglu E{WSP(bf16, WS_ACT), F.in[33]}; pg8::gemm_phase(F.lds, g, Mo, E, F.tid); }
      GRID_BAR(); STAMP(17);
      PH(15) { Mo.ntn = 4; pg8::Gemm g{WSP(bf16, WS_ACT), WSP(bf16, WS_WD), 1024, 1024, 1024}; pg8::EpiDown E{WSP(bf16, WS_A1), F.in[35]}; pg8::gemm_phase(F.lds, g, Mo, E, F.tid); }
      GRID_BAR(); STAMP(18); }
    PH(16) moe_combine(F);
    STAMP(19);
    if (PRB_A >= 0 && blockIdx.x == 0 && F.tid == 0) {
        const unsigned long long ta = TS[PRB_A + 1] - TS[PRB_A];
        unsigned long long extra = 8ull * ta;
        if (PRB_B >= 0) { const unsigned long long tb = TS[PRB_B + 1] - TS[PRB_B]; extra += ((tb + 500ull) / 1000ull) * 200000ull; }
        const unsigned long long t0 = __builtin_amdgcn_s_memrealtime();
        while (__builtin_amdgcn_s_memrealtime() - t0 < extra) __builtin_amdgcn_s_sleep(8);
    }
}

extern "C" void kernel_launch(void* const* d_in, const int* in_sizes, int n_in, void* d_out, int out_size, void* d_ws, size_t ws_size, hipStream_t stream) {
    static int grid = 0;
    if (grid == 0) {
        if (n_in != 36 || out_size != NTOK * D || ws_size < WS_END) { fprintf(stderr, "kernel_launch: unexpected shapes (n_in %d out %d ws %zu need %zu)\n", n_in, out_size, ws_size, (size_t)WS_END); grid = -1; return; }
        int dev = 0, cus = 0;
        if (hipGetDevice(&dev) != hipSuccess || hipDeviceGetAttribute(&cus, hipDeviceAttributeMultiprocessorCount, dev) != hipSuccess) { grid = -1; return; }
        if (hipFuncSetAttribute((const void*)fwd_kernel, hipFuncAttributeMaxDynamicSharedMemorySize, LDS_BYTES) != hipSuccess) { fprintf(stderr, "kernel_launch: hipFuncSetAttribute failed\n"); grid = -1; return; }
        (void)hipGetLastError();
        grid = cus >= 256 ? 256 : (cus / 8) * 8;
    }
    if (grid <= 0) return;
    (void)hipMemsetAsync((char*)d_ws + WS_CTL, 0, CTL_BYTES, stream);
    Args a{};
    for (int i = 0; i < 36; ++i) a.in[i] = (const float*)d_in[i];
    a.out = (float*)d_out; a.ws = (unsigned char*)d_ws;
    hipLaunchKernelGGL(fwd_kernel, dim3(grid), dim3(512), LDS_BYTES, stream, a);
}
```

```cpp
#include <hip/hip_runtime.h>
#include <cstdint>
#include <cstdio>

#define GAS __attribute__((address_space(1)))
#define LAS __attribute__((address_space(3)))
typedef unsigned short bf16;
typedef short bf16x8 __attribute__((ext_vector_type(8)));
typedef short s16x4 __attribute__((ext_vector_type(4)));
typedef float f32x4 __attribute__((ext_vector_type(4)));
typedef float f32x16 __attribute__((ext_vector_type(16)));
typedef unsigned u32x4 __attribute__((ext_vector_type(4)));
typedef unsigned u32x2 __attribute__((ext_vector_type(2)));
typedef float f32x2_t __attribute__((ext_vector_type(2)));
typedef __bf16 bf16x2_t __attribute__((ext_vector_type(2)));

constexpr int NB = 2, S = 8192, D = 1024, NTOK = NB * S;
constexpr int NINP = 1792;
constexpr int C_CQ = 0, C_CKV = 256, C_KR = 384, C_QN = 416, C_KC = 928, C_VC = 1056, C_KS = 1184, C_VS = 1312, C_KW = 1440, C_VW = 1568, C_GT = 1696;
constexpr float EPS = 1e-6f;
constexpr float LOG2E = 1.4426950408889634f;
constexpr int NEXP = 32, MROWS = 65536 + 32 * 256;

constexpr size_t MiB = 1u << 20;
constexpr size_t al256(size_t x) { return (x + 255) & ~(size_t)255; }
constexpr size_t WS_CTL = 0, CTL_BYTES = 1 * MiB;
constexpr size_t WS_CONST = 1 * MiB;
constexpr size_t WS_WIN = 2 * MiB;
constexpr size_t WS_WUQ = WS_WIN + al256((size_t)NINP * 1024 * 2);
constexpr size_t WS_WUKV = WS_WUQ + al256((size_t)768 * 256 * 2);
constexpr size_t WS_WOUT = WS_WUKV + al256((size_t)1024 * 256 * 2);
constexpr size_t WS_WMQ = WS_WOUT + al256((size_t)1024 * 1024 * 2);
constexpr size_t WS_WMO = WS_WMQ + al256((size_t)256 * 1024 * 2);
constexpr size_t WS_W1T = WS_WMO + al256((size_t)1024 * 256 * 2);
constexpr size_t WS_WMKVT = WS_W1T + al256((size_t)2 * 128 * 2048 * 2);
constexpr size_t WS_MEMB = WS_WMKVT + al256((size_t)512 * 1024 * 2);
constexpr size_t WS_KVMR = WS_MEMB + al256((size_t)512 * 1024 * 2);
constexpr size_t WS_RSM = WS_KVMR + al256((size_t)512 * 512 * 2);
constexpr size_t WS_WRH = WS_RSM + 4096;
constexpr size_t WS_WRL = WS_WRH + 65536;
static_assert(WS_WRL + 65536 <= 16 * MiB, "small-weight region");
constexpr size_t WS_WGU = 16 * MiB;
constexpr size_t WS_WD = WS_WGU + 128 * MiB;
constexpr size_t WS_XB = WS_WD + 64 * MiB;
constexpr size_t WS_PB = WS_XB + 32 * MiB;
constexpr size_t WS_QRAW = WS_PB + 56 * MiB;
constexpr size_t WS_KVRAW = WS_QRAW + 24 * MiB;
constexpr size_t WS_QM = WS_KVRAW + 32 * MiB;
constexpr size_t WS_KM = WS_QM + 24 * MiB;
constexpr size_t WS_VM = WS_KM + 24 * MiB;
constexpr size_t WS_QN = WS_VM + 16 * MiB;
constexpr size_t WS_KS = WS_QN + 16 * MiB;
constexpr size_t WS_VS = WS_KS + 4 * MiB;
constexpr size_t WS_KW = WS_VS + 4 * MiB;
constexpr size_t WS_VW = WS_KW + 4 * MiB;
constexpr size_t WS_KCMP = WS_VW + 4 * MiB;
constexpr size_t WS_VCMP = WS_KCMP + 1 * MiB;
constexpr size_t WS_KMEM = WS_VCMP + 1 * MiB;
constexpr size_t WS_VMEM = WS_KMEM + 1 * MiB;
constexpr size_t WS_QBM = WS_VMEM + 1 * MiB;
constexpr size_t WS_QBN = WS_QBM + 1 * MiB;
constexpr size_t WS_RS = WS_QBN + 1 * MiB;
constexpr size_t WS_GATE = WS_RS + 1 * MiB;
constexpr size_t WS_ASG = WS_GATE + 2 * MiB;
constexpr size_t WS_Y = WS_ASG + 1 * MiB;
constexpr size_t WS_QMEM = WS_Y + 32 * MiB;
constexpr size_t WS_OMEM = WS_QMEM + 8 * MiB;
constexpr size_t WS_A1 = WS_OMEM + 8 * MiB;
constexpr size_t WS_ACT = WS_A1 + 144 * MiB;
constexpr size_t WS_END = WS_ACT + 144 * MiB;
constexpr int CW_BAR = 4096;
constexpr int CW_CNT = 16384;
constexpr int CF_CPP = 4096;
constexpr int CF_KBM = 0, CF_KBN = 1, CF_KBMEM = 2, CF_MAXB2 = 8  , CF_BIAS2 = 64  , CF_LUT = 512  , CF_CPOSK = 1024  , CF_CPOSV = 1152  ;

constexpr int RING_BYTES = 131072;
constexpr int LDS_BYTES = 147456;
constexpr int LDSX_OFF = RING_BYTES + 1024;
constexpr int LDSCTL_OFF = LDS_BYTES - 1024;

__device__ __forceinline__ float bf2f(unsigned v) { return __uint_as_float(v << 16); }
__device__ __forceinline__ unsigned cvtpk(float lo, float hi) { f32x2_t v = {lo, hi}; bf16x2_t b = __builtin_convertvector(v, bf16x2_t); return __builtin_bit_cast(unsigned, b); }
__device__ __forceinline__ unsigned lane_id_opaque() { unsigned r; asm volatile("v_mbcnt_lo_u32_b32 %0, -1, 0\n\tv_mbcnt_hi_u32_b32 %0, -1, %0" : "=v"(r)); return r; }
template <int M> __device__ __forceinline__ float shx(float v) {
    if constexpr (M < 32) { return __int_as_float(__builtin_amdgcn_ds_swizzle(__float_as_int(v), (M << 10) | 0x1f)); }
    else { auto r = __builtin_amdgcn_permlane32_swap(__float_as_uint(v), __float_as_uint(v), false, false);
           const bool lo = lane_id_opaque() < 32u; return __uint_as_float(lo ? r[1] : r[0]); }
}
template <int M> __device__ __forceinline__ int shxi(int v) { return __float_as_int(shx<M>(__int_as_float(v))); }
__device__ __forceinline__ float sum32x(float v) { auto r = __builtin_amdgcn_permlane32_swap(__float_as_uint(v), __float_as_uint(v), false, false); return __uint_as_float(r[0]) + __uint_as_float(r[1]); }
__device__ __forceinline__ float wave_sum(float v) {
    v += shx<1>(v); v += shx<2>(v); v += shx<4>(v); v += shx<8>(v); v += shx<16>(v); return sum32x(v);
}
__device__ __forceinline__ float wave_max(float v) {
    v = fmaxf(v, shx<1>(v)); v = fmaxf(v, shx<2>(v)); v = fmaxf(v, shx<4>(v)); v = fmaxf(v, shx<8>(v)); v = fmaxf(v, shx<16>(v)); return fmaxf(v, shx<32>(v));
}
__device__ __forceinline__ float grp8_sum(float v) { v += shx<1>(v); v += shx<2>(v); v += shx<4>(v); return v; }
#define LDS_WAIT() asm volatile("s_waitcnt lgkmcnt(0)" ::: "memory")
#define VM_WAIT() asm volatile("s_waitcnt vmcnt(0)" ::: "memory")

namespace pg8 {
constexpr int BM = 256, BK = 64, HALF = 128, HTB = HALF * BK * 2, STAGE_BYTES = 8 * HTB, NXCD = 8, WGM = 8;
__host__ __device__ __forceinline__ int lds_byte(int r, int c) { const int st = (r >> 4) * 2 + (c >> 5), rr = r & 15, cc = c & 31, ob = rr * 64 + cc * 2; return st * 1024 + (ob ^ (((ob >> 9) & 1) << 5)); }
__host__ __device__ __forceinline__ void stage_rc(int b, int& R, int& C) { const int st = b / 1024, sb = b % 1024, swz = sb ^ (((sb >> 9) & 1) << 5); R = (st >> 1) * 16 + swz / 64; C = (st & 1) * 32 + (swz % 64) / 2; }
__host__ __device__ __forceinline__ int perm32(int rho) { const int n = rho >> 4, i = rho & 15; return 8 * (i >> 2) + 4 * n + (i & 3); }
struct Unit { int pm, pn, aux; };
struct Gemm { const bf16* A; const bf16* Bt; int lda, ldb, K; };
struct StaticOrder {
    int nM, nN, nwg, G, c;
    __device__ void init(int M, int N, int G_, int c_) { nM = M / BM; nN = N / BM; nwg = nM * nN; G = G_; c = c_; }
    __device__ bool next(int i, Unit& u) const {
        const long L = (long)i * G + c; if (L >= nwg) return false;
        int wgid = (int)L; { const int q = nwg / NXCD, r = nwg % NXCD, xcd = wgid % NXCD, off = wgid / NXCD; wgid = (xcd < r ? xcd * (q + 1) : r * (q + 1) + (xcd - r) * q) + off; }
        const int nig = WGM * nN, gid = wgid / nig, fm = gid * WGM, gsz = (nM - fm) < WGM ? (nM - fm) : WGM;
        u.pm = fm + ((wgid % nig) % gsz); u.pn = (wgid % nig) / gsz; u.aux = 0; return true;
    }
};
struct MoeOrder {
    int ntn, xl, cl, nl; int mt[4], tp[4];
    __device__ bool next(int i, Unit& u) const {
        int L = i * nl + cl;
#pragma unroll
        for (int s = 0; s < 4; ++s) { const int nu = mt[s] * ntn; if (L < nu) { const int e = xl + 8 * s; u.pm = tp[s] + L % mt[s]; u.pn = e * ntn + L / mt[s]; u.aux = e; return true; } L -= nu; }
        return false;
    }
};
template <class Epi, class Sched>
__device__ __forceinline__ void gemm_phase(LAS unsigned char* lds, const Gemm g, const Sched& S, const Epi& E, int tid_in) {
    int tid_ = tid_in; asm volatile("" : "+v"(tid_));
    const int tid = tid_, wid = __builtin_amdgcn_readfirstlane(tid >> 6), lane = tid & 63, wr = wid >> 2, wc = wid & 3, fr = lane & 15, fq = lane >> 4;
    const int K = g.K, nt = K / BK;
    unsigned voffA[2], voffB[2];
#pragma unroll
    for (int i = 0; i < 2; ++i) { int R, C; stage_rc(tid * 16 + i * 8192, R, C); const int Rb = Epi::PERM ? ((R & ~31) + perm32(R & 31)) : R;
        voffA[i] = (unsigned)(R * g.lda + C) * 2u; voffB[i] = (unsigned)(Rb * g.ldb + C) * 2u; }
    const size_t kstep = (size_t)(BK * 2);
    const size_t hstepA = (size_t)HALF * g.lda * 2, hstepB = (size_t)HALF * g.ldb * 2;
    const size_t tstepA = 2 * hstepA, tstepB = 2 * hstepB;
    const unsigned ldsw = (unsigned)wid * 1024u;
    const int aoff = lds_byte(wr * 64 + fr, fq * 8), boff = lds_byte(wc * 32 + fr, fq * 8);
#define PG8_SA(b, h) (((b) * 2 + (h)) * HTB)
#define PG8_SB(b, h) ((4 + (b) * 2 + (h)) * HTB)
#define PG8_STAGE(bufoff, gbase, voff) do { _Pragma("unroll") for (int _i = 0; _i < 2; ++_i) \
        __builtin_amdgcn_global_load_lds((const unsigned*)((const char*)(gbase) + (voff)[_i]), (LAS unsigned*)(lds + (bufoff) + ldsw + _i * 8192), 16, 0, 0); } while (0)
#define PG8_LDA(dst, b, h) do { _Pragma("unroll") for (int m = 0; m < 4; ++m) _Pragma("unroll") for (int k = 0; k < 2; ++k) dst[m][k] = *(const LAS bf16x8*)(lds + PG8_SA(b, h) + aoff + m * 2048 + k * 1024); } while (0)
#define PG8_LDB(dst, b, h) do { _Pragma("unroll") for (int n = 0; n < 2; ++n) _Pragma("unroll") for (int k = 0; k < 2; ++k) dst[n][k] = *(const LAS bf16x8*)(lds + PG8_SB(b, h) + boff + n * 2048 + k * 1024); } while (0)
#define PG8_MMA(ai, bj, At, Bt) do { __builtin_amdgcn_s_setprio(1); _Pragma("unroll") for (int m = 0; m < 4; ++m) _Pragma("unroll") for (int n = 0; n < 2; ++n) _Pragma("unroll") for (int k = 0; k < 2; ++k) \
        acc[ai][bj][m][n] = __builtin_amdgcn_mfma_f32_16x16x32_bf16(Bt[n][k], At[m][k], acc[ai][bj][m][n], 0, 0, 0); __builtin_amdgcn_s_setprio(0); } while (0)
#define PG8_WAIT_V(n) asm volatile("s_waitcnt vmcnt(" #n ")" ::: "memory")
#define PG8_WAIT_L(n) asm volatile("s_waitcnt lgkmcnt(" #n ")" ::: "memory")
#define PG8_BAR __builtin_amdgcn_s_barrier()
#define PG8_SCHED __builtin_amdgcn_sched_barrier(0)
    Unit cur, nxt; int ui = 0;
    if (!S.next(0, cur)) return;
    f32x4 acc[2][2][4][2];
#pragma unroll
    for (int a = 0; a < 2; ++a)
#pragma unroll
        for (int b = 0; b < 2; ++b)
#pragma unroll
            for (int m = 0; m < 4; ++m)
#pragma unroll
                for (int n = 0; n < 2; ++n) acc[a][b][m][n] = (f32x4){0.f, 0.f, 0.f, 0.f};
    bf16x8 At[4][2], B0[2][2], B1[2][2];
    const char* cA = (const char*)g.A + (size_t)cur.pm * tstepA; const char* cB = (const char*)g.Bt + (size_t)cur.pn * tstepB;
    PG8_STAGE(PG8_SB(0, 0), cB, voffB); PG8_STAGE(PG8_SB(0, 1), cB + hstepB, voffB); PG8_STAGE(PG8_SA(0, 0), cA, voffA); PG8_STAGE(PG8_SA(0, 1), cA + hstepA, voffA);
    if (wr == 1) PG8_BAR;
    PG8_WAIT_V(2); PG8_BAR;
    PG8_STAGE(PG8_SB(1, 0), cB + kstep, voffB); PG8_STAGE(PG8_SA(1, 0), cA + kstep, voffA); PG8_STAGE(PG8_SB(1, 1), cB + hstepB + kstep, voffB);
    PG8_WAIT_V(6); PG8_BAR;
    for (;;) {
        const bool has_next = S.next(ui + 1, nxt);
        const char* nA = has_next ? (const char*)g.A + (size_t)nxt.pm * tstepA : cA; const char* nB = has_next ? (const char*)g.Bt + (size_t)nxt.pn * tstepB : cB;
#pragma unroll 1
        for (int t = 0; t < nt; t += 2) {
            const bool last = (t == nt - 2);
            const char* a1 = cA + (size_t)(t + 1) * kstep;
            const char* a2 = last ? nA : cA + (size_t)(t + 2) * kstep; const char* b2 = last ? nB : cB + (size_t)(t + 2) * kstep;
            const char* a3 = a2 + kstep; const char* b3 = b2 + kstep;
            PG8_LDB(B0, 0, 0); PG8_LDB(B1, 0, 1); PG8_SCHED; PG8_LDA(At, 0, 0); PG8_STAGE(PG8_SA(1, 1), a1 + hstepA, voffA);
            PG8_WAIT_V(8); PG8_WAIT_L(0); PG8_BAR; PG8_MMA(0, 0, At, B0); PG8_MMA(0, 1, At, B1); PG8_BAR; PG8_SCHED;
            PG8_LDA(At, 0, 1); PG8_STAGE(PG8_SB(0, 0), b2, voffB); PG8_STAGE(PG8_SB(0, 1), b2 + hstepB, voffB); PG8_STAGE(PG8_SA(0, 0), a2, voffA);
            PG8_WAIT_V(8); PG8_WAIT_L(0); PG8_BAR; PG8_MMA(1, 0, At, B0); PG8_MMA(1, 1, At, B1); PG8_BAR; PG8_SCHED;
            PG8_LDB(B0, 1, 0); PG8_LDB(B1, 1, 1); PG8_SCHED; PG8_LDA(At, 1, 0); PG8_STAGE(PG8_SA(0, 1), a2 + hstepA, voffA);
            PG8_WAIT_V(8); PG8_WAIT_L(0); PG8_BAR; PG8_MMA(0, 0, At, B0); PG8_MMA(0, 1, At, B1); PG8_BAR; PG8_SCHED;
            PG8_LDA(At, 1, 1); PG8_STAGE(PG8_SB(1, 0), b3, voffB); PG8_STAGE(PG8_SB(1, 1), b3 + hstepB, voffB); PG8_STAGE(PG8_SA(1, 0), a3, voffA);
            PG8_WAIT_V(8); PG8_WAIT_L(0); PG8_BAR; PG8_MMA(1, 0, At, B0); PG8_MMA(1, 1, At, B1); PG8_BAR; PG8_SCHED;
        }
        if (wr == 0) PG8_BAR;
        E(acc, cur, wr, wc, fr, fq);
        if (!has_next) break;
#pragma unroll
        for (int a = 0; a < 2; ++a)
#pragma unroll
            for (int b = 0; b < 2; ++b)
#pragma unroll
                for (int m = 0; m < 4; ++m)
#pragma unroll
                    for (int n = 0; n < 2; ++n) acc[a][b][m][n] = (f32x4){0.f, 0.f, 0.f, 0.f};
        cur = nxt; cA = nA; cB = nB; ++ui;
        if (wr == 1) PG8_BAR;
    }
    PG8_WAIT_V(0);
    PG8_BAR;
#undef PG8_SA
#undef PG8_SB
#undef PG8_STAGE
#undef PG8_LDA
#undef PG8_LDB
#undef PG8_MMA
#undef PG8_WAIT_V
#undef PG8_WAIT_L
#undef PG8_BAR
#undef PG8_SCHED
}
template <class Epi, class Sched>
__device__ __forceinline__ void gemm_phase_mid(LAS unsigned char* lds, const Gemm g, const Sched& S, const Epi& E, int tid_in) {
    int tid_ = tid_in; asm volatile("" : "+v"(tid_));
    const int tid = tid_, wid = __builtin_amdgcn_readfirstlane(tid >> 6), lane = tid & 63, wr = wid >> 2, wc = wid & 3, fr = lane & 15, fq = lane >> 4;
    const int K = g.K, nt = K / BK;
    unsigned voffA[2], voffB[2];
#pragma unroll
    for (int i = 0; i < 2; ++i) { int R, C; stage_rc(tid * 16 + i * 8192, R, C); const int Rb = Epi::PERM ? ((R & ~31) + perm32(R & 31)) : R;
        voffA[i] = (unsigned)(R * g.lda + C) * 2u; voffB[i] = (unsigned)(Rb * g.ldb + C) * 2u; }
    const size_t kstep = (size_t)(BK * 2);
    const size_t hstepA = (size_t)HALF * g.lda * 2, hstepB = (size_t)HALF * g.ldb * 2;
    const size_t tstepA = 2 * hstepA, tstepB = 2 * hstepB;
    const unsigned ldsw = (unsigned)wid * 1024u;
    const int aoff = lds_byte(wr * 64 + fr, fq * 8), boff = lds_byte(wc * 32 + fr, fq * 8);
#define PG8_SA(b, h) (((b) * 2 + (h)) * HTB)
#define PG8_SB(b, h) ((4 + (b) * 2 + (h)) * HTB)
#define PG8_STAGE(bufoff, gbase, voff) do { _Pragma("unroll") for (int _i = 0; _i < 2; ++_i) \
        __builtin_amdgcn_global_load_lds((const unsigned*)((const char*)(gbase) + (voff)[_i]), (LAS unsigned*)(lds + (bufoff) + ldsw + _i * 8192), 16, 0, 0); } while (0)
#define PG8_LDA(dst, b, h) do { _Pragma("unroll") for (int m = 0; m < 4; ++m) _Pragma("unroll") for (int k = 0; k < 2; ++k) dst[m][k] = *(const LAS bf16x8*)(lds + PG8_SA(b, h) + aoff + m * 2048 + k * 1024); } while (0)
#define PG8_LDB(dst, b, h) do { _Pragma("unroll") for (int n = 0; n < 2; ++n) _Pragma("unroll") for (int k = 0; k < 2; ++k) dst[n][k] = *(const LAS bf16x8*)(lds + PG8_SB(b, h) + boff + n * 2048 + k * 1024); } while (0)
#define PG8_MMA(ai, bj, At, Bt) do { __builtin_amdgcn_s_setprio(1); _Pragma("unroll") for (int m = 0; m < 4; ++m) _Pragma("unroll") for (int n = 0; n < 2; ++n) _Pragma("unroll") for (int k = 0; k < 2; ++k) \
        acc[ai][bj][m][n] = __builtin_amdgcn_mfma_f32_16x16x32_bf16(Bt[n][k], At[m][k], acc[ai][bj][m][n], 0, 0, 0); __builtin_amdgcn_s_setprio(0); } while (0)
#define PG8_WAIT_V(n) asm volatile("s_waitcnt vmcnt(" #n ")" ::: "memory")
#define PG8_WAIT_L(n) asm volatile("s_waitcnt lgkmcnt(" #n ")" ::: "memory")
#define PG8_BAR __builtin_amdgcn_s_barrier()
#define PG8_SCHED __builtin_amdgcn_sched_barrier(0)
    Unit cur, nxt; int ui = 0;
    if (!S.next(0, cur)) return;
    f32x4 acc[2][2][4][2];
#pragma unroll
    for (int a = 0; a < 2; ++a)
#pragma unroll
        for (int b = 0; b < 2; ++b)
#pragma unroll
            for (int m = 0; m < 4; ++m)
#pragma unroll
                for (int n = 0; n < 2; ++n) acc[a][b][m][n] = (f32x4){0.f, 0.f, 0.f, 0.f};
    bf16x8 At[4][2], B0[2][2], B1[2][2];
    LAS float* midtab = (LAS float*)(lds + STAGE_BYTES + 1024);
    E.mid_table(midtab, cur, tid);
    const char* cA = (const char*)g.A + (size_t)cur.pm * tstepA; const char* cB = (const char*)g.Bt + (size_t)cur.pn * tstepB;
    PG8_STAGE(PG8_SB(0, 0), cB, voffB); PG8_STAGE(PG8_SB(0, 1), cB + hstepB, voffB); PG8_STAGE(PG8_SA(0, 0), cA, voffA); PG8_STAGE(PG8_SA(0, 1), cA + hstepA, voffA);
    if (wr == 1) PG8_BAR;
    PG8_WAIT_V(2); PG8_BAR;
    PG8_STAGE(PG8_SB(1, 0), cB + kstep, voffB); PG8_STAGE(PG8_SA(1, 0), cA + kstep, voffA); PG8_STAGE(PG8_SB(1, 1), cB + hstepB + kstep, voffB);
    PG8_WAIT_V(6); PG8_BAR;
    for (;;) {
        const bool has_next = S.next(ui + 1, nxt);
        const char* nA = has_next ? (const char*)g.A + (size_t)nxt.pm * tstepA : cA; const char* nB = has_next ? (const char*)g.Bt + (size_t)nxt.pn * tstepB : cB;
#pragma unroll 1
        for (int t = 0; t < nt; t += 2) {
            const bool last = (t == nt - 2);
            if (t == Epi::MID_T) {
#pragma unroll
                for (int a = 0; a < 2; ++a)
#pragma unroll
                    for (int mm = 0; mm < 4; ++mm) { const float sc = midtab[a * HALF + wr * 64 + mm * 16 + fr];
#pragma unroll
                        for (int b = 0; b < 2; ++b)
#pragma unroll
                            for (int n = 0; n < 2; ++n) acc[a][b][mm][n] = acc[a][b][mm][n] * sc; } }
            const char* a1 = cA + (size_t)(t + 1) * kstep;
            const char* a2 = last ? nA : cA + (size_t)(t + 2) * kstep; const char* b2 = last ? nB : cB + (size_t)(t + 2) * kstep;
            const char* a3 = a2 + kstep; const char* b3 = b2 + kstep;
            PG8_LDB(B0, 0, 0); PG8_LDB(B1, 0, 1); PG8_SCHED; PG8_LDA(At, 0, 0); PG8_STAGE(PG8_SA(1, 1), a1 + hstepA, voffA);
            PG8_WAIT_V(8); PG8_WAIT_L(0); PG8_BAR; PG8_MMA(0, 0, At, B0); PG8_MMA(0, 1, At, B1); PG8_BAR; PG8_SCHED;
            PG8_LDA(At, 0, 1); PG8_STAGE(PG8_SB(0, 0), b2, voffB); PG8_STAGE(PG8_SB(0, 1), b2 + hstepB, voffB); PG8_STAGE(PG8_SA(0, 0), a2, voffA);
            PG8_WAIT_V(8); PG8_WAIT_L(0); PG8_BAR; PG8_MMA(1, 0, At, B0); PG8_MMA(1, 1, At, B1); PG8_BAR; PG8_SCHED;
            PG8_LDB(B0, 1, 0); PG8_LDB(B1, 1, 1); PG8_SCHED; PG8_LDA(At, 1, 0); PG8_STAGE(PG8_SA(0, 1), a2 + hstepA, voffA);
            PG8_WAIT_V(8); PG8_WAIT_L(0); PG8_BAR; PG8_MMA(0, 0, At, B0); PG8_MMA(0, 1, At, B1); PG8_BAR; PG8_SCHED;
            PG8_LDA(At, 1, 1); PG8_STAGE(PG8_SB(1, 0), b3, voffB); PG8_STAGE(PG8_SB(1, 1), b3 + hstepB, voffB); PG8_STAGE(PG8_SA(1, 0), a3, voffA);
            PG8_WAIT_V(8); PG8_WAIT_L(0); PG8_BAR; PG8_MMA(1, 0, At, B0); PG8_MMA(1, 1, At, B1); PG8_BAR; PG8_SCHED;
        }
        if (wr == 0) PG8_BAR;
        E(acc, cur, wr, wc, fr, fq);
        if (!has_next) break;
#pragma unroll
        for (int a = 0; a < 2; ++a)
#pragma unroll
            for (int b = 0; b < 2; ++b)
#pragma unroll
                for (int m = 0; m < 4; ++m)
#pragma unroll
                    for (int n = 0; n < 2; ++n) acc[a][b][m][n] = (f32x4){0.f, 0.f, 0.f, 0.f};
        E.mid_table(midtab, nxt, tid);
        cur = nxt; cA = nA; cB = nB; ++ui;
        if (wr == 1) PG8_BAR;
    }
    PG8_WAIT_V(0);
    PG8_BAR;
#undef PG8_SA
#undef PG8_SB
#undef PG8_STAGE
#undef PG8_LDA
#undef PG8_LDB
#undef PG8_MMA
#undef PG8_WAIT_V
#undef PG8_WAIT_L
#undef PG8_BAR
#undef PG8_SCHED
}
struct EpiScaleBf16 {
    static constexpr bool PERM = true;
    bf16* O; int ldc; const float* rs; int rs_stride;
    __device__ __forceinline__ void operator()(const f32x4 (&acc)[2][2][4][2], const Unit& u, int wr, int wc, int fr, int fq) const {
        const int row0 = u.pm * BM + wr * 64 + fr, col0 = u.pn * BM + wc * 32 + 8 * fq;
#pragma unroll
        for (int ai = 0; ai < 2; ++ai)
#pragma unroll
            for (int m = 0; m < 4; ++m) { const int row = row0 + ai * HALF + m * 16; const float sc = rs ? rs[(size_t)row * rs_stride] : 1.0f; bf16* rowp = O + (size_t)row * ldc + col0;
#pragma unroll
                for (int bj = 0; bj < 2; ++bj) { const f32x4 v0 = acc[ai][bj][m][0] * sc, v1 = acc[ai][bj][m][1] * sc;
                    u32x4 w; w.x = cvtpk(v0[0], v0[1]); w.y = cvtpk(v0[2], v0[3]); w.z = cvtpk(v1[0], v1[1]); w.w = cvtpk(v1[2], v1[3]);
                    *(u32x4*)(rowp + bj * HALF) = w; } }
    }
};
struct EpiResF32 {
    static constexpr bool PERM = false;
    const float* base; float* out; int ldc;
    __device__ __forceinline__ void operator()(const f32x4 (&acc)[2][2][4][2], const Unit& u, int wr, int wc, int fr, int fq) const {
        const int row0 = u.pm * BM + wr * 64 + fr, col0 = u.pn * BM + wc * 32 + 4 * fq;
#pragma unroll
        for (int ai = 0; ai < 2; ++ai)
#pragma unroll
            for (int m = 0; m < 4; ++m) { const size_t off = (size_t)(row0 + ai * HALF + m * 16) * ldc + col0;
#pragma unroll
                for (int bj = 0; bj < 2; ++bj)
#pragma unroll
                    for (int n = 0; n < 2; ++n) { const f32x4 bs = *(const f32x4*)(base + off + bj * HALF + n * 16); *(f32x4*)(out + off + bj * HALF + n * 16) = bs + acc[ai][bj][m][n]; } }
    }
};
struct EpiResF32Bf16 {
    static constexpr bool PERM = false;
    const float* base; float* out; bf16* xb; float* ssq; int ldc;
    __device__ __forceinline__ void operator()(const f32x4 (&acc)[2][2][4][2], const Unit& u, int wr, int wc, int fr, int fq) const {
        const int row0 = u.pm * BM + wr * 64 + fr, col0 = u.pn * BM + wc * 32 + 4 * fq;
#pragma unroll
        for (int ai = 0; ai < 2; ++ai)
#pragma unroll
            for (int m = 0; m < 4; ++m) { const int row = row0 + ai * HALF + m * 16; const size_t off = (size_t)row * ldc + col0; float ss = 0.f;
#pragma unroll
                for (int bj = 0; bj < 2; ++bj)
#pragma unroll
                    for (int n = 0; n < 2; ++n) { const f32x4 v = *(const f32x4*)(base + off + bj * HALF + n * 16) + acc[ai][bj][m][n];
                        ss += (v[0] * v[0] + v[1] * v[1]) + (v[2] * v[2] + v[3] * v[3]);
                        u32x2 w; w.x = cvtpk(v[0], v[1]); w.y = cvtpk(v[2], v[3]); *(u32x2*)(xb + off + bj * HALF + n * 16) = w; }
                ss += shx<16>(ss); ss = sum32x(ss);
                if (fq == 0) ssq[(size_t)row * 16 + u.pn * 4 + wc] = ss; }
    }
};
struct EpiAddBf16 {
    static constexpr bool PERM = true;
    bf16* xb; int ldc;
    __device__ __forceinline__ void operator()(const f32x4 (&acc)[2][2][4][2], const Unit& u, int wr, int wc, int fr, int fq) const {
        const int row0 = u.pm * BM + wr * 64 + fr, col0 = u.pn * BM + wc * 32 + 8 * fq;
#pragma unroll
        for (int ai = 0; ai < 2; ++ai)
#pragma unroll
            for (int m = 0; m < 4; ++m) { bf16* rowp = xb + (size_t)(row0 + ai * HALF + m * 16) * ldc + col0;
#pragma unroll
                for (int bj = 0; bj < 2; ++bj) { const u32x4 o = *(const u32x4*)(rowp + bj * HALF); const f32x4 a0 = acc[ai][bj][m][0], a1 = acc[ai][bj][m][1];
                    u32x4 w; w.x = cvtpk(__uint_as_float(o.x << 16) + a0[0], __uint_as_float(o.x & 0xffff0000u) + a0[1]); w.y = cvtpk(__uint_as_float(o.y << 16) + a0[2], __uint_as_float(o.y & 0xffff0000u) + a0[3]);
                    w.z = cvtpk(__uint_as_float(o.z << 16) + a1[0], __uint_as_float(o.z & 0xffff0000u) + a1[1]); w.w = cvtpk(__uint_as_float(o.w << 16) + a1[2], __uint_as_float(o.w & 0xffff0000u) + a1[3]);
                    *(u32x4*)(rowp + bj * HALF) = w; } }
    }
};
struct EpiAddBf16Ssq {
    static constexpr bool PERM = true;
    bf16* xb; int ldc; float* ssq;
    __device__ __forceinline__ void operator()(const f32x4 (&acc)[2][2][4][2], const Unit& u, int wr, int wc, int fr, int fq) const {
        const int row0 = u.pm * BM + wr * 64 + fr, col0 = u.pn * BM + wc * 32 + 8 * fq;
#pragma unroll
        for (int ai = 0; ai < 2; ++ai)
#pragma unroll
            for (int m = 0; m < 4; ++m) { const int row = row0 + ai * HALF + m * 16; bf16* rowp = xb + (size_t)row * ldc + col0; float ss = 0.f;
#pragma unroll
                for (int bj = 0; bj < 2; ++bj) { const u32x4 o = *(const u32x4*)(rowp + bj * HALF); const f32x4 a0 = acc[ai][bj][m][0], a1 = acc[ai][bj][m][1];
                    const float v0 = __uint_as_float(o.x << 16) + a0[0], v1 = __uint_as_float(o.x & 0xffff0000u) + a0[1], v2 = __uint_as_float(o.y << 16) + a0[2], v3 = __uint_as_float(o.y & 0xffff0000u) + a0[3];
                    const float v4 = __uint_as_float(o.z << 16) + a1[0], v5 = __uint_as_float(o.z & 0xffff0000u) + a1[1], v6 = __uint_as_float(o.w << 16) + a1[2], v7 = __uint_as_float(o.w & 0xffff0000u) + a1[3];
                    ss += ((v0 * v0 + v1 * v1) + (v2 * v2 + v3 * v3)) + ((v4 * v4 + v5 * v5) + (v6 * v6 + v7 * v7));
                    u32x4 w; w.x = cvtpk(v0, v1); w.y = cvtpk(v2, v3); w.z = cvtpk(v4, v5); w.w = cvtpk(v6, v7);
                    *(u32x4*)(rowp + bj * HALF) = w; }
                ss += shx<16>(ss); ss = sum32x(ss);
                if (fq == 0) ssq[(size_t)row * 16 + u.pn * 4 + wc] = ss; }
    }
};
struct EpiOutProj {
    static constexpr bool PERM = true; static constexpr int MID_T = 8;
    bf16* xb; int ldc; float* ssq; const float* ssy;
    __device__ __forceinline__ void rscales(int row, float& rm, float& rn) const { const f32x4* sp = (const f32x4*)(ssy + (size_t)row * 16); const f32x4 a = sp[0], b = sp[1], c = sp[2], d = sp[3];
        rm = 1.0f / sqrtf((((a[0] + a[1]) + (a[2] + a[3])) + ((b[0] + b[1]) + (b[2] + b[3]))) * (1.0f / 512) + EPS); rn = 1.0f / sqrtf((((c[0] + c[1]) + (c[2] + c[3])) + ((d[0] + d[1]) + (d[2] + d[3]))) * (1.0f / 512) + EPS); }
    __device__ __forceinline__ void mid_table(LAS float* tab, const Unit& u, int tid) const {
        if (tid < 256) { const f32x4* sp = (const f32x4*)(ssy + (size_t)(u.pm * BM + tid) * 16); const f32x4 a = sp[0], b = sp[1], c = sp[2], d = sp[3];
            const float vm = (((a[0] + a[1]) + (a[2] + a[3])) + ((b[0] + b[1]) + (b[2] + b[3]))) * (1.0f / 512) + EPS, vn = (((c[0] + c[1]) + (c[2] + c[3])) + ((d[0] + d[1]) + (d[2] + d[3]))) * (1.0f / 512) + EPS;
            tab[tid] = __builtin_amdgcn_sqrtf(vn * __builtin_amdgcn_rcpf(vm)); }
        asm volatile("s_waitcnt vmcnt(0) lgkmcnt(0)" ::: "memory"); }
    __device__ __forceinline__ void operator()(const f32x4 (&acc)[2][2][4][2], const Unit& u, int wr, int wc, int fr, int fq) const {
        int row0 = u.pm * BM + wr * 64 + fr, col0 = u.pn * BM + wc * 32 + 8 * fq;
        asm volatile("" : "+v"(row0), "+v"(col0));
#pragma unroll
        for (int ai = 0; ai < 2; ++ai)
#pragma unroll
            for (int m = 0; m < 4; ++m) { const int row = row0 + ai * HALF + m * 16; bf16* rowp = xb + (size_t)row * ldc + col0; float ss = 0.f; float rn; { const f32x4* sp = (const f32x4*)(ssy + (size_t)row * 16 + 8); const f32x4 c = sp[0], d = sp[1]; rn = 1.0f / sqrtf((((c[0] + c[1]) + (c[2] + c[3])) + ((d[0] + d[1]) + (d[2] + d[3]))) * (1.0f / 512) + EPS); }
#pragma unroll
                for (int bj = 0; bj < 2; ++bj) { const u32x4 o = *(const u32x4*)(rowp + bj * HALF); const f32x4 a0 = acc[ai][bj][m][0] * rn, a1 = acc[ai][bj][m][1] * rn;
                    const float v0 = __uint_as_float(o.x << 16) + a0[0], v1 = __uint_as_float(o.x & 0xffff0000u) + a0[1], v2 = __uint_as_float(o.y << 16) + a0[2], v3 = __uint_as_float(o.y & 0xffff0000u) + a0[3];
                    const float v4 = __uint_as_float(o.z << 16) + a1[0], v5 = __uint_as_float(o.z & 0xffff0000u) + a1[1], v6 = __uint_as_float(o.w << 16) + a1[2], v7 = __uint_as_float(o.w & 0xffff0000u) + a1[3];
                    ss += ((v0 * v0 + v1 * v1) + (v2 * v2 + v3 * v3)) + ((v4 * v4 + v5 * v5) + (v6 * v6 + v7 * v7));
                    u32x4 w; w.x = cvtpk(v0, v1); w.y = cvtpk(v2, v3); w.z = cvtpk(v4, v5); w.w = cvtpk(v6, v7);
                    *(u32x4*)(rowp + bj * HALF) = w; }
                ss += shx<16>(ss); ss = sum32x(ss);
                if (fq == 0) ssq[(size_t)row * 16 + u.pn * 4 + wc] = ss; }
    }
};
struct EpiSsqScaleBf16 {
    static constexpr bool PERM = true;
    bf16* O; int ldc; const float* ssq;
    __device__ __forceinline__ void operator()(const f32x4 (&acc)[2][2][4][2], const Unit& u, int wr, int wc, int fr, int fq) const {
        const int row0 = u.pm * BM + wr * 64 + fr, col0 = u.pn * BM + wc * 32 + 8 * fq;
#pragma unroll
        for (int ai = 0; ai < 2; ++ai)
#pragma unroll
            for (int m = 0; m < 4; ++m) { const int row = row0 + ai * HALF + m * 16; const f32x4* sp = (const f32x4*)(ssq + (size_t)row * 16);
                const f32x4 s0 = sp[0], s1 = sp[1], s2 = sp[2], s3 = sp[3];
                const float tot = ((s0[0] + s0[1]) + (s0[2] + s0[3])) + ((s1[0] + s1[1]) + (s1[2] + s1[3])) + ((s2[0] + s2[1]) + (s2[2] + s2[3])) + ((s3[0] + s3[1]) + (s3[2] + s3[3]));
                const float sc = 1.0f / sqrtf(tot * (1.0f / 1024) + EPS); bf16* rowp = O + (size_t)row * ldc + col0;
#pragma unroll
                for (int bj = 0; bj < 2; ++bj) { const f32x4 v0 = acc[ai][bj][m][0] * sc, v1 = acc[ai][bj][m][1] * sc;
                    u32x4 w; w.x = cvtpk(v0[0], v0[1]); w.y = cvtpk(v0[2], v0[3]); w.z = cvtpk(v1[0], v1[1]); w.w = cvtpk(v1[2], v1[3]);
                    *(u32x4*)(rowp + bj * HALF) = w; } }
    }
};
struct EpiSwiglu {
    static constexpr bool PERM = true;
    bf16* act; const float* bgu;
    __device__ __forceinline__ void operator()(const f32x4 (&acc)[2][2][4][2], const Unit& u, int wr, int wc, int fr, int fq) const {
        const int e = u.aux, pnl = u.pn - e * 8;
        const int row0 = u.pm * BM + wr * 64 + fr, c0 = pnl * BM + wc * 32 + 8 * fq;
#pragma unroll
        for (int bj = 0; bj < 2; ++bj) { const f32x4 b0 = *(const f32x4*)(bgu + (size_t)e * 2048 + c0 + bj * HALF), b1 = *(const f32x4*)(bgu + (size_t)e * 2048 + c0 + bj * HALF + 4);
#pragma unroll
            for (int ai = 0; ai < 2; ++ai)
#pragma unroll
                for (int m = 0; m < 4; ++m) { const int row = row0 + ai * HALF + m * 16; const f32x4 v0 = acc[ai][bj][m][0] + b0, v1 = acc[ai][bj][m][1] + b1; float o[4];
#pragma unroll
                    for (int j = 0; j < 4; ++j) { float gt = j < 2 ? v0[2 * j] : v1[2 * j - 4], up = j < 2 ? v0[2 * j + 1] : v1[2 * j - 3];
                        gt = fminf(gt, 7.0f); up = fminf(fmaxf(up, -7.0f), 7.0f);
                        const float sg = __builtin_amdgcn_rcpf(1.0f + __builtin_amdgcn_exp2f(-1.702f * LOG2E * gt));
                        o[j] = (up + 1.0f) * gt * sg; }
                    u32x2 w; w.x = cvtpk(o[0], o[1]); w.y = cvtpk(o[2], o[3]);
                    *(u32x2*)(act + (size_t)row * 1024 + ((c0 + bj * HALF) >> 1)) = w; } }
    }
};
struct EpiDown {
    static constexpr bool PERM = true;
    bf16* Y; const float* bd;
    __device__ __forceinline__ void operator()(const f32x4 (&acc)[2][2][4][2], const Unit& u, int wr, int wc, int fr, int fq) const {
        const int e = u.aux, pnl = u.pn - e * 4;
        const int row0 = u.pm * BM + wr * 64 + fr, c0 = pnl * BM + wc * 32 + 8 * fq;
#pragma unroll
        for (int bj = 0; bj < 2; ++bj) { const f32x4 b0 = *(const f32x4*)(bd + (size_t)e * 1024 + c0 + bj * HALF), b1 = *(const f32x4*)(bd + (size_t)e * 1024 + c0 + bj * HALF + 4);
#pragma unroll
            for (int ai = 0; ai < 2; ++ai)
#pragma unroll
                for (int m = 0; m < 4; ++m) { const int row = row0 + ai * HALF + m * 16; const f32x4 v0 = acc[ai][bj][m][0] + b0, v1 = acc[ai][bj][m][1] + b1;
                    u32x4 w; w.x = cvtpk(v0[0], v0[1]); w.y = cvtpk(v0[2], v0[3]); w.z = cvtpk(v1[0], v1[1]); w.w = cvtpk(v1[2], v1[3]);
                    *(u32x4*)(Y + (size_t)row * 1024 + c0 + bj * HALF) = w; } }
    }
};
}

#define XB_TMO      128
#define XB_XCNT(j)  (256  + 64 * (j))
#define XB_XSUB(j)  (1280 + 64 * (j))
#define XB_XGEN(j)  (2304 + 64 * (j))
#define XB_TOP      3328
#define XB_TOPGEN   3392
#define XCD_BAR_WORDS 3456
#define XB_SPIN_CAP (1u << 18)
__device__ __forceinline__ unsigned xb_ld(unsigned* p)              { return __hip_atomic_load(p, __ATOMIC_RELAXED, __HIP_MEMORY_SCOPE_AGENT); }
__device__ __forceinline__ unsigned xb_add(unsigned* p, unsigned v) { return __hip_atomic_fetch_add(p, v, __ATOMIC_RELAXED, __HIP_MEMORY_SCOPE_AGENT); }
__device__ __forceinline__ unsigned xb_xcc_id() { return (unsigned)__builtin_amdgcn_s_getreg((3 << 11) | 20) & 0xFu; }
#define XB_SPIN(cond, bar) do { unsigned _sp = 0; while (cond) { __builtin_amdgcn_s_sleep(1); \
    if ((++_sp & 255u) == 0u) { if (xb_ld(&(bar)[XB_TMO])) break; if (_sp > XB_SPIN_CAP) { atomicAdd(&(bar)[XB_TMO], 1u); break; } } } } while (0)
struct XcdBarrier { unsigned* bar; unsigned x; volatile LAS unsigned* st; };
__device__ __forceinline__ XcdBarrier xcd_barrier_post(unsigned* bar, volatile LAS unsigned* st) {
    XcdBarrier b; b.bar = bar; b.x = xb_xcc_id(); b.st = st;
    if (threadIdx.x == 0) (void)xb_add(&bar[XB_XCNT(b.x)], 1u);
    return b;
}
__device__ __forceinline__ void xcd_barrier_complete(unsigned* bar, unsigned x, unsigned& nloc, unsigned& nx) {
    const unsigned G = gridDim.x * gridDim.y * gridDim.z;
    unsigned sum, cnt, mine, sp = 0u;
    for (;;) {
        sum = 0u; cnt = 0u; mine = 0u;
#pragma unroll
        for (unsigned j = 0; j < 16; ++j) { const unsigned c = xb_ld(&bar[XB_XCNT(j)]); sum += c; cnt += (c > 0u) ? 1u : 0u; mine = (j == x) ? c : mine; }
        if (sum == G) break;
        __builtin_amdgcn_s_sleep(1);
        if ((++sp & 255u) == 0u) { if (xb_ld(&bar[XB_TMO])) break; if (sp > XB_SPIN_CAP) { atomicAdd(&bar[XB_TMO], 1u); break; } }
    }
    nloc = mine > 0u ? mine : 1u; nx = cnt > 0u ? cnt : 1u;
}
__device__ __forceinline__ void xcd_barrier(const XcdBarrier& b, bool leader) {
    asm volatile("s_waitcnt vmcnt(0)" ::: "memory");
    __syncthreads();
    if (leader) {
        unsigned* bar = b.bar;
        __builtin_amdgcn_s_waitcnt(0);
        unsigned nloc = b.st[0], nx = b.st[1];
        if (nloc == 0u) { xcd_barrier_complete(bar, b.x, nloc, nx); b.st[0] = nloc; b.st[1] = nx; }
        const unsigned old = xb_add(&bar[XB_XSUB(b.x)], 1u);
        const unsigned gen = old / nloc;
        if (old + 1u == (gen + 1u) * nloc) {
            __builtin_amdgcn_fence(__ATOMIC_RELEASE, "agent");
            asm volatile("s_waitcnt vmcnt(0)" ::: "memory");
            const unsigned og = xb_add(&bar[XB_TOP], 1u);
            const unsigned tg = og / nx;
            if (og + 1u == (tg + 1u) * nx) xb_add(&bar[XB_TOPGEN], 1u);
            else XB_SPIN(xb_ld(&bar[XB_TOPGEN]) == tg, bar);
            __builtin_amdgcn_fence(__ATOMIC_ACQUIRE, "agent");
            xb_add(&bar[XB_XGEN(b.x)], 1u);
            asm volatile("s_waitcnt vmcnt(0)" ::: "memory");
        } else {
            XB_SPIN(xb_ld(&bar[XB_XGEN(b.x)]) == gen, bar);
            __builtin_amdgcn_fence(__ATOMIC_ACQUIRE, "agent");
            asm volatile("s_waitcnt vmcnt(0)" ::: "memory");
        }
    }
    __syncthreads();
}

struct Args { const float* in[36]; float* out; unsigned char* ws; };
struct Frame {
    LAS unsigned char* lds; int tid, lane, wave, G, bid, gw, ngw;
    const float* const* in; float* out; unsigned char* ws;
};
#ifndef PRB_A
#define PRB_A -1
#endif
#ifndef PRB_B
#define PRB_B -1
#endif
#define FSTAMP(F, k) do { if (PRB_A >= 0 && (F).bid == 0 && (F).tid == 0) ((volatile LAS unsigned long long*)((F).lds + LDSCTL_OFF + 128))[k] = __builtin_amdgcn_s_memrealtime(); } while (0)
#define WSP(T, off) ((T*)(F.ws + (off)))

struct TrItem { const float* wp; const float* gp; bf16* dst; int ldw, ldd; float msk; };
__device__ __forceinline__ void tr_decode(Frame& F, int it, TrItem& d) {
    const float* const* in = F.in; const float* nog = nullptr;
    constexpr int I0 = 16 * 28, I1 = 4 * 12, I2 = 4 * 16, I3 = 16 * 16, I4 = 16 * 4, I5 = 4 * 16, I6 = 32 * 16 * 32, I7 = 32 * 16 * 16;
    int r = it; const float* W; int ldw, kvalid, nvalid, gsplit = 1 << 30, ldd, kb, nb; const float* g1 = nog; const float* g2 = nog; bf16* WT;
    if (r < I0) { kb = r / 28; nb = r % 28; W = in[3]; ldw = 1720; kvalid = 1024; nvalid = 1720; g1 = in[2]; g2 = in[2]; WT = WSP(bf16, WS_WIN); ldd = 1024; }
    else if ((r -= I0) < I1) { kb = r / 12; nb = r % 12; W = in[5]; ldw = 768; kvalid = 256; nvalid = 768; g1 = in[4]; g2 = in[4]; WT = WSP(bf16, WS_WUQ); ldd = 256; }
    else if ((r -= I1) < I2) { kb = r / 16; nb = r % 16; W = in[7]; ldw = 1024; kvalid = 128; nvalid = 1024; g1 = in[6]; g2 = in[6]; WT = WSP(bf16, WS_WUKV); ldd = 256; }
    else if ((r -= I2) < I3) { kb = r / 16; nb = r % 16; W = in[21]; ldw = 1024; kvalid = 1024; nvalid = 1024; g1 = in[19]; g2 = in[20]; gsplit = 512; WT = WSP(bf16, WS_WOUT); ldd = 1024; }
    else if ((r -= I3) < I4) { kb = r / 4; nb = r % 4; W = in[24]; ldw = 256; kvalid = 1024; nvalid = 256; g1 = in[22]; g2 = in[22]; WT = WSP(bf16, WS_WMQ); ldd = 1024; }
    else if ((r -= I4) < I5) { kb = r / 16; nb = r % 16; W = in[28]; ldw = 1024; kvalid = 256; nvalid = 1024; WT = WSP(bf16, WS_WMO); ldd = 256; }
    else if ((r -= I5) < I6) { const int e = r / 512, q = r % 512; kb = q / 32; nb = q % 32; W = in[32] + (size_t)e * 1024 * 2048; ldw = 2048; kvalid = 1024; nvalid = 2048; g1 = in[29]; g2 = in[29]; WT = WSP(bf16, WS_WGU) + (size_t)e * 2048 * 1024; ldd = 1024; }
    else if ((r -= I6) < I7) { const int e = r / 256, q = r % 256; kb = q / 16; nb = q % 16; W = in[34] + (size_t)e * 1024 * 1024; ldw = 1024; kvalid = 1024; nvalid = 1024; WT = WSP(bf16, WS_WD) + (size_t)e * 1024 * 1024; ldd = 1024; }
    else if ((r -= I7) < 128) { const int kv = r / 64, q = r % 64; kb = q / 2; nb = q % 2; W = in[kv ? 14 : 11]; ldw = 128; kvalid = 2048; nvalid = 128; WT = WSP(bf16, WS_W1T) + (size_t)kv * 128 * 2048; ldd = 2048; }
    else { r -= 128; kb = r / 8; nb = r % 8; W = in[25]; ldw = 512; kvalid = 1024; nvalid = 512; g1 = in[23]; g2 = in[23]; WT = WSP(bf16, WS_WMKVT); ldd = 1024; }
    const int k0 = 64 * kb, n0 = 64 * nb, cg = F.lane & 15, rp = F.lane >> 4, nc = n0 + 4 * cg;
    const bool ok = (nc < nvalid) && (k0 < kvalid);
    d.gp = g1 ? ((k0 < gsplit ? g1 + k0 : g2 + (k0 - gsplit)) + 2 * rp) : nullptr;
    d.wp = W + (ok ? (size_t)(k0 + 2 * rp) * ldw + nc : (size_t)0);
    d.msk = ok ? 1.0f : 0.0f; d.ldw = ldw; d.ldd = ldd; d.dst = WT + (size_t)n0 * ldd + k0;
}
__device__ __forceinline__ void tr_load(const TrItem& d, f32x4 (&a)[8], f32x4 (&b)[8]) {
#pragma unroll
    for (int j = 0; j < 8; ++j) { a[j] = __builtin_nontemporal_load((const f32x4*)(d.wp + (size_t)(8 * j) * d.ldw)); b[j] = __builtin_nontemporal_load((const f32x4*)(d.wp + (size_t)(8 * j + 1) * d.ldw)); }
}
__device__ __forceinline__ void tr_finish(const TrItem& d, f32x4 (&a)[8], f32x4 (&b)[8], LAS unsigned* scr, int lane) {
    const int cg = lane & 15, rp = lane >> 4;
#pragma unroll
    for (int j = 0; j < 8; ++j) {
        float ga = d.msk, gb = d.msk;
        if (d.gp) { const f32x2_t g2v = *(const f32x2_t*)(d.gp + 8 * j); ga *= g2v.x; gb *= g2v.y; }
        a[j] = a[j] * ga; b[j] = b[j] * gb;
        LAS unsigned* q = scr + (4 * cg) * 36 + 4 * j + rp;
        q[0] = cvtpk(a[j].x, b[j].x); q[36] = cvtpk(a[j].y, b[j].y); q[72] = cvtpk(a[j].z, b[j].z); q[108] = cvtpk(a[j].w, b[j].w); }
    LDS_WAIT(); asm volatile("" ::: "memory");
#pragma unroll
    for (int i = 0; i < 8; ++i) { const int n = 8 * i + (lane >> 3), c = lane & 7;
        const u32x4 v = *(const LAS u32x4*)(scr + n * 36 + 4 * c);
        *(u32x4*)(d.dst + (size_t)n * d.ldd + 8 * c) = v; }
    LDS_WAIT(); asm volatile("" ::: "memory");
}

__device__ __forceinline__ void p0_prologue(Frame& F) {
    LAS unsigned* scr = (LAS unsigned*)(F.lds + F.wave * 16384);
    const float* const* in = F.in;
    constexpr int NITEMS = 16 * 28 + 4 * 12 + 4 * 16 + 16 * 16 + 16 * 4 + 4 * 16 + 32 * 16 * 32 + 32 * 16 * 16 + 2 * 32 * 2 + 16 * 8;
    { TrItem d0, d1; f32x4 a0[8], b0[8], a1[8], b1[8];
      int it = F.gw; if (it < NITEMS) { tr_decode(F, it, d0); tr_load(d0, a0, b0); }
#pragma unroll 1
      while (it < NITEMS) {
          const int it1 = it + F.ngw; if (it1 < NITEMS) { tr_decode(F, it1, d1); tr_load(d1, a1, b1); }
          tr_finish(d0, a0, b0, scr, F.lane);
          if (it1 >= NITEMS) break;
          const int it2 = it1 + F.ngw; if (it2 < NITEMS) { tr_decode(F, it2, d0); tr_load(d0, a0, b0); }
          tr_finish(d1, a1, b1, scr, F.lane);
          it = it2;
      } }
    FSTAMP(F, 32);
    { float* RS = WSP(float, WS_RS); bf16* XB = WSP(bf16, WS_XB);
      for (int m = F.gw; m < NTOK; m += F.ngw) {
        const f32x4* xr = (const f32x4*)(in[0] + (size_t)m * D) + F.lane; f32x4 v[4]; float s = 0.f;
#pragma unroll
        for (int j = 0; j < 4; ++j) { v[j] = xr[64 * j]; s += (v[j].x * v[j].x + v[j].y * v[j].y) + (v[j].z * v[j].z + v[j].w * v[j].w); }
        s = wave_sum(s); if (F.lane == 0) RS[m * 4 + 0] = 1.0f / sqrtf(s * (1.0f / D) + EPS);
        u32x2* o8 = (u32x2*)(XB + (size_t)m * D) + F.lane;
#pragma unroll
        for (int j = 0; j < 4; ++j) { u32x2 w; w.x = cvtpk(v[j].x, v[j].y); w.y = cvtpk(v[j].z, v[j].w); o8[64 * j] = w; }
      } }
    { float* RSM = WSP(float, WS_RSM); bf16* MB = WSP(bf16, WS_MEMB);
      for (int m = F.gw; m < 512; m += F.ngw) {
        const f32x4* xr = (const f32x4*)(in[1] + (size_t)m * D) + F.lane; f32x4 v[4]; float s = 0.f;
#pragma unroll
        for (int j = 0; j < 4; ++j) { v[j] = xr[64 * j]; s += (v[j].x * v[j].x + v[j].y * v[j].y) + (v[j].z * v[j].z + v[j].w * v[j].w); }
        s = wave_sum(s); if (F.lane == 0) RSM[m] = 1.0f / sqrtf(s * (1.0f / D) + EPS);
        u32x2* o8 = (u32x2*)(MB + (size_t)m * D) + F.lane;
#pragma unroll
        for (int j = 0; j < 4; ++j) { u32x2 w; w.x = cvtpk(v[j].x, v[j].y); w.y = cvtpk(v[j].z, v[j].w); o8[64 * j] = w; }
      } }
    FSTAMP(F, 33);
    if (F.bid < 32) { const int kv = F.bid >> 4, part = (F.bid & 15) * 4 + (F.tid >> 7), f = F.tid & 127;
        const float* pos = in[kv ? 13 : 10] + 32 * part; const float* w1 = in[kv ? 14 : 11] + (size_t)(32 * part) * 128 + f; float wv[32], acc = 0.f;
#pragma unroll
        for (int k = 0; k < 32; ++k) wv[k] = w1[(size_t)k * 128];
#pragma unroll
        for (int k = 0; k < 32; ++k) acc += pos[k] * wv[k];
        WSP(float, WS_CONST)[CF_CPP + (kv * 64 + part) * 128 + f] = acc; }
    if (F.bid >= 64 && F.bid < 128) { const float* rw = in[30]; const float* gm = in[29]; bf16* WH = WSP(bf16, WS_WRH); bf16* WL = WSP(bf16, WS_WRL);
        { const int i = (F.bid - 64) * 512 + F.tid; const int k = i >> 5, e = i & 31; const float v = rw[i] * gm[k];
            const unsigned hb = cvtpk(v, 0.f) & 0xffffu; const float lo = v - bf2f(hb);
            WH[e * 1024 + k] = (bf16)hb; WL[e * 1024 + k] = (bf16)(cvtpk(lo, 0.f) & 0xffffu); } }
    float* CF = WSP(float, WS_CONST);
    if (F.bid == 0 && F.wave == 1) {
        const int l = F.lane;
        float m1 = 0.f; for (int i = l; i < 96; i += 64) m1 = fmaxf(m1, fabsf(in[9][i])); m1 = wave_max(m1);
        float m2 = wave_max(fabsf(in[17][l])); float m3 = wave_max(fabsf(in[27][l]));
        if (l == 0) { CF[CF_KBM] = sqrtf(96.f) * m1; CF[CF_KBN] = 8.f * m2; CF[CF_KBMEM] = 8.f * m3; }
        if (l < 8) { float mb = -1e30f; for (int b = 0; b < 32; ++b) mb = fmaxf(mb, in[18][b * 8 + l]); CF[CF_MAXB2 + l] = mb * LOG2E; }
        for (int i = l; i < 256; i += 64) CF[CF_BIAS2 + i] = in[18][i] * LOG2E;
        for (int n = l; n < 512; n += 64) { int bk; if (n < 16) bk = n; else { bk = 16 + (int)(logf((float)n / 16.0f) / logf(32.0f) * 16.0f); bk = bk < 31 ? bk : 31; } CF[CF_LUT + n] = (float)bk; }
    }
}
__device__ __forceinline__ void unpack8(const u32x4 w, float (&v)[8]) {
    v[0] = bf2f(w.x & 0xffff); v[1] = bf2f(w.x >> 16); v[2] = bf2f(w.y & 0xffff); v[3] = bf2f(w.y >> 16);
    v[4] = bf2f(w.z & 0xffff); v[5] = bf2f(w.z >> 16); v[6] = bf2f(w.w & 0xffff); v[7] = bf2f(w.w >> 16);
}
__device__ __forceinline__ u32x4 pack8f(const float (&v)[8]) { u32x4 w; w.x = cvtpk(v[0], v[1]); w.y = cvtpk(v[2], v[3]); w.z = cvtpk(v[4], v[5]); w.w = cvtpk(v[6], v[7]); return w; }

__device__ __forceinline__ void tp_a(Frame& F) {
    const float* CF = WSP(float, WS_CONST); const float kbn = CF[CF_KBN];
    const bf16* PB = WSP(bf16, WS_PB); float* RS = WSP(float, WS_RS);
    const int l = F.lane;
    const float* gq = F.in[16]; const float* gk = F.in[17];
    float gqv[8], gkv[8];
#pragma unroll
    for (int j = 0; j < 8; ++j) { gqv[j] = gq[(8 * l + j) & 63]; gkv[j] = gk[(8 * l + j) & 63]; }
    for (int t = F.gw; t < NTOK; t += F.ngw) {
        const bf16* pr = PB + (size_t)t * NINP; const int b = t >> 13, s = t & 8191;
        { const u32x2 w = *(const u32x2*)(pr + C_CQ + 4 * l); const float a0 = bf2f(w.x & 0xffff), a1 = bf2f(w.x >> 16), a2 = bf2f(w.y & 0xffff), a3 = bf2f(w.y >> 16);
          const float sq = wave_sum(a0 * a0 + a1 * a1 + a2 * a2 + a3 * a3);
          const unsigned w2 = *(const unsigned*)(pr + C_CKV + 2 * l); const float c0 = bf2f(w2 & 0xffff), c1 = bf2f(w2 >> 16);
          const float sk = wave_sum(c0 * c0 + c1 * c1);
          if (l == 0) { RS[t * 4 + 1] = 1.0f / sqrtf(sq * (1.0f / 256) + EPS); RS[t * 4 + 2] = 1.0f / sqrtf(sk * (1.0f / 128) + EPS); } }
        { float v[8]; unpack8(*(const u32x4*)(pr + C_QN + 8 * l), v); float ss = 0.f;
#pragma unroll
          for (int j = 0; j < 8; ++j) ss += v[j] * v[j];
          ss = grp8_sum(ss); const float rinv = 1.0f / sqrtf(ss * (1.0f / 64) + EPS) * (0.125f * LOG2E); float n2 = 0.f;
#pragma unroll
          for (int j = 0; j < 8; ++j) { v[j] = v[j] * rinv * gqv[j]; n2 += v[j] * v[j]; }
          n2 = grp8_sum(n2);
          const int h = l >> 3, g = h >> 2, hp = h & 3; const size_t ridx = (((size_t)(b * 2 + g) * S + s) * 4 + hp);
          *(u32x4*)(WSP(bf16, WS_QN) + ridx * 64 + (8 * l & 63)) = pack8f(v);
          if ((l & 7) == 0) WSP(float, WS_QBN)[ridx] = sqrtf(n2) * kbn + CF[CF_MAXB2 + h]; }
        { float v[8]; unpack8(*(const u32x4*)(pr + C_KS + 8 * l), v); const int seg = l >> 4, i = l & 15, g = i >> 3, d0 = (i & 7) * 8;
          float ss = 0.f;
#pragma unroll
          for (int j = 0; j < 8; ++j) ss += v[j] * v[j];
          ss = grp8_sum(ss);
          if ((seg & 1) == 0) { const float rinv = 1.0f / sqrtf(ss * (1.0f / 64) + EPS);
#pragma unroll
              for (int j = 0; j < 8; ++j) v[j] = v[j] * rinv * gkv[j]; }
          bf16* dst = WSP(bf16, seg == 0 ? WS_KS : seg == 1 ? WS_VS : seg == 2 ? WS_KW : WS_VW);
          *(u32x4*)(dst + ((size_t)(b * 2 + g) * S + s) * 64 + d0) = pack8f(v); }
        if (l < 24) { const float x = bf2f(pr[C_GT + l]); WSP(float, WS_GATE)[t * 24 + l] = 1.0f / (1.0f + __expf(-x)); }
    }
}

__device__ __forceinline__ void compress_phase(Frame& F) {
    const float* CF = WSP(float, WS_CONST);
    const bf16* PB = WSP(bf16, WS_PB);
    LAS float* red = (LAS float*)F.lds;
    LAS float* hid = (LAS float*)(F.lds + 65536);
    LAS float* ob = (LAS float*)(F.lds + 65536 + 8192);
    const int lane = F.lane, row = lane & 15, kq = lane >> 4;
    LAS float* cps = (LAS float*)(F.lds + 65536 + 8192 + 4096);
    __syncthreads();
    if (F.tid < 256) { float a = 0.f; const float* cp = CF + CF_CPP + (F.tid >> 7) * 64 * 128 + (F.tid & 127);
#pragma unroll 8
        for (int p = 0; p < 64; ++p) a += cp[p * 128];
        cps[F.tid] = a; }
    for (int it = F.bid; it < 256; it += F.G) {
        const int kv = it >> 7, slab = (it >> 5) & 3, n0 = (it & 31) * 16, b = slab >> 1, g = slab & 1;
        const int n = n0 + row;
        int tok0 = 16 * n + 4 * F.wave; if (tok0 > S - 4) tok0 = S - 4;
        const bf16* ap = PB + (size_t)(b * S + tok0) * NINP + (kv ? C_VC : C_KC) + g * 64 + 8 * kq;
        const bf16* bp = WSP(bf16, WS_W1T) + (size_t)kv * 128 * 2048 + (size_t)row * 2048 + 256 * F.wave + 8 * kq;
        f32x4 acc[8];
#pragma unroll
        for (int i = 0; i < 8; ++i) acc[i] = (f32x4){0.f, 0.f, 0.f, 0.f};
#pragma unroll
        for (int hb = 0; hb < 2; ++hb) {
            bf16x8 af[4], bf[4][8];
#pragma unroll
            for (int s = 0; s < 4; ++s) { const int ks = hb * 4 + s;
                af[s] = *(const bf16x8*)(ap + (size_t)(ks >> 1) * NINP + 32 * (ks & 1));
#pragma unroll
                for (int fb = 0; fb < 8; ++fb) bf[s][fb] = *(const bf16x8*)(bp + (size_t)fb * 16 * 2048 + 32 * ks); }
#pragma unroll
            for (int s = 0; s < 4; ++s)
#pragma unroll
                for (int fb = 0; fb < 8; ++fb) acc[fb] = __builtin_amdgcn_mfma_f32_16x16x32_bf16(af[s], bf[s][fb], acc[fb], 0, 0, 0);
        }
        __syncthreads();
#pragma unroll
        for (int fb = 0; fb < 8; ++fb)
#pragma unroll
            for (int i = 0; i < 4; ++i) red[(F.wave * 16 + 4 * kq + i) * 128 + fb * 16 + row] = acc[fb][i];
        __syncthreads();
        { const float c0 = 0.7978845608028654f, c1 = 0.044715f;
#pragma unroll
          for (int q = 0; q < 4; ++q) { const int idx = F.tid + 512 * q; float a = cps[kv * 128 + (idx & 127)];
#pragma unroll
              for (int ww = 0; ww < 8; ++ww) a += red[ww * 2048 + idx];
              hid[idx] = 0.5f * a * (1.f + tanhf(c0 * (a + c1 * a * a * a))); } }
        __syncthreads();
        { const float* w2 = F.in[kv ? 15 : 12];
#pragma unroll
          for (int q = 0; q < 2; ++q) { const int idx = F.tid + 512 * q, r = idx >> 6, d = idx & 63; float o = 0.f;
              for (int f = 0; f < 128; ++f) o += hid[r * 128 + f] * w2[f * 64 + d];
              if (kv == 0) { const float ss = wave_sum(o * o); o = o * (1.0f / sqrtf(ss * (1.0f / 64) + EPS)) * F.in[17][d]; }
              const int nn = n0 + r; if (nn >= 511) o = 0.f;
              WSP(bf16, kv ? WS_VCMP : WS_KCMP)[((size_t)slab * 512 + nn) * 64 + d] = (bf16)(cvtpk(o, 0.f) & 0xffff); } }
    }
    __syncthreads();
}

__device__ __forceinline__ void tp_b(Frame& F) {
    const float* CF = WSP(float, WS_CONST); const float kbm = CF[CF_KBM];
    const bf16* PB = WSP(bf16, WS_PB); const bf16* QR = WSP(bf16, WS_QRAW); const bf16* KVR = WSP(bf16, WS_KVRAW);
    const int l = F.lane, h = l >> 3, c = l & 7;
    const float* gq = F.in[8]; const float* gk = F.in[9];
    float gqn[8], gkn[8], gqr[4], gkr[4];
#pragma unroll
    for (int j = 0; j < 8; ++j) { gqn[j] = gq[8 * c + j]; gkn[j] = gk[8 * c + j]; }
    gqr[0] = gq[64 + 2 * c]; gqr[1] = gq[65 + 2 * c]; gqr[2] = gq[80 + 2 * c]; gqr[3] = gq[81 + 2 * c];
    gkr[0] = gk[64 + 2 * c]; gkr[1] = gk[65 + 2 * c]; gkr[2] = gk[80 + 2 * c]; gkr[3] = gk[81 + 2 * c];
    const float if0 = exp2f(-(float)(2 * c) * (13.287712379549449f / 16.0f)), if1 = exp2f(-(float)(2 * c + 1) * (13.287712379549449f / 16.0f));
    const float cq = 0.10206207261596575f * LOG2E;
    for (int t = F.gw; t < NTOK; t += F.ngw) {
        const int b = t >> 13, s = t & 8191; const size_t hrow = ((size_t)(b * 8 + h) * S + s);
        const float rcq = WSP(float, WS_RS)[t * 4 + 1], rckv = WSP(float, WS_RS)[t * 4 + 2];
        const float rv0 = __builtin_amdgcn_fractf((float)s * if0 * 0.15915494309189535f), rv1 = __builtin_amdgcn_fractf((float)s * if1 * 0.15915494309189535f);
        const float sn0 = __builtin_amdgcn_sinf(rv0), cs0 = __builtin_amdgcn_cosf(rv0), sn1 = __builtin_amdgcn_sinf(rv1), cs1 = __builtin_amdgcn_cosf(rv1);
        {
          float v[8]; unpack8(*(const u32x4*)(QR + (size_t)t * 768 + h * 96 + 8 * c), v);
          const unsigned wa = *(const unsigned*)(QR + (size_t)t * 768 + h * 96 + 64 + 2 * c), wb = *(const unsigned*)(QR + (size_t)t * 768 + h * 96 + 80 + 2 * c);
          float r0 = bf2f(wa & 0xffff), r1 = bf2f(wa >> 16), r2 = bf2f(wb & 0xffff), r3 = bf2f(wb >> 16);
          float ss = r0 * r0 + r1 * r1 + r2 * r2 + r3 * r3;
#pragma unroll
          for (int j = 0; j < 8; ++j) ss += v[j] * v[j];
          ss = grp8_sum(ss) * rcq * rcq; const float rinv = rcq / sqrtf(ss * (1.0f / 96) + EPS) * cq; float n2 = 0.f;
#pragma unroll
          for (int j = 0; j < 8; ++j) { v[j] = v[j] * rinv * gqn[j]; n2 += v[j] * v[j]; }
          r0 *= rinv * gqr[0]; r1 *= rinv * gqr[1]; r2 *= rinv * gqr[2]; r3 *= rinv * gqr[3];
          const float y0 = r0 * cs0 - r2 * sn0, y2 = r2 * cs0 + r0 * sn0, y1 = r1 * cs1 - r3 * sn1, y3 = r3 * cs1 + r1 * sn1;
          n2 += y0 * y0 + y1 * y1 + y2 * y2 + y3 * y3; n2 = grp8_sum(n2);
          bf16* dst = WSP(bf16, WS_QM) + hrow * 96;
          *(u32x4*)(dst + 8 * c) = pack8f(v); *(unsigned*)(dst + 64 + 2 * c) = cvtpk(y0, y1); *(unsigned*)(dst + 80 + 2 * c) = cvtpk(y2, y3);
          if (c == 0) WSP(float, WS_QBM)[hrow] = sqrtf(n2) * kbm; }
        {
          float v[8]; unpack8(*(const u32x4*)(KVR + (size_t)t * 1024 + h * 128 + 8 * c), v);
          const unsigned wa = *(const unsigned*)(PB + (size_t)t * NINP + C_KR + 2 * c), wb = *(const unsigned*)(PB + (size_t)t * NINP + C_KR + 16 + 2 * c);
          float r0 = bf2f(wa & 0xffff), r1 = bf2f(wa >> 16), r2 = bf2f(wb & 0xffff), r3 = bf2f(wb >> 16);
          float ss = r0 * r0 + r1 * r1 + r2 * r2 + r3 * r3;
#pragma unroll
          for (int j = 0; j < 8; ++j) { v[j] *= rckv; ss += v[j] * v[j]; }
          ss = grp8_sum(ss); const float rinv = 1.0f / sqrtf(ss * (1.0f / 96) + EPS);
#pragma unroll
          for (int j = 0; j < 8; ++j) v[j] = v[j] * rinv * gkn[j];
          r0 *= rinv * gkr[0]; r1 *= rinv * gkr[1]; r2 *= rinv * gkr[2]; r3 *= rinv * gkr[3];
          const float y0 = r0 * cs0 - r2 * sn0, y2 = r2 * cs0 + r0 * sn0, y1 = r1 * cs1 - r3 * sn1, y3 = r3 * cs1 + r1 * sn1;
          bf16* dst = WSP(bf16, WS_KM) + hrow * 96;
          *(u32x4*)(dst + 8 * c) = pack8f(v); *(unsigned*)(dst + 64 + 2 * c) = cvtpk(y0, y1); *(unsigned*)(dst + 80 + 2 * c) = cvtpk(y2, y3); }
        { float vv[8]; unpack8(*(const u32x4*)(KVR + (size_t)t * 1024 + h * 128 + 64 + 8 * c), vv);
#pragma unroll
          for (int j = 0; j < 8; ++j) vv[j] *= rckv;
          *(u32x4*)(WSP(bf16, WS_VM) + hrow * 64 + 8 * c) = pack8f(vv); }
    }
}

__device__ __forceinline__ void tp_c0(Frame& F) {
    bf16* Y = WSP(bf16, WS_Y); const int l = F.lane;
    for (int t = F.gw; t < NTOK; t += F.ngw) {
        u32x4* p = (u32x4*)(Y + (size_t)t * 1024 + 16 * l); float v0[8], v1[8]; unpack8(p[0], v0); unpack8(p[1], v1); float ss = 0.f;
#pragma unroll
        for (int j = 0; j < 8; ++j) ss += v0[j] * v0[j] + v1[j] * v1[j];
        ss += shx<1>(ss); ss += shx<2>(ss); ss += shx<4>(ss); ss += shx<8>(ss); ss += shx<16>(ss);
        const float rinv = 1.0f / sqrtf(ss * (1.0f / 512) + EPS);
#pragma unroll
        for (int j = 0; j < 8; ++j) { v0[j] *= rinv; v1[j] *= rinv; }
        p[0] = pack8f(v0); p[1] = pack8f(v1);
    }
}
__device__ __forceinline__ void tp_c(Frame& F) {
    float* RS = WSP(float, WS_RS); bf16* XB = WSP(bf16, WS_XB);
    for (int m = F.gw; m < NTOK; m += F.ngw) {
        const f32x4* xr = (const f32x4*)(F.out + (size_t)m * D) + F.lane; f32x4 v[4]; float s = 0.f;
#pragma unroll
        for (int j = 0; j < 4; ++j) { v[j] = xr[64 * j]; s += (v[j].x * v[j].x + v[j].y * v[j].y) + (v[j].z * v[j].z + v[j].w * v[j].w); }
        s = wave_sum(s); if (F.lane == 0) RS[m * 4 + 3] = 1.0f / sqrtf(s * (1.0f / D) + EPS);
        u32x2* o8 = (u32x2*)(XB + (size_t)m * D) + F.lane;
#pragma unroll
        for (int j = 0; j < 4; ++j) { u32x2 w; w.x = cvtpk(v[j].x, v[j].y); w.y = cvtpk(v[j].z, v[j].w); o8[64 * j] = w; }
    }
}

__device__ __forceinline__ int crow(int r, int hi) { return (r & 3) + 8 * (r >> 2) + 4 * hi; }
typedef short v4i16_t __attribute__((ext_vector_type(4)));
__device__ __forceinline__ s16x4 vtr(const LAS char* p) { return __builtin_bit_cast(s16x4, __builtin_amdgcn_ds_read_tr16_b64_v4i16((LAS v4i16_t*)p)); }

template <int ROWB> struct TileRegs { u32x4 r[(64 * ROWB / 16 + 511) / 512]; };
__device__ __forceinline__ const GAS char* uni_ptr(const char* p) { const unsigned long long v = (unsigned long long)p; const unsigned lo = __builtin_amdgcn_readfirstlane((unsigned)v), hi = __builtin_amdgcn_readfirstlane((unsigned)(v >> 32)); return (const GAS char*)(((unsigned long long)hi << 32) | lo); }
template <int ROWB> __device__ __forceinline__ void tile_load(TileRegs<ROWB>& T, const char* g_, int tid) {
    constexpr int NCH = 64 * ROWB / 16; const GAS char* g = uni_ptr(g_);
#pragma unroll
    for (int i = 0; i < (NCH + 511) / 512; ++i) { const int c = tid + 512 * i; const unsigned off = (unsigned)c * 16u; if (c < NCH) T.r[i] = *(const GAS u32x4*)(g + off); }
}
template <int ROWB, int STR> __device__ __forceinline__ void tile_store(const TileRegs<ROWB>& T, LAS char* l, int tid) {
    constexpr int NCH = 64 * ROWB / 16, CPR = ROWB / 16;
#pragma unroll
    for (int i = 0; i < (NCH + 511) / 512; ++i) { const int c = tid + 512 * i; if (c < NCH) *(LAS u32x4*)(l + (c / CPR) * STR + (c % CPR) * 16) = T.r[i]; }
}
template <int DK, int KSTR> __device__ __forceinline__ void qk_tile(f32x16& p0, f32x16& p1, const LAS char* Kt, const bf16x8* q, int lane, float cinit = 0.f) {
    const LAS char* kb = Kt + (lane & 31) * KSTR + (lane >> 5) * 16;
#pragma unroll
    for (int r = 0; r < 16; ++r) { p0[r] = cinit; p1[r] = cinit; }
#pragma unroll
    for (int s = 0; s < DK / 16; ++s) {
        const bf16x8 a0 = *(const LAS bf16x8*)(kb + s * 32), a1 = *(const LAS bf16x8*)(kb + 32 * KSTR + s * 32);
        p0 = __builtin_amdgcn_mfma_f32_32x32x16_bf16(a0, q[s], p0, 0, 0, 0);
        p1 = __builtin_amdgcn_mfma_f32_32x32x16_bf16(a1, q[s], p1, 0, 0, 0);
    }
    __builtin_amdgcn_sched_barrier(0);
}
__device__ __forceinline__ bf16x8 packp(const f32x16& p, int b) {
    u32x4 w; w.x = cvtpk(p[b], p[b + 1]); w.y = cvtpk(p[b + 2], p[b + 3]); w.z = cvtpk(p[b + 4], p[b + 5]); w.w = cvtpk(p[b + 6], p[b + 7]); return __builtin_bit_cast(bf16x8, w);
}
template <int VSTR> __device__ __forceinline__ void pv_tile(f32x16 (&o)[2], const LAS char* Vt, const f32x16& p0, const f32x16& p1, int lane) {
    const int i = lane & 15, g16 = lane >> 4, hi = g16 >> 1, dblk = (g16 & 1) * 16, q_ = i >> 2, p_ = i & 3;
    const LAS char* vb = Vt + (4 * hi + q_) * VSTR + (dblk + 4 * p_) * 2;
    __builtin_amdgcn_sched_barrier(0);
#pragma unroll
    for (int s = 0; s < 4; ++s) {
        const bf16x8 pa = packp(s < 2 ? p0 : p1, (s & 1) * 8);
#pragma unroll
        for (int d0 = 0; d0 < 2; ++d0) {
            const s16x4 lo = vtr(vb + (16 * s) * VSTR + d0 * 64), h8 = vtr(vb + (16 * s + 8) * VSTR + d0 * 64);
            const bf16x8 bv = {lo[0], lo[1], lo[2], lo[3], h8[0], h8[1], h8[2], h8[3]};
            o[d0] = __builtin_amdgcn_mfma_f32_32x32x16_bf16(pa, bv, o[d0], 0, 0, 0);
        }
        __builtin_amdgcn_sched_barrier(0);
    }
}
template <int DK, int KSTR> __device__ __forceinline__ void qk_half(f32x16& p, const LAS char* Kt, const bf16x8* q, int lane, float cinit, int hf) {
    const LAS char* kb = Kt + ((lane & 31) + 32 * hf) * KSTR + (lane >> 5) * 16;
#pragma unroll
    for (int r = 0; r < 16; ++r) p[r] = cinit;
#pragma unroll
    for (int s = 0; s < DK / 16; ++s) { const bf16x8 a = *(const LAS bf16x8*)(kb + s * 32); p = __builtin_amdgcn_mfma_f32_32x32x16_bf16(a, q[s], p, 0, 0, 0); }
    __builtin_amdgcn_sched_barrier(0);
}
template <int VSTR> __device__ __forceinline__ void pv_half(f32x16 (&o)[2], const LAS char* Vt, const f32x16& p, int lane, int hf) {
    const int i = lane & 15, g16 = lane >> 4, hi = g16 >> 1, dblk = (g16 & 1) * 16, q_ = i >> 2, p_ = i & 3;
    const LAS char* vb = Vt + (32 * hf + 4 * hi + q_) * VSTR + (dblk + 4 * p_) * 2;
    __builtin_amdgcn_sched_barrier(0);
#pragma unroll
    for (int s = 0; s < 2; ++s) {
        const bf16x8 pa = packp(p, s * 8);
#pragma unroll
        for (int d0 = 0; d0 < 2; ++d0) {
            const s16x4 lo = vtr(vb + (16 * s) * VSTR + d0 * 64), h8 = vtr(vb + (16 * s + 8) * VSTR + d0 * 64);
            const bf16x8 bv = {lo[0], lo[1], lo[2], lo[3], h8[0], h8[1], h8[2], h8[3]};
            o[d0] = __builtin_amdgcn_mfma_f32_32x32x16_bf16(pa, bv, o[d0], 0, 0, 0);
        }
        __builtin_amdgcn_sched_barrier(0);
    }
}
__device__ __forceinline__ float sum16(const f32x16& p) {
    const float a = (p[0] + p[1]) + (p[2] + p[3]), b = (p[4] + p[5]) + (p[6] + p[7]), c = (p[8] + p[9]) + (p[10] + p[11]), d = (p[12] + p[13]) + (p[14] + p[15]); return (a + b) + (c + d);
}
template <int DK, int KSTR> __device__ __forceinline__ void kf_load(bf16x8 (&kf)[DK / 16], const LAS char* Kt, int lane, int hf) {
    const LAS char* kb = Kt + ((lane & 31) + 32 * hf) * KSTR + (lane >> 5) * 16;
#pragma unroll
    for (int s = 0; s < DK / 16; ++s) kf[s] = *(const LAS bf16x8*)(kb + s * 32);
}
template <int VSTR> __device__ __forceinline__ void vf_load(bf16x8 (&vf)[2][2], const LAS char* Vt, int lane, int hf) {
    const int i = lane & 15, g16 = lane >> 4, hi = g16 >> 1, dblk = (g16 & 1) * 16, q_ = i >> 2, p_ = i & 3;
    const LAS char* vb = Vt + (32 * hf + 4 * hi + q_) * VSTR + (dblk + 4 * p_) * 2;
#pragma unroll
    for (int s = 0; s < 2; ++s)
#pragma unroll
        for (int d0 = 0; d0 < 2; ++d0) { const s16x4 lo = vtr(vb + (16 * s) * VSTR + d0 * 64), h8 = vtr(vb + (16 * s + 8) * VSTR + d0 * 64);
            vf[s][d0] = (bf16x8){lo[0], lo[1], lo[2], lo[3], h8[0], h8[1], h8[2], h8[3]}; }
}
template <int DK, int KSTR, int VSTR, class CI, class EF>
__device__ __forceinline__ void attn_tile(const LAS char* Kb, const LAS char* Vb, const bf16x8* q, f32x16 (&o)[2], int lane, CI cinit, EF elem, bool act0 = true, bool act1 = true) {
    bf16x8 kf[DK / 16];
    if (act0) kf_load<DK, KSTR>(kf, Kb, lane, 0); else if (act1) kf_load<DK, KSTR>(kf, Kb, lane, 1);
#pragma unroll
    for (int hf = 0; hf < 2; ++hf) {
        if (!(hf ? act1 : act0)) continue;
        f32x16 p; const float ci = cinit(hf);
#pragma unroll
        for (int r = 0; r < 16; ++r) p[r] = ci;
        __builtin_amdgcn_sched_barrier(0);
#pragma unroll
        for (int s = 0; s < DK / 16; ++s) p = __builtin_amdgcn_mfma_f32_32x32x16_bf16(kf[s], q[s], p, 0, 0, 0);
        __builtin_amdgcn_sched_barrier(0);
        bf16x8 vf[2][2]; vf_load<VSTR>(vf, Vb, lane, hf);
        if (hf == 0 && act1) kf_load<DK, KSTR>(kf, Kb, lane, 1);
        __builtin_amdgcn_sched_barrier(0);
        elem(p, hf);
        __builtin_amdgcn_sched_barrier(0);
#pragma unroll
        for (int s = 0; s < 2; ++s) { const bf16x8 pa = packp(p, s * 8);
#pragma unroll
            for (int d0 = 0; d0 < 2; ++d0) o[d0] = __builtin_amdgcn_mfma_f32_32x32x16_bf16(pa, vf[s][d0], o[d0], 0, 0, 0); }
        __builtin_amdgcn_sched_barrier(0);
    }
}
constexpr int BCAST_OFF = LDSX_OFF + 4096;
__device__ __forceinline__ void bcast_rows(float v, LAS unsigned char* lds, int wave, int lane, float (&out)[16]) {
    LAS float* wsf = (LAS float*)(lds + BCAST_OFF) + wave * 32;
    wsf[lane & 31] = v;
    LDS_WAIT(); asm volatile("" ::: "memory");
    const LAS float* rp = wsf + 4 * (lane >> 5);
#pragma unroll
    for (int r = 0; r < 16; ++r) out[r] = rp[(r & 3) + 8 * (r >> 2)];
    LDS_WAIT(); asm volatile("" ::: "memory");
}
constexpr int KSTR64 = 144, KSTR96 = 208, VSTR64 = 192;

__device__ __forceinline__ void mla_unit(Frame& F, int bh, int qb) {
    const int lane = F.lane, hi = lane >> 5, w = F.wave;
    const int q0 = qb * 256, qpos = q0 + 32 * w + (lane & 31);
    const bf16* Qm = WSP(bf16, WS_QM) + ((size_t)bh * S + qpos) * 96;
    const char* Kg = (const char*)(WSP(bf16, WS_KM) + (size_t)bh * S * 96); const char* Vg = (const char*)(WSP(bf16, WS_VM) + (size_t)bh * S * 64);
    bf16x8 qf[6];
#pragma unroll
    for (int s = 0; s < 6; ++s) qf[s] = *(const bf16x8*)(Qm + 16 * s + 8 * hi);
    const float bound = WSP(float, WS_QBM)[(size_t)bh * S + qpos];
    LAS char* KT[2] = {(LAS char*)F.lds, (LAS char*)F.lds + 64 * KSTR96}; LAS char* VT[2] = {(LAS char*)F.lds + 2 * 64 * KSTR96, (LAS char*)F.lds + 2 * 64 * KSTR96 + 64 * VSTR64};
    f32x16 o[2]; float lsum = 0.f;
#pragma unroll
    for (int r = 0; r < 16; ++r) { o[0][r] = 0.f; o[1][r] = 0.f; }
    const int NT = (q0 + 256) / 64; const int wq0 = q0 + 32 * w;
    TileRegs<192> krA; TileRegs<128> vrA;
    auto mla_compute = [&](int t, const LAS char* Kb, const LAS char* Vb) {
        if (64 * t <= wq0 + 31) {
            const bool diag = (64 * t + 63 > wq0);
            if (diag) {
                attn_tile<96, KSTR96, VSTR64>(Kb, Vb, qf, o, lane, [&](int) { return -bound; },
                    [&](f32x16& p, int hf) {
                        const int dl = qpos - 64 * t - 32 * hf - 4 * hi;
#pragma unroll
                        for (int r = 0; r < 16; ++r) { float e = __builtin_amdgcn_exp2f(p[r]); if ((r & 3) + 8 * (r >> 2) > dl) e = 0.f; p[r] = e; }
                        lsum += sum16(p); },
                    true, 64 * t + 32 <= wq0 + 31);
            } else {
                attn_tile<96, KSTR96, VSTR64>(Kb, Vb, qf, o, lane, [&](int) { return -bound; },
                    [&](f32x16& p, int) {
#pragma unroll
                        for (int r = 0; r < 16; ++r) p[r] = __builtin_amdgcn_exp2f(p[r]);
                        lsum += sum16(p); });
            }
        } };
    __syncthreads();
    tile_load<192>(krA, Kg, F.tid); tile_load<128>(vrA, Vg, F.tid);
    tile_store<192, KSTR96>(krA, KT[0], F.tid); tile_store<128, VSTR64>(vrA, VT[0], F.tid);
    __syncthreads();
    for (int t = 0; t < NT; ++t) {
        if (t + 1 < NT) { tile_load<192>(krA, Kg + (size_t)(t + 1) * 64 * 192, F.tid); tile_load<128>(vrA, Vg + (size_t)(t + 1) * 64 * 128, F.tid); }
        mla_compute(t, KT[t & 1], VT[t & 1]);
        if (t + 1 < NT) { tile_store<192, KSTR96>(krA, KT[(t + 1) & 1], F.tid); tile_store<128, VSTR64>(vrA, VT[(t + 1) & 1], F.tid); }
        __syncthreads();
    }
    lsum = sum32x(lsum); const float linv = lsum > 0.f ? 1.0f / lsum : 0.f;
    bf16* Y = WSP(bf16, WS_Y); const int b = bh >> 3, h = bh & 7;
    float fr_[16]; bcast_rows(linv, F.lds, w, lane, fr_);
#pragma unroll
    for (int r = 0; r < 16; ++r) { const int row = crow(r, hi); const float f = fr_[r]; bf16* yp = Y + ((size_t)b * S + wq0 + row) * 1024 + h * 64 + (lane & 31);
        const float y0 = o[0][r] * f, y1 = o[1][r] * f; yp[0] = (bf16)(cvtpk(y0, 0.f) & 0xffff); yp[32] = (bf16)(cvtpk(y1, 0.f) & 0xffff);
        float ss = y0 * y0 + y1 * y1; ss += shx<1>(ss); ss += shx<2>(ss); ss += shx<4>(ss); ss += shx<8>(ss); ss += shx<16>(ss);
        if ((lane & 31) == 0) WSP(float, WS_VMEM)[((size_t)b * S + wq0 + row) * 16 + h] = ss; }
}

__device__ __forceinline__ void nsa_unit(Frame& F, int bg, int cur, bool build_tables) {
    const int lane = F.lane, hi = lane >> 5, w = F.wave, hp = w & 3, qs = w >> 2;
    const int b = bg >> 1, g = bg & 1, h = g * 4 + hp;
    const int q0 = 64 * cur, qi = 32 * qs + (lane & 31), qpos = q0 + qi;
    const float* CF = WSP(float, WS_CONST);
    constexpr int TBL = 712; constexpr float NEGB = -3.0e38f;
    LAS char* KT[2] = {(LAS char*)F.lds, (LAS char*)F.lds + 64 * KSTR64}; LAS char* VT[2] = {(LAS char*)F.lds + 2 * 64 * KSTR64, (LAS char*)F.lds + 2 * 64 * KSTR64 + 64 * VSTR64};
    LAS float* TW = (LAS float*)(F.lds + 43008);
    LAS float* TS = TW + 4 * TBL;
    LAS unsigned* MSK = (LAS unsigned*)(F.lds + 43008 + 2 * 4 * TBL * 4);
    LAS float* PL = (LAS float*)(F.lds + 66816);
    LAS float* IMP = (LAS float*)(F.lds + 66816 + 17408);
    LAS float* PARK = (LAS float*)(F.lds + 66816) + w * 2048 + lane;
    __syncthreads();
    if (build_tables)
    for (int i = F.tid; i < 4 * TBL; i += 512) { const int hh = i / TBL, x = i - hh * TBL, dist = 639 - x; const bool in = dist >= 0 && dist < 512;
        const float bv = CF[CF_BIAS2 + (in ? (int)CF[CF_LUT + dist] : 31) * 8 + g * 4 + hh];
        TW[i] = in ? bv : NEGB; TS[i] = dist < 0 ? NEGB : bv; }
    const float bias31 = CF[CF_BIAS2 + 31 * 8 + h];
    const size_t qrow = ((size_t)bg * S + qpos) * 4 + hp;
    bf16x8 qf[4];
    { const GAS char* qb = uni_ptr((const char*)(F.ws + WS_QN)); const unsigned qoff = (unsigned)qrow * 128u + 16u * hi;
#pragma unroll
      for (int s = 0; s < 4; ++s) qf[s] = *(const GAS bf16x8*)(qb + qoff + 32 * s); }
    const float bound = *(const GAS float*)(uni_ptr((const char*)(F.ws + WS_QBN)) + (unsigned)qrow * 4u);
    const float* GT = WSP(float, WS_GATE); const int gto = (b * S + qpos) * 24 + h * 3;
    const LAS float* tsl = TS + hp * TBL; const LAS float* twl = TW + hp * TBL;
    const float cfar = bias31 - bound;
    TileRegs<128> kr, vr;
    f32x16 ocmp[2];
    const int ncmp = 4 * cur + 3 < 511 ? 4 * cur + 3 : 511, nct = (ncmp + 63) / 64;
    const char* Kc = (const char*)(WSP(bf16, WS_KCMP) + (size_t)bg * 512 * 64); const char* Vc = (const char*)(WSP(bf16, WS_VCMP) + (size_t)bg * 512 * 64);
#define NSA_CMP_EXP(T_, HF_, P_, SCALE_) do { \
        if (q0 - (16 * (64 * (T_) + 63) + 31) >= 512) { \
            _Pragma("unroll") for (int r = 0; r < 16; ++r) P_[r] = __builtin_amdgcn_exp2f(P_[r]) * (SCALE_); \
        } else { \
            _Pragma("unroll") for (int r = 0; r < 16; ++r) { const int n = 64 * (T_) + 32 * (HF_) + crow(r, hi); const int dist = qpos - (16 * n + 31); \
                const float bs = dist < 512 ? tsl[639 - (dist < 0 ? 0 : dist)] - bias31 : 0.f; const float sv = P_[r] + bs; \
                P_[r] = dist >= 0 ? __builtin_amdgcn_exp2f(sv) * (SCALE_) : 0.f; \
                if ((r & 3) == 3) __builtin_amdgcn_sched_barrier(0); } \
        } } while (0)
    float lc = 0.f;
    __syncthreads();
    for (int t = 0; t < nct; ++t) {
        tile_load<128>(kr, Kc + (size_t)t * 8192, F.tid); tile_store<128, KSTR64>(kr, KT[0], F.tid); __syncthreads();
        { bf16x8 kf[4]; kf_load<64, KSTR64>(kf, KT[0], lane, 0);
#pragma unroll
          for (int hf = 0; hf < 2; ++hf) { f32x16 p;
#pragma unroll
            for (int r = 0; r < 16; ++r) p[r] = cfar;
#pragma unroll
            for (int s = 0; s < 4; ++s) p = __builtin_amdgcn_mfma_f32_32x32x16_bf16(kf[s], qf[s], p, 0, 0, 0);
            __builtin_amdgcn_sched_barrier(0);
            if (hf == 0) kf_load<64, KSTR64>(kf, KT[0], lane, 1);
            NSA_CMP_EXP(t, hf, p, 1.0f);
            lc += sum16(p); } }
        __syncthreads();
    }
    lc = sum32x(lc); const float lcinv = lc > 0.f ? 1.0f / lc : 0.f;
    {
        f32x16 o[2];
#pragma unroll
        for (int r = 0; r < 16; ++r) { o[0][r] = 0.f; o[1][r] = 0.f; }
        float carry = 0.f;
        for (int t = 0; t < nct; ++t) {
            tile_load<128>(kr, Kc + (size_t)t * 8192, F.tid); tile_load<128>(vr, Vc + (size_t)t * 8192, F.tid);
            tile_store<128, KSTR64>(kr, KT[0], F.tid); tile_store<128, VSTR64>(vr, VT[0], F.tid); __syncthreads();
            float yprev = carry; f32x16 ph[2];
            bf16x8 kf[4]; kf_load<64, KSTR64>(kf, KT[0], lane, 0);
#pragma unroll
            for (int hf = 0; hf < 2; ++hf) {
#pragma unroll
                for (int r = 0; r < 16; ++r) ph[hf][r] = cfar;
#pragma unroll
                for (int s = 0; s < 4; ++s) ph[hf] = __builtin_amdgcn_mfma_f32_32x32x16_bf16(kf[s], qf[s], ph[hf], 0, 0, 0);
                __builtin_amdgcn_sched_barrier(0);
                if (hf == 0) kf_load<64, KSTR64>(kf, KT[0], lane, 1);
                NSA_CMP_EXP(t, hf, ph[hf], lcinv);
#pragma unroll
                for (int gi = 0; gi < 4; ++gi) { const f32x16& P = ph[hf]; const float x = P[4 * gi + 3]; const float y = shx<32>(x);
                    const float prev = hi ? y : yprev; PL[(hp * 64 + qi) * 17 + 8 * hf + 2 * gi + hi] = (P[4 * gi] + P[4 * gi + 1]) + (P[4 * gi + 2] + x) + prev; yprev = y; } }
            carry = yprev;
            __syncthreads();
#pragma unroll
            for (int q2 = 0; q2 < 2; ++q2) { const int idx = F.tid + 512 * q2, qq = idx >> 4, jl = idx & 15;
                IMP[qq * 128 + 16 * t + jl] = (PL[(0 * 64 + qq) * 17 + jl] + PL[(1 * 64 + qq) * 17 + jl]) + (PL[(2 * 64 + qq) * 17 + jl] + PL[(3 * 64 + qq) * 17 + jl]); }
#pragma unroll
            for (int hf = 0; hf < 2; ++hf) { bf16x8 vf[2][2]; vf_load<VSTR64>(vf, VT[0], lane, hf);
#pragma unroll
                for (int s = 0; s < 2; ++s) { const bf16x8 pa = packp(ph[hf], s * 8);
#pragma unroll
                    for (int d0 = 0; d0 < 2; ++d0) o[d0] = __builtin_amdgcn_mfma_f32_32x32x16_bf16(pa, vf[s][d0], o[d0], 0, 0, 0); } }
            __syncthreads();
        }
        const float g0 = GT[gto];
        float fr_[16]; bcast_rows(g0, F.lds, w, lane, fr_);
#pragma unroll
        for (int r = 0; r < 16; ++r) { const float f = fr_[r]; ocmp[0][r] = o[0][r] * f; ocmp[1][r] = o[1][r] * f; }
    }
#undef NSA_CMP_EXP
    {
        for (int i8 = 0; i8 < 8; i8 += 4) {
            unsigned long long mlo[4], mhi[4];
            if (cur < 16) {
#pragma unroll
                for (int k = 0; k < 4; ++k) { mlo[k] = (1ull << (cur + 1)) - 1ull; mhi[k] = 0ull; }
            } else {
                const int ja = lane, jb = lane + 64; const bool va = ja >= 1 && ja <= cur - 2, vb = jb <= cur - 2;
                unsigned ua[4], ub[4], thr[4];
#pragma unroll
                for (int k = 0; k < 4; ++k) { const int q = w * 8 + i8 + k; ua[k] = __float_as_uint(IMP[q * 128 + lane]); ub[k] = __float_as_uint(IMP[q * 128 + 64 + lane]); thr[k] = 0u; }
                for (int bit = 30; bit >= 0; --bit) {
#pragma unroll
                    for (int k = 0; k < 4; ++k) { const unsigned trial = thr[k] | (1u << bit);
                        const int cnt = __popcll(__ballot(va && ua[k] >= trial)) + __popcll(__ballot(vb && ub[k] >= trial)); if (cnt >= 13) thr[k] = trial; } }
#pragma unroll
                for (int k = 0; k < 4; ++k) {
                    const bool ga = va && ua[k] > thr[k], gb = vb && ub[k] > thr[k], ea = va && ua[k] == thr[k], eb = vb && ub[k] == thr[k];
                    const int need = 13 - (__popcll(__ballot(ga)) + __popcll(__ballot(gb)));
                    const unsigned long long ma = __ballot(ea), mb = __ballot(eb);
                    const int ra = (int)__builtin_amdgcn_mbcnt_hi((unsigned)(ma >> 32), __builtin_amdgcn_mbcnt_lo((unsigned)ma, 0u));
                    const int rb = __popcll(ma) + (int)__builtin_amdgcn_mbcnt_hi((unsigned)(mb >> 32), __builtin_amdgcn_mbcnt_lo((unsigned)mb, 0u));
                    const bool sa = ga || (ea && ra < need) || ja == 0 || ja == cur || ja == cur - 1;
                    const bool sb = gb || (eb && rb < need) || jb == cur || jb == cur - 1;
                    mlo[k] = __ballot(sa); mhi[k] = __ballot(sb); }
            }
            if (lane == 0) {
#pragma unroll
                for (int k = 0; k < 4; ++k) { const int q = w * 8 + i8 + k; MSK[q * 4 + 0] = (unsigned)mlo[k]; MSK[q * 4 + 1] = (unsigned)(mlo[k] >> 32); MSK[q * 4 + 2] = (unsigned)mhi[k]; MSK[q * 4 + 3] = (unsigned)(mhi[k] >> 32); } }
        }
        __syncthreads();
    }
#pragma unroll
    for (int r = 0; r < 16; ++r) { PARK[r * 64] = ocmp[0][r]; PARK[(16 + r) * 64] = ocmp[1][r]; }
    {
        const char* Kg = (const char*)(WSP(bf16, WS_KS) + (size_t)bg * S * 64); const char* Vg = (const char*)(WSP(bf16, WS_VS) + (size_t)bg * S * 64);
        f32x16 o[2]; float ls = 0.f;
#pragma unroll
        for (int r = 0; r < 16; ++r) { o[0][r] = 0.f; o[1][r] = 0.f; }
        const int NT = cur + 1;
        auto slc_compute = [&](int j, const LAS char* Kb, const LAS char* Vb) {
            const unsigned mw = MSK[qi * 4 + (j >> 5)]; const bool sel = (mw >> (j & 31)) & 1u;
            if (__ballot(sel) != 0ull) {
                if (cur - j >= 9) {
                    const float ci = sel ? cfar : NEGB;
                    attn_tile<64, KSTR64, VSTR64>(Kb, Vb, qf, o, lane, [&](int) { return ci; },
                        [&](f32x16& p, int) {
#pragma unroll
                            for (int r = 0; r < 16; ++r) p[r] = __builtin_amdgcn_exp2f(p[r]);
                            ls += sum16(p); });
                } else {
                    const float ci = sel ? -bound : NEGB;
                    const LAS float* tp = tsl + (639 - (qpos - 64 * j - 4 * hi));
                    attn_tile<64, KSTR64, VSTR64>(Kb, Vb, qf, o, lane, [&](int) { return ci; },
                        [&](f32x16& p, int hf) {
#pragma unroll
                            for (int r = 0; r < 16; ++r) { const int c = (r & 3) + 8 * (r >> 2) + 32 * hf; p[r] = __builtin_amdgcn_exp2f(p[r] + tp[c]); }
                            ls += sum16(p); });
                }
            } };
        TileRegs<128> krB, vrB;
        tile_load<128>(kr, Kg, F.tid); tile_load<128>(vr, Vg, F.tid);
        if (NT > 1) { tile_load<128>(krB, Kg + (size_t)8192, F.tid); tile_load<128>(vrB, Vg + (size_t)8192, F.tid); }
        tile_store<128, KSTR64>(kr, KT[0], F.tid); tile_store<128, VSTR64>(vr, VT[0], F.tid);
        __syncthreads();
        for (int j = 0; j < NT; j += 2) {
            if (j + 2 < NT) { tile_load<128>(kr, Kg + (size_t)(j + 2) * 8192, F.tid); tile_load<128>(vr, Vg + (size_t)(j + 2) * 8192, F.tid); }
            slc_compute(j, KT[0], VT[0]);
            if (j + 1 < NT) { tile_store<128, KSTR64>(krB, KT[1], F.tid); tile_store<128, VSTR64>(vrB, VT[1], F.tid); }
            __syncthreads();
            if (j + 1 >= NT) break;
            if (j + 3 < NT) { tile_load<128>(krB, Kg + (size_t)(j + 3) * 8192, F.tid); tile_load<128>(vrB, Vg + (size_t)(j + 3) * 8192, F.tid); }
            slc_compute(j + 1, KT[1], VT[1]);
            if (j + 2 < NT) { tile_store<128, KSTR64>(kr, KT[0], F.tid); tile_store<128, VSTR64>(vr, VT[0], F.tid); }
            __syncthreads();
        }
        ls = sum32x(ls); const float fs = ls > 0.f ? GT[gto + 1] / ls : 0.f;
        float fr_[16]; bcast_rows(fs, F.lds, w, lane, fr_);
#pragma unroll
        for (int r = 0; r < 16; ++r) { const float f = fr_[r]; PARK[r * 64] += o[0][r] * f; PARK[(16 + r) * 64] += o[1][r] * f; }
    }
    {
        const char* Kg = (const char*)(WSP(bf16, WS_KW) + (size_t)bg * S * 64); const char* Vg = (const char*)(WSP(bf16, WS_VW) + (size_t)bg * S * 64);
        f32x16 o[2]; float ls = 0.f;
#pragma unroll
        for (int r = 0; r < 16; ++r) { o[0][r] = 0.f; o[1][r] = 0.f; }
        const int j0 = cur >= 8 ? cur - 8 : 0;
        tile_load<128>(kr, Kg + (size_t)j0 * 8192, F.tid); tile_load<128>(vr, Vg + (size_t)j0 * 8192, F.tid);
        tile_store<128, KSTR64>(kr, KT[0], F.tid); tile_store<128, VSTR64>(vr, VT[0], F.tid);
        __syncthreads();
        for (int j = j0; j <= cur; ++j) { const int bi = (j - j0) & 1;
            if (j < cur) { tile_load<128>(kr, Kg + (size_t)(j + 1) * 8192, F.tid); tile_load<128>(vr, Vg + (size_t)(j + 1) * 8192, F.tid); }
            const LAS float* tp = twl + (639 - (qpos - 64 * j - 4 * hi));
            attn_tile<64, KSTR64, VSTR64>(KT[bi], VT[bi], qf, o, lane, [&](int) { return -bound; },
                [&](f32x16& p, int hf) {
#pragma unroll
                    for (int r = 0; r < 16; ++r) { const int c = (r & 3) + 8 * (r >> 2) + 32 * hf; p[r] = __builtin_amdgcn_exp2f(p[r] + tp[c]); }
                    ls += sum16(p); });
            if (j < cur) { tile_store<128, KSTR64>(kr, KT[bi ^ 1], F.tid); tile_store<128, VSTR64>(vr, VT[bi ^ 1], F.tid); }
            __syncthreads();
        }
        ls = sum32x(ls); const float fs = ls > 0.f ? GT[gto + 2] / ls : 0.f;
        float fr_[16]; bcast_rows(fs, F.lds, w, lane, fr_);
#pragma unroll
        for (int r = 0; r < 16; ++r) { const float f = fr_[r]; PARK[r * 64] += o[0][r] * f; PARK[(16 + r) * 64] += o[1][r] * f; }
    }
    bf16* Y = WSP(bf16, WS_Y);
#pragma unroll
    for (int r = 0; r < 16; ++r) { const int row = crow(r, hi); bf16* yp = Y + ((size_t)b * S + q0 + 32 * qs + row) * 1024 + 512 + h * 64 + (lane & 31);
        const float y0 = PARK[r * 64], y1 = PARK[(16 + r) * 64]; yp[0] = (bf16)(cvtpk(y0, 0.f) & 0xffff); yp[32] = (bf16)(cvtpk(y1, 0.f) & 0xffff);
        float ss = y0 * y0 + y1 * y1; ss += shx<1>(ss); ss += shx<2>(ss); ss += shx<4>(ss); ss += shx<8>(ss); ss += shx<16>(ss);
        if ((lane & 31) == 0) WSP(float, WS_VMEM)[((size_t)b * S + q0 + 32 * qs + row) * 16 + 8 + h] = ss; }
}

__device__ __forceinline__ void mem_unit(Frame& F, int bh, int qb) {
    const int lane = F.lane, hi = lane >> 5, w = F.wave; const int b = bh >> 2, hm = bh & 3;
    const int tok = b * S + qb * 256 + 32 * w + (lane & 31);
    const float* CF = WSP(float, WS_CONST);
    const bf16* qp = WSP(bf16, WS_QMEM) + (size_t)tok * 256 + hm * 64; float qv[4][8]; float ss = 0.f;
#pragma unroll
    for (int s = 0; s < 4; ++s) { unpack8(*(const u32x4*)(qp + 16 * s + 8 * hi), qv[s]);
#pragma unroll
        for (int j = 0; j < 8; ++j) ss += qv[s][j] * qv[s][j]; }
    ss = sum32x(ss); const float rinv = 1.0f / sqrtf(ss * (1.0f / 64) + EPS) * (0.125f * LOG2E); float n2 = 0.f;
    bf16x8 qf[4];
#pragma unroll
    for (int s = 0; s < 4; ++s) {
#pragma unroll
        for (int j = 0; j < 8; ++j) { qv[s][j] *= rinv * F.in[26][16 * s + 8 * hi + j]; n2 += qv[s][j] * qv[s][j]; }
        qf[s] = __builtin_bit_cast(bf16x8, pack8f(qv[s])); }
    n2 = sum32x(n2); const float bound = sqrtf(n2) * CF[CF_KBMEM];
    LAS char* KT = (LAS char*)F.lds; LAS char* VT = (LAS char*)F.lds + 64 * KSTR64;
    const GAS char* Kg = uni_ptr((const char*)(WSP(bf16, WS_KVMR) + (size_t)b * 256 * 512 + hm * 64)); const GAS char* Vg = Kg + 512;
    const int trow = F.tid >> 3, tch = F.tid & 7; float gmk[8];
#pragma unroll
    for (int j = 0; j < 8; ++j) gmk[j] = F.in[27][8 * tch + j];
    f32x16 o[2]; float ls = 0.f;
#pragma unroll
    for (int r = 0; r < 16; ++r) { o[0][r] = 0.f; o[1][r] = 0.f; }
    TileRegs<128> kr, vr;
    for (int t = 0; t < 4; ++t) {
        __syncthreads();
        { const unsigned goff = (unsigned)(64 * t + trow) * 1024u + 16u * tch;
          kr.r[0] = *(const GAS u32x4*)(Kg + goff); vr.r[0] = *(const GAS u32x4*)(Vg + goff);
          float kv8[8]; unpack8(kr.r[0], kv8); float ssk = 0.f;
#pragma unroll
          for (int j = 0; j < 8; ++j) ssk += kv8[j] * kv8[j];
          ssk = grp8_sum(ssk); const float rk = 1.0f / sqrtf(ssk * (1.0f / 64) + EPS);
#pragma unroll
          for (int j = 0; j < 8; ++j) kv8[j] *= rk * gmk[j];
          kr.r[0] = pack8f(kv8); }
        tile_store<128, KSTR64>(kr, KT, F.tid); tile_store<128, VSTR64>(vr, VT, F.tid);
        __syncthreads();
        attn_tile<64, KSTR64, VSTR64>(KT, VT, qf, o, lane, [&](int) { return -bound; },
            [&](f32x16& p, int) {
#pragma unroll
                for (int r = 0; r < 16; ++r) p[r] = __builtin_amdgcn_exp2f(p[r]);
                ls += sum16(p); });
    }
    ls = sum32x(ls); const float linv = 1.0f / ls;
    bf16* O = WSP(bf16, WS_OMEM);
    float fr_[16]; bcast_rows(linv, F.lds, w, lane, fr_);
#pragma unroll
    for (int r = 0; r < 16; ++r) { const int row = crow(r, hi); const float f = fr_[r]; bf16* yp = O + ((size_t)b * S + qb * 256 + 32 * w + row) * 256 + hm * 64 + (lane & 31);
        yp[0] = (bf16)(cvtpk(o[0][r] * f, 0.f) & 0xffff); yp[32] = (bf16)(cvtpk(o[1][r] * f, 0.f) & 0xffff); }
}

__device__ __forceinline__ void tp_d(Frame& F) {
    LAS float* part = (LAS float*)F.lds;
    LAS float* ssqp = part + 4 * 2 * 32 * 33;
    LAS float* rin = ssqp + 256;
    LAS float* LG = (LAS float*)(F.lds + LDSX_OFF);
    LAS unsigned* lcnt = (LAS unsigned*)(F.lds + LDSX_OFF + 64 * 33 * 4);
    LAS unsigned* lbase = lcnt + 32;
    const float* rb = F.in[31];
    const bf16* XB = WSP(bf16, WS_XB); const bf16* WH = WSP(bf16, WS_WRH); const bf16* WL = WSP(bf16, WS_WRL);
    unsigned* cnt = (unsigned*)(F.ws + WS_CTL) + CW_CNT; int* ASG = WSP(int, WS_ASG);
    const int l = F.lane, t = l & 31, hi = l >> 5, tg = F.wave & 1, kq = F.wave >> 1;
    for (int m0 = F.bid * 64; m0 < NTOK; m0 += F.G * 64) {
        __syncthreads();
        if (F.tid < 32) lcnt[F.tid] = 0u;
        { f32x16 acc; float ss = 0.f;
#pragma unroll
          for (int r = 0; r < 16; ++r) acc[r] = 0.f;
          const bf16* xp = XB + (size_t)(m0 + 32 * tg + t) * D + 256 * kq + 8 * hi; const bf16* hp_ = WH + t * 1024 + 256 * kq + 8 * hi; const bf16* lp_ = WL + t * 1024 + 256 * kq + 8 * hi;
#pragma unroll 4
          for (int s = 0; s < 16; ++s) { const u32x4 xw = *(const u32x4*)(xp + 16 * s); const bf16x8 xb = __builtin_bit_cast(bf16x8, xw);
              const bf16x8 ah = *(const bf16x8*)(hp_ + 16 * s), al = *(const bf16x8*)(lp_ + 16 * s);
              acc = __builtin_amdgcn_mfma_f32_32x32x16_bf16(ah, xb, acc, 0, 0, 0); acc = __builtin_amdgcn_mfma_f32_32x32x16_bf16(al, xb, acc, 0, 0, 0);
              float xv[8]; unpack8(xw, xv);
#pragma unroll
              for (int j = 0; j < 8; ++j) ss += xv[j] * xv[j]; }
#pragma unroll
          for (int r = 0; r < 16; ++r) part[((kq * 2 + tg) * 32 + crow(r, hi)) * 33 + t] = acc[r];
          ss = sum32x(ss); if (hi == 0) ssqp[kq * 64 + 32 * tg + t] = ss; }
        __syncthreads();
        if (F.tid < 64) rin[F.tid] = 1.0f / sqrtf(((ssqp[F.tid] + ssqp[64 + F.tid]) + (ssqp[128 + F.tid] + ssqp[192 + F.tid])) * (1.0f / D) + EPS);
        __syncthreads();
        { const int tt = F.tid & 63, e0 = (F.tid >> 6) * 4, g2 = tt >> 5, t2 = tt & 31; const float rv = rin[tt];
#pragma unroll
          for (int j = 0; j < 4; ++j) { const int e = e0 + j; const float a = (part[((0 * 2 + g2) * 32 + e) * 33 + t2] + part[((1 * 2 + g2) * 32 + e) * 33 + t2]) + (part[((2 * 2 + g2) * 32 + e) * 33 + t2] + part[((3 * 2 + g2) * 32 + e) * 33 + t2]);
              LG[tt * 33 + e] = a * rv + rb[e]; } }
#pragma unroll 4
        for (int q = 0; q < 16; ++q) { const int c = F.tid + 512 * q, row = c >> 7, ch = c & 127; float xv[8]; unpack8(*(const u32x4*)(XB + (size_t)(m0 + row) * D + 8 * ch), xv); const float rv = rin[row];
#pragma unroll
            for (int j = 0; j < 8; ++j) xv[j] *= rv;
            *(u32x4*)(WSP(bf16, WS_Y) + (size_t)(m0 + row) * D + 8 * ch) = pack8f(xv); }
        __syncthreads();
        if (F.wave == 0) {
            const int m = m0 + l; float lg[32];
#pragma unroll
            for (int e = 0; e < 32; ++e) lg[e] = LG[l * 33 + e];
            int idx[4]; float val[4];
#pragma unroll
            for (int k = 0; k < 4; ++k) { float bv = -3.0e38f; int bi = 0;
#pragma unroll
                for (int e = 0; e < 32; ++e) { const bool taken = (k > 0 && idx[0] == e) || (k > 1 && idx[1] == e) || (k > 2 && idx[2] == e); if (!taken && lg[e] > bv) { bv = lg[e]; bi = e; } }
                idx[k] = bi; val[k] = bv; }
            const float e1 = __expf(val[1] - val[0]), e2 = __expf(val[2] - val[0]), e3 = __expf(val[3] - val[0]); const float inv = 1.0f / (1.0f + e1 + e2 + e3);
            const float ge[4] = {inv, e1 * inv, e2 * inv, e3 * inv};
            unsigned lp[4];
#pragma unroll
            for (int k = 0; k < 4; ++k) lp[k] = atomicAdd((unsigned*)&lcnt[idx[k]], 1u);
            LDS_WAIT(); asm volatile("" ::: "memory");
            if (l < 32) { const unsigned c = lcnt[l]; lbase[l] = c ? atomicAdd(&cnt[l], c) : 0u; }
            LDS_WAIT(); asm volatile("" ::: "memory");
#pragma unroll
            for (int k = 0; k < 4; ++k) { ASG[(m * 4 + k) * 2 + 0] = idx[k] | ((int)(lbase[idx[k]] + lp[k]) << 8); ASG[(m * 4 + k) * 2 + 1] = __float_as_int(ge[k]); }
        }
    }
    __syncthreads();
}
__device__ __forceinline__ void moe_tables(Frame& F, LAS int* mt, LAS int* ro) {
    __syncthreads();
    if (F.tid == 0) { unsigned* cnt = (unsigned*)(F.ws + WS_CTL) + CW_CNT; int acc = 0;
        for (int e = 0; e < 32; ++e) { const int c = (int)__hip_atomic_load(cnt + e, __ATOMIC_RELAXED, __HIP_MEMORY_SCOPE_AGENT); const int t = (c + 255) >> 8; mt[e] = t; ro[e] = acc; acc += t * 256; } }
    __syncthreads();
}
__device__ __forceinline__ void moe_gather(Frame& F) {
    LAS int* mt = (LAS int*)(F.lds + LDSX_OFF + 1024); LAS int* ro = mt + 32;
    moe_tables(F, mt, ro);
    const int* ASG = WSP(int, WS_ASG); const bf16* XB = WSP(bf16, WS_Y); bf16* A1 = WSP(bf16, WS_A1);
    for (int m = F.gw; m < NTOK; m += F.ngw) {
        const u32x4* src = (const u32x4*)(XB + (size_t)m * D) + F.lane; const u32x4 a = src[0], b = src[64];
#pragma unroll
        for (int k = 0; k < 4; ++k) { const int pe = ASG[(m * 4 + k) * 2]; const int e = pe & 255, pos = pe >> 8; const size_t row = (size_t)ro[e] + pos;
            u32x4* dst = (u32x4*)(A1 + row * D) + F.lane; dst[0] = a; dst[64] = b; }
    }
}
__device__ __forceinline__ void moe_combine(Frame& F) {
    LAS int* mt = (LAS int*)(F.lds + LDSX_OFF + 1024); LAS int* ro = mt + 32;
    moe_tables(F, mt, ro);
    const int* ASG = WSP(int, WS_ASG); const bf16* Yb = WSP(bf16, WS_A1);
    for (int m = F.gw; m < NTOK; m += F.ngw) {
        f32x4* op = (f32x4*)(F.out + (size_t)m * D) + 4 * F.lane; f32x4 o[4];
        { const u32x4* xp = (const u32x4*)(WSP(bf16, WS_XB) + (size_t)m * D + 16 * F.lane); float x0[8], x1[8]; unpack8(xp[0], x0); unpack8(xp[1], x1);
          o[0] = (f32x4){x0[0], x0[1], x0[2], x0[3]}; o[1] = (f32x4){x0[4], x0[5], x0[6], x0[7]}; o[2] = (f32x4){x1[0], x1[1], x1[2], x1[3]}; o[3] = (f32x4){x1[4], x1[5], x1[6], x1[7]}; }
#pragma unroll
        for (int k = 0; k < 4; ++k) { const int pe = ASG[(m * 4 + k) * 2]; const float gw = __int_as_float(ASG[(m * 4 + k) * 2 + 1]); const int e = pe & 255, pos = pe >> 8; const size_t row = (size_t)ro[e] + pos;
            const u32x4* yp = (const u32x4*)(Yb + row * D + 16 * F.lane); float y0[8], y1[8]; unpack8(yp[0], y0); unpack8(yp[1], y1);
            o[0] += gw * (f32x4){y0[0], y0[1], y0[2], y0[3]}; o[1] += gw * (f32x4){y0[4], y0[5], y0[6], y0[7]};
            o[2] += gw * (f32x4){y1[0], y1[1], y1[2], y1[3]}; o[3] += gw * (f32x4){y1[4], y1[5], y1[6], y1[7]}; }
#pragma unroll
        for (int j = 0; j < 4; ++j) op[j] = o[j];
    }
}

#ifndef LB
#define LB 512
#endif
__global__ void __launch_bounds__(LB) fwd_kernel(Args args) {
    extern __shared__ __attribute__((aligned(16))) unsigned char lds_raw[];
    Frame F;
    F.lds = (LAS unsigned char*)lds_raw; F.tid = threadIdx.x; F.lane = F.tid & 63; F.wave = __builtin_amdgcn_readfirstlane(F.tid >> 6);
    F.G = gridDim.x; F.bid = blockIdx.x; F.gw = F.bid * 8 + F.wave; F.ngw = F.G * 8;
    F.in = args.in; F.out = args.out; F.ws = args.ws;
    for (int u = F.tid; u < 128; u += 512) ((LAS unsigned*)(F.lds + LDSCTL_OFF))[u] = 0u;
    __syncthreads();
    unsigned* ctl = (unsigned*)(F.ws + WS_CTL);
    XcdBarrier bar = xcd_barrier_post(ctl + CW_BAR, (volatile LAS unsigned*)(F.lds + LDSCTL_OFF) + 8);
#ifndef PHM
#define PHM 0xFFFFFFFFu
#endif
#define RELAUNDER() do { int t_ = F.wave * 64 + (int)lane_id_opaque(); F.tid = t_; F.lane = t_ & 63; } while (0)
#define PH(n) RELAUNDER(); if (PHM & (1u << (n)))
#ifndef PRB_A
#define PRB_A -1
#endif
#ifndef PRB_B
#define PRB_B -1
#endif
    volatile LAS unsigned long long* TS = (volatile LAS unsigned long long*)(F.lds + LDSCTL_OFF + 128);
#define STAMP(k) do { if (PRB_A >= 0 && blockIdx.x == 0 && F.tid == 0) TS[k] = __builtin_amdgcn_s_memrealtime(); } while (0)
#define GRID_BAR() do { RELAUNDER(); xcd_barrier(bar, F.tid == 0); } while (0)
    float* RS = WSP(float, WS_RS);
    STAMP(0); PH(0) { FSTAMP(F, 30); FSTAMP(F, 31); PH(21) p0_prologue(F); FSTAMP(F, 34); } GRID_BAR(); STAMP(1); FSTAMP(F, 35);
#ifdef DUMMY_STREAM
    STAMP(30);
    { f32x4 acc4 = {0.f, 0.f, 0.f, 0.f}; const f32x4* p1 = (const f32x4*)F.in[32]; const f32x4* p2 = (const f32x4*)F.in[34];
      const size_t n1 = (size_t)32 * 1024 * 2048 / 4, n2 = (size_t)32 * 1024 * 1024 / 4; const size_t gt = (size_t)F.bid * 512 + F.tid, gs_ = (size_t)F.G * 512;
      for (size_t i = gt; i < n1; i += 4 * gs_) { acc4 += p1[i]; if (i + gs_ < n1) acc4 += p1[i + gs_]; if (i + 2 * gs_ < n1) acc4 += p1[i + 2 * gs_]; if (i + 3 * gs_ < n1) acc4 += p1[i + 3 * gs_]; }
      for (size_t i = gt; i < n2; i += 4 * gs_) { acc4 += p2[i]; if (i + gs_ < n2) acc4 += p2[i + gs_]; if (i + 2 * gs_ < n2) acc4 += p2[i + 2 * gs_]; if (i + 3 * gs_ < n2) acc4 += p2[i + 3 * gs_]; }
      WSP(float, WS_CONST)[4096 + (F.bid * 512 + F.tid) % 2048] = acc4.x + acc4.y + acc4.z + acc4.w; }
    GRID_BAR(); STAMP(31);
#endif
    PH(1) { pg8::Gemm g{WSP(bf16, WS_XB), WSP(bf16, WS_WIN), 1024, 1024, 1024}; pg8::StaticOrder So; So.init(NTOK, NINP, F.G, F.bid);
      pg8::EpiScaleBf16 E{WSP(bf16, WS_PB), NINP, RS + 0, 4}; pg8::gemm_phase(F.lds, g, So, E, F.tid); }
    PH(1) if (F.bid >= F.G - 4) { pg8::Gemm g{WSP(bf16, WS_MEMB), WSP(bf16, WS_WMKVT), 1024, 1024, 1024}; pg8::StaticOrder So; So.init(512, 512, 4, F.bid - (F.G - 4));
      pg8::EpiScaleBf16 E{WSP(bf16, WS_KVMR), 512, WSP(float, WS_RSM), 1}; pg8::gemm_phase(F.lds, g, So, E, F.tid); }
    GRID_BAR(); STAMP(2);
    PH(3) { pg8::Gemm g{WSP(bf16, WS_PB) + C_CQ, WSP(bf16, WS_WUQ), NINP, 256, 256}; pg8::StaticOrder So; So.init(NTOK, 768, F.G, F.bid);
      pg8::EpiScaleBf16 E{WSP(bf16, WS_QRAW), 768, nullptr, 0}; pg8::gemm_phase(F.lds, g, So, E, F.tid); }
    PH(3) { pg8::Gemm g{WSP(bf16, WS_PB) + C_CKV, WSP(bf16, WS_WUKV), NINP, 256, 256}; pg8::StaticOrder So; So.init(NTOK, 1024, F.G, F.bid);
      pg8::EpiScaleBf16 E{WSP(bf16, WS_KVRAW), 1024, nullptr, 0}; pg8::gemm_phase(F.lds, g, So, E, F.tid); }
    STAMP(3);
    PH(2) tp_a(F); PH(17) compress_phase(F); GRID_BAR(); STAMP(4); STAMP(5);
    PH(4) tp_b(F); GRID_BAR(); STAMP(6);
    { const int vcu = (F.G % 8 == 0) ? (F.bid % 8) * (F.G / 8) + F.bid / 8 : F.bid;
      PH(5) for (int v = vcu; v < 256; v += F.G) { const int bh = v >> 4, sidx = v & 15; mla_unit(F, bh, 31 - sidx); mla_unit(F, bh, sidx); }
      STAMP(7);
      PH(18) for (int v = vcu; v < 256; v += F.G) { const int bg = v >> 6, sidx = v & 63; nsa_unit(F, bg, 127 - sidx, true); nsa_unit(F, bg, sidx, false); } }
    GRID_BAR(); STAMP(8);
    STAMP(9);
    PH(7) { pg8::Gemm g{WSP(bf16, WS_Y), WSP(bf16, WS_WOUT), 1024, 1024, 1024}; pg8::StaticOrder So; So.init(NTOK, 1024, F.G, F.bid);
      pg8::EpiOutProj E{WSP(bf16, WS_XB), 1024, WSP(float, WS_KMEM), WSP(float, WS_VMEM)}; pg8::gemm_phase_mid(F.lds, g, So, E, F.tid); }
    GRID_BAR(); STAMP(10); STAMP(11);
    PH(9) { pg8::Gemm g{WSP(bf16, WS_XB), WSP(bf16, WS_WMQ), 1024, 1024, 1024}; pg8::StaticOrder So; So.init(NTOK, 256, F.G, F.bid);
      pg8::EpiSsqScaleBf16 E{WSP(bf16, WS_QMEM), 256, WSP(float, WS_KMEM)}; pg8::gemm_phase(F.lds, g, So, E, F.tid); }
    GRID_BAR(); STAMP(12);
    PH(10) for (int v = F.bid; v < 256; v += F.G) mem_unit(F, v >> 5, v & 31);
    GRID_BAR(); STAMP(13);
    PH(11) { pg8::Gemm g{WSP(bf16, WS_OMEM), WSP(bf16, WS_WMO), 256, 256, 256}; pg8::StaticOrder So; So.init(NTOK, 1024, F.G, F.bid);
      pg8::EpiAddBf16 E{WSP(bf16, WS_XB), 1024}; pg8::gemm_phase(F.lds, g, So, E, F.tid); }
    GRID_BAR(); STAMP(14);
    PH(12) tp_d(F); GRID_BAR(); STAMP(15);
    PH(13) moe_gather(F); GRID_BAR(); STAMP(16);
    { LAS int* mt = (LAS int*)(F.lds + LDSX_OFF + 1024); LAS int* ro = mt + 32;
      pg8::MoeOrder Mo; Mo.xl = F.bid & 7; Mo.cl = F.bid >> 3; Mo.nl = F.G >> 3;
#pragma unroll
      for (int s = 0; s < 4; ++s) { Mo.mt[s] = mt[Mo.xl + 8 * s]; Mo.tp[s] = ro[Mo.xl + 8 * s] >> 8; }
      PH(14) { Mo.ntn = 8; pg8::Gemm g{WSP(bf16, WS_A1), WSP(bf16, WS_WGU), 1024, 1024, 1024}; pg8::EpiSwiglu E{WSP(bf16, WS_ACT), F.in[33]}; pg8::gemm_phase(F.lds, g, Mo, E, F.tid); }
      GRID_BAR(); STAMP(17);
      PH(15) { Mo.ntn = 4; pg8::Gemm g{WSP(bf16, WS_ACT), WSP(bf16, WS_WD), 1024, 1024, 1024}; pg8::EpiDown E{WSP(bf16, WS_A1), F.in[35]}; pg8::gemm_phase(F.lds, g, Mo, E, F.tid); }
      GRID_BAR(); STAMP(18); }
    PH(16) moe_combine(F);
    STAMP(19);
    if (PRB_A >= 0 && blockIdx.x == 0 && F.tid == 0) {
        const unsigned long long ta = TS[PRB_A + 1] - TS[PRB_A];
        unsigned long long extra = 8ull * ta;
        if (PRB_B >= 0) { const unsigned long long tb = TS[PRB_B + 1] - TS[PRB_B]; extra += ((tb + 500ull) / 1000ull) * 200000ull; }
        const unsigned long long t0 = __builtin_amdgcn_s_memrealtime();
        while (__builtin_amdgcn_s_memrealtime() - t0 < extra) __builtin_amdgcn_s_sleep(8);
    }
}

extern "C" void kernel_launch(void* const* d_in, const int* in_sizes, int n_in, void* d_out, int out_size, void* d_ws, size_t ws_size, hipStream_t stream) {
    static int grid = 0;
    if (grid == 0) {
        if (n_in != 36 || out_size != NTOK * D || ws_size < WS_END) { fprintf(stderr, "kernel_launch: unexpected shapes (n_in %d out %d ws %zu need %zu)\n", n_in, out_size, ws_size, (size_t)WS_END); grid = -1; return; }
        int dev = 0, cus = 0;
        if (hipGetDevice(&dev) != hipSuccess || hipDeviceGetAttribute(&cus, hipDeviceAttributeMultiprocessorCount, dev) != hipSuccess) { grid = -1; return; }
        if (hipFuncSetAttribute((const void*)fwd_kernel, hipFuncAttributeMaxDynamicSharedMemorySize, LDS_BYTES) != hipSuccess) { fprintf(stderr, "kernel_launch: hipFuncSetAttribute failed\n"); grid = -1; return; }
        (void)hipGetLastError();
        grid = cus >= 256 ? 256 : (cus / 8) * 8;
    }
    if (grid <= 0) return;
    (void)hipMemsetAsync((char*)d_ws + WS_CTL, 0, CTL_BYTES, stream);
    Args a{};
    for (int i = 0; i < 36; ++i) a.in[i] = (const float*)d_in[i];
    a.out = (float*)d_out; a.ws = (unsigned char*)d_ws;
    hipLaunchKernelGGL(fwd_kernel, dim3(grid), dim3(512), LDS_BYTES, stream, a);
}
```

```cpp
#include <hip/hip_runtime.h>
#include <cstdint>
#include <cstdio>

#define GAS __attribute__((address_space(1)))
#define LAS __attribute__((address_space(3)))
typedef unsigned short bf16;
typedef short bf16x8 __attribute__((ext_vector_type(8)));
typedef short s16x4 __attribute__((ext_vector_type(4)));
typedef float f32x4 __attribute__((ext_vector_type(4)));
typedef float f32x16 __attribute__((ext_vector_type(16)));
typedef unsigned u32x4 __attribute__((ext_vector_type(4)));
typedef unsigned u32x2 __attribute__((ext_vector_type(2)));
typedef float f32x2_t __attribute__((ext_vector_type(2)));
typedef __bf16 bf16x2_t __attribute__((ext_vector_type(2)));

constexpr int NB = 2, S = 8192, D = 1024, NTOK = NB * S;
constexpr int NINP = 1792;
constexpr int C_CQ = 0, C_CKV = 256, C_KR = 384, C_QN = 416, C_KC = 928, C_VC = 1056, C_KS = 1184, C_VS = 1312, C_KW = 1440, C_VW = 1568, C_GT = 1696;
constexpr float EPS = 1e-6f;
constexpr float LOG2E = 1.4426950408889634f;
constexpr int NEXP = 32, MROWS = 65536 + 32 * 256;

constexpr size_t MiB = 1u << 20;
constexpr size_t al256(size_t x) { return (x + 255) & ~(size_t)255; }
constexpr size_t WS_CTL = 0, CTL_BYTES = 1 * MiB;
constexpr size_t WS_CONST = 1 * MiB;
constexpr size_t WS_WIN = 2 * MiB;
constexpr size_t WS_WUQ = WS_WIN + al256((size_t)NINP * 1024 * 2);
constexpr size_t WS_WUKV = WS_WUQ + al256((size_t)768 * 256 * 2);
constexpr size_t WS_WOUT = WS_WUKV + al256((size_t)1024 * 256 * 2);
constexpr size_t WS_WMQ = WS_WOUT + al256((size_t)1024 * 1024 * 2);
constexpr size_t WS_WMO = WS_WMQ + al256((size_t)256 * 1024 * 2);
constexpr size_t WS_W1T = WS_WMO + al256((size_t)1024 * 256 * 2);
constexpr size_t WS_WMKVT = WS_W1T + al256((size_t)2 * 128 * 2048 * 2);
constexpr size_t WS_MEMB = WS_WMKVT + al256((size_t)512 * 1024 * 2);
constexpr size_t WS_KVMR = WS_MEMB + al256((size_t)512 * 1024 * 2);
constexpr size_t WS_RSM = WS_KVMR + al256((size_t)512 * 512 * 2);
constexpr size_t WS_WRH = WS_RSM + 4096;
constexpr size_t WS_WRL = WS_WRH + 65536;
static_assert(WS_WRL + 65536 <= 16 * MiB, "small-weight region");
constexpr size_t WS_WGU = 16 * MiB;
constexpr size_t WS_WD = WS_WGU + 128 * MiB;
constexpr size_t WS_XB = WS_WD + 64 * MiB;
constexpr size_t WS_PB = WS_XB + 32 * MiB;
constexpr size_t WS_QRAW = WS_PB + 56 * MiB;
constexpr size_t WS_KVRAW = WS_QRAW + 24 * MiB;
constexpr size_t WS_QM = WS_KVRAW + 32 * MiB;
constexpr size_t WS_KM = WS_QM + 24 * MiB;
constexpr size_t WS_VM = WS_KM + 24 * MiB;
constexpr size_t WS_QN = WS_VM + 16 * MiB;
constexpr size_t WS_KS = WS_QN + 16 * MiB;
constexpr size_t WS_VS = WS_KS + 4 * MiB;
constexpr size_t WS_KW = WS_VS + 4 * MiB;
constexpr size_t WS_VW = WS_KW + 4 * MiB;
constexpr size_t WS_KCMP = WS_VW + 4 * MiB;
constexpr size_t WS_VCMP = WS_KCMP + 1 * MiB;
constexpr size_t WS_KMEM = WS_VCMP + 1 * MiB;
constexpr size_t WS_VMEM = WS_KMEM + 1 * MiB;
constexpr size_t WS_QBM = WS_VMEM + 1 * MiB;
constexpr size_t WS_QBN = WS_QBM + 1 * MiB;
constexpr size_t WS_RS = WS_QBN + 1 * MiB;
constexpr size_t WS_GATE = WS_RS + 1 * MiB;
constexpr size_t WS_ASG = WS_GATE + 2 * MiB;
constexpr size_t WS_Y = WS_ASG + 1 * MiB;
constexpr size_t WS_QMEM = WS_Y + 32 * MiB;
constexpr size_t WS_OMEM = WS_QMEM + 8 * MiB;
constexpr size_t WS_A1 = WS_OMEM + 8 * MiB;
constexpr size_t WS_ACT = WS_A1 + 144 * MiB;
constexpr size_t WS_END = WS_ACT + 144 * MiB;
constexpr int CW_BAR = 4096;
constexpr int CW_CNT = 16384;
constexpr int CF_CPP = 4096;
constexpr int CF_KBM = 0, CF_KBN = 1, CF_KBMEM = 2, CF_MAXB2 = 8  , CF_BIAS2 = 64  , CF_LUT = 512  , CF_CPOSK = 1024  , CF_CPOSV = 1152  ;

constexpr int RING_BYTES = 131072;
constexpr int LDS_BYTES = 147456;
constexpr int LDSX_OFF = RING_BYTES + 1024;
constexpr int LDSCTL_OFF = LDS_BYTES - 1024;

__device__ __forceinline__ float bf2f(unsigned v) { return __uint_as_float(v << 16); }
__device__ __forceinline__ unsigned cvtpk(float lo, float hi) { f32x2_t v = {lo, hi}; bf16x2_t b = __builtin_convertvector(v, bf16x2_t); return __builtin_bit_cast(unsigned, b); }
__device__ __forceinline__ unsigned lane_id_opaque() { unsigned r; asm volatile("v_mbcnt_lo_u32_b32 %0, -1, 0\n\tv_mbcnt_hi_u32_b32 %0, -1, %0" : "=v"(r)); return r; }
template <int M> __device__ __forceinline__ float shx(float v) {
    if constexpr (M < 32) { return __int_as_float(__builtin_amdgcn_ds_swizzle(__float_as_int(v), (M << 10) | 0x1f)); }
    else { auto r = __builtin_amdgcn_permlane32_swap(__float_as_uint(v), __float_as_uint(v), false, false);
           const bool lo = lane_id_opaque() < 32u; return __uint_as_float(lo ? r[1] : r[0]); }
}
template <int M> __device__ __forceinline__ int shxi(int v) { return __float_as_int(shx<M>(__int_as_float(v))); }
__device__ __forceinline__ float sum32x(float v) { auto r = __builtin_amdgcn_permlane32_swap(__float_as_uint(v), __float_as_uint(v), false, false); return __uint_as_float(r[0]) + __uint_as_float(r[1]); }
__device__ __forceinline__ float wave_sum(float v) {
    v += shx<1>(v); v += shx<2>(v); v += shx<4>(v); v += shx<8>(v); v += shx<16>(v); return sum32x(v);
}
__device__ __forceinline__ float wave_max(float v) {
    v = fmaxf(v, shx<1>(v)); v = fmaxf(v, shx<2>(v)); v = fmaxf(v, shx<4>(v)); v = fmaxf(v, shx<8>(v)); v = fmaxf(v, shx<16>(v)); return fmaxf(v, shx<32>(v));
}
__device__ __forceinline__ float grp8_sum(float v) { v += shx<1>(v); v += shx<2>(v); v += shx<4>(v); return v; }
#define LDS_WAIT() asm volatile("s_waitcnt lgkmcnt(0)" ::: "memory")
#define VM_WAIT() asm volatile("s_waitcnt vmcnt(0)" ::: "memory")

namespace pg8 {
constexpr int BM = 256, BK = 64, HALF = 128, HTB = HALF * BK * 2, STAGE_BYTES = 8 * HTB, NXCD = 8, WGM = 8;
__host__ __device__ __forceinline__ int lds_byte(int r, int c) { const int st = (r >> 4) * 2 + (c >> 5), rr = r & 15, cc = c & 31, ob = rr * 64 + cc * 2; return st * 1024 + (ob ^ (((ob >> 9) & 1) << 5)); }
__host__ __device__ __forceinline__ void stage_rc(int b, int& R, int& C) { const int st = b / 1024, sb = b % 1024, swz = sb ^ (((sb >> 9) & 1) << 5); R = (st >> 1) * 16 + swz / 64; C = (st & 1) * 32 + (swz % 64) / 2; }
__host__ __device__ __forceinline__ int perm32(int rho) { const int n = rho >> 4, i = rho & 15; return 8 * (i >> 2) + 4 * n + (i & 3); }
struct Unit { int pm, pn, aux; };
struct Gemm { const bf16* A; const bf16* Bt; int lda, ldb, K; };
struct StaticOrder {
    int nM, nN, nwg, G, c;
    __device__ void init(int M, int N, int G_, int c_) { nM = M / BM; nN = N / BM; nwg = nM * nN; G = G_; c = c_; }
    __device__ bool next(int i, Unit& u) const {
        const long L = (long)i * G + c; if (L >= nwg) return false;
        int wgid = (int)L; { const int q = nwg / NXCD, r = nwg % NXCD, xcd = wgid % NXCD, off = wgid / NXCD; wgid = (xcd < r ? xcd * (q + 1) : r * (q + 1) + (xcd - r) * q) + off; }
        const int nig = WGM * nN, gid = wgid / nig, fm = gid * WGM, gsz = (nM - fm) < WGM ? (nM - fm) : WGM;
        u.pm = fm + ((wgid % nig) % gsz); u.pn = (wgid % nig) / gsz; u.aux = 0; return true;
    }
};
struct MoeOrder {
    int ntn, xl, cl, nl; int mt[4], tp[4];
    __device__ bool next(int i, Unit& u) const {
        int L = i * nl + cl;
#pragma unroll
        for (int s = 0; s < 4; ++s) { const int nu = mt[s] * ntn; if (L < nu) { const int e = xl + 8 * s; u.pm = tp[s] + L % mt[s]; u.pn = e * ntn + L / mt[s]; u.aux = e; return true; } L -= nu; }
        return false;
    }
};
template <class Epi, class Sched>
__device__ __forceinline__ void gemm_phase(LAS unsigned char* lds, const Gemm g, const Sched& S, const Epi& E, int tid_in) {
    int tid_ = tid_in; asm volatile("" : "+v"(tid_));
    const int tid = tid_, wid = __builtin_amdgcn_readfirstlane(tid >> 6), lane = tid & 63, wr = wid >> 2, wc = wid & 3, fr = lane & 15, fq = lane >> 4;
    const int K = g.K, nt = K / BK;
    unsigned voffA[2], voffB[2];
#pragma unroll
    for (int i = 0; i < 2; ++i) { int R, C; stage_rc(tid * 16 + i * 8192, R, C); const int Rb = Epi::PERM ? ((R & ~31) + perm32(R & 31)) : R;
        voffA[i] = (unsigned)(R * g.lda + C) * 2u; voffB[i] = (unsigned)(Rb * g.ldb + C) * 2u; }
    const size_t kstep = (size_t)(BK * 2);
    const size_t hstepA = (size_t)HALF * g.lda * 2, hstepB = (size_t)HALF * g.ldb * 2;
    const size_t tstepA = 2 * hstepA, tstepB = 2 * hstepB;
    const unsigned ldsw = (unsigned)wid * 1024u;
    const int aoff = lds_byte(wr * 64 + fr, fq * 8), boff = lds_byte(wc * 32 + fr, fq * 8);
#define PG8_SA(b, h) (((b) * 2 + (h)) * HTB)
#define PG8_SB(b, h) ((4 + (b) * 2 + (h)) * HTB)
#define PG8_STAGE(bufoff, gbase, voff) do { _Pragma("unroll") for (int _i = 0; _i < 2; ++_i) \
        __builtin_amdgcn_global_load_lds((const unsigned*)((const char*)(gbase) + (voff)[_i]), (LAS unsigned*)(lds + (bufoff) + ldsw + _i * 8192), 16, 0, 0); } while (0)
#define PG8_LDA(dst, b, h) do { _Pragma("unroll") for (int m = 0; m < 4; ++m) _Pragma("unroll") for (int k = 0; k < 2; ++k) dst[m][k] = *(const LAS bf16x8*)(lds + PG8_SA(b, h) + aoff + m * 2048 + k * 1024); } while (0)
#define PG8_LDB(dst, b, h) do { _Pragma("unroll") for (int n = 0; n < 2; ++n) _Pragma("unroll") for (int k = 0; k < 2; ++k) dst[n][k] = *(const LAS bf16x8*)(lds + PG8_SB(b, h) + boff + n * 2048 + k * 1024); } while (0)
#define PG8_MMA(ai, bj, At, Bt) do { __builtin_amdgcn_s_setprio(1); _Pragma("unroll") for (int m = 0; m < 4; ++m) _Pragma("unroll") for (int n = 0; n < 2; ++n) _Pragma("unroll") for (int k = 0; k < 2; ++k) \
        acc[ai][bj][m][n] = __builtin_amdgcn_mfma_f32_16x16x32_bf16(Bt[n][k], At[m][k], acc[ai][bj][m][n], 0, 0, 0); __builtin_amdgcn_s_setprio(0); } while (0)
#define PG8_WAIT_V(n) asm volatile("s_waitcnt vmcnt(" #n ")" ::: "memory")
#define PG8_WAIT_L(n) asm volatile("s_waitcnt lgkmcnt(" #n ")" ::: "memory")
#define PG8_BAR __builtin_amdgcn_s_barrier()
#define PG8_SCHED __builtin_amdgcn_sched_barrier(0)
    Unit cur, nxt; int ui = 0;
    if (!S.next(0, cur)) return;
    f32x4 acc[2][2][4][2];
#pragma unroll
    for (int a = 0; a < 2; ++a)
#pragma unroll
        for (int b = 0; b < 2; ++b)
#pragma unroll
            for (int m = 0; m < 4; ++m)
#pragma unroll
                for (int n = 0; n < 2; ++n) acc[a][b][m][n] = (f32x4){0.f, 0.f, 0.f, 0.f};
    bf16x8 At[4][2], B0[2][2], B1[2][2];
    const char* cA = (const char*)g.A + (size_t)cur.pm * tstepA; const char* cB = (const char*)g.Bt + (size_t)cur.pn * tstepB;
    PG8_STAGE(PG8_SB(0, 0), cB, voffB); PG8_STAGE(PG8_SB(0, 1), cB + hstepB, voffB); PG8_STAGE(PG8_SA(0, 0), cA, voffA); PG8_STAGE(PG8_SA(0, 1), cA + hstepA, voffA);
    if (wr == 1) PG8_BAR;
    PG8_WAIT_V(2); PG8_BAR;
    PG8_STAGE(PG8_SB(1, 0), cB + kstep, voffB); PG8_STAGE(PG8_SA(1, 0), cA + kstep, voffA); PG8_STAGE(PG8_SB(1, 1), cB + hstepB + kstep, voffB);
    PG8_WAIT_V(6); PG8_BAR;
    for (;;) {
        const bool has_next = S.next(ui + 1, nxt);
        const char* nA = has_next ? (const char*)g.A + (size_t)nxt.pm * tstepA : cA; const char* nB = has_next ? (const char*)g.Bt + (size_t)nxt.pn * tstepB : cB;
#pragma unroll 1
        for (int t = 0; t < nt; t += 2) {
            const bool last = (t == nt - 2);
            const char* a1 = cA + (size_t)(t + 1) * kstep;
            const char* a2 = last ? nA : cA + (size_t)(t + 2) * kstep; const char* b2 = last ? nB : cB + (size_t)(t + 2) * kstep;
            const char* a3 = a2 + kstep; const char* b3 = b2 + kstep;
            PG8_LDB(B0, 0, 0); PG8_LDB(B1, 0, 1); PG8_SCHED; PG8_LDA(At, 0, 0); PG8_STAGE(PG8_SA(1, 1), a1 + hstepA, voffA);
            PG8_WAIT_V(8); PG8_WAIT_L(0); PG8_BAR; PG8_MMA(0, 0, At, B0); PG8_MMA(0, 1, At, B1); PG8_BAR; PG8_SCHED;
            PG8_LDA(At, 0, 1); PG8_STAGE(PG8_SB(0, 0), b2, voffB); PG8_STAGE(PG8_SB(0, 1), b2 + hstepB, voffB); PG8_STAGE(PG8_SA(0, 0), a2, voffA);
            PG8_WAIT_V(8); PG8_WAIT_L(0); PG8_BAR; PG8_MMA(1, 0, At, B0); PG8_MMA(1, 1, At, B1); PG8_BAR; PG8_SCHED;
            PG8_LDB(B0, 1, 0); PG8_LDB(B1, 1, 1); PG8_SCHED; PG8_LDA(At, 1, 0); PG8_STAGE(PG8_SA(0, 1), a2 + hstepA, voffA);
            PG8_WAIT_V(8); PG8_WAIT_L(0); PG8_BAR; PG8_MMA(0, 0, At, B0); PG8_MMA(0, 1, At, B1); PG8_BAR; PG8_SCHED;
            PG8_LDA(At, 1, 1); PG8_STAGE(PG8_SB(1, 0), b3, voffB); PG8_STAGE(PG8_SB(1, 1), b3 + hstepB, voffB); PG8_STAGE(PG8_SA(1, 0), a3, voffA);
            PG8_WAIT_V(8); PG8_WAIT_L(0); PG8_BAR; PG8_MMA(1, 0, At, B0); PG8_MMA(1, 1, At, B1); PG8_BAR; PG8_SCHED;
        }
        if (wr == 0) PG8_BAR;
        E(acc, cur, wr, wc, fr, fq);
        if (!has_next) break;
#pragma unroll
        for (int a = 0; a < 2; ++a)
#pragma unroll
            for (int b = 0; b < 2; ++b)
#pragma unroll
                for (int m = 0; m < 4; ++m)
#pragma unroll
                    for (int n = 0; n < 2; ++n) acc[a][b][m][n] = (f32x4){0.f, 0.f, 0.f, 0.f};
        cur = nxt; cA = nA; cB = nB; ++ui;
        if (wr == 1) PG8_BAR;
    }
    PG8_WAIT_V(0);
    PG8_BAR;
#undef PG8_SA
#undef PG8_SB
#undef PG8_STAGE
#undef PG8_LDA
#undef PG8_LDB
#undef PG8_MMA
#undef PG8_WAIT_V
#undef PG8_WAIT_L
#undef PG8_BAR
#undef PG8_SCHED
}
template <class Epi, class Sched>
__device__ __forceinline__ void gemm_phase_b(LAS unsigned char* lds, const Gemm g, const Sched& S, const Epi& E, int tid_in) {
    int tid_ = tid_in; asm volatile("" : "+v"(tid_));
    const int tid = tid_, wid = __builtin_amdgcn_readfirstlane(tid >> 6), lane = tid & 63, wr = wid >> 2, wc = wid & 3, fr = lane & 15, fq = lane >> 4;
    const int K = g.K, nt = K / BK;
    unsigned voffA[2], voffB[2];
#pragma unroll
    for (int i = 0; i < 2; ++i) { int R, C; stage_rc(tid * 16 + i * 8192, R, C); const int Rb = Epi::PERM ? ((R & ~31) + perm32(R & 31)) : R;
        voffA[i] = (unsigned)(R * g.lda + C) * 2u; voffB[i] = (unsigned)(Rb * g.ldb + C) * 2u; }
    const size_t kstep = (size_t)(BK * 2);
    const size_t hstepA = (size_t)HALF * g.lda * 2, hstepB = (size_t)HALF * g.ldb * 2;
    const size_t tstepA = 2 * hstepA, tstepB = 2 * hstepB;
    const unsigned ldsw = (unsigned)wid * 1024u;
    const int aoff = lds_byte(wr * 64 + fr, fq * 8), boff = lds_byte(wc * 32 + fr, fq * 8);
#define PG8_SA(b, h) (((b) * 2 + (h)) * HTB)
#define PG8_SB(b, h) ((4 + (b) * 2 + (h)) * HTB)
#define PG8_STAGE(bufoff, gbase, voff) do { _Pragma("unroll") for (int _i = 0; _i < 2; ++_i) \
        __builtin_amdgcn_global_load_lds((const unsigned*)((const char*)(gbase) + (voff)[_i]), (LAS unsigned*)(lds + (bufoff) + ldsw + _i * 8192), 16, 0, 0); } while (0)
#define PG8_LDA(dst, b, h) do { _Pragma("unroll") for (int m = 0; m < 4; ++m) _Pragma("unroll") for (int k = 0; k < 2; ++k) dst[m][k] = *(const LAS bf16x8*)(lds + PG8_SA(b, h) + aoff + m * 2048 + k * 1024); } while (0)
#define PG8_LDB(dst, b, h) do { _Pragma("unroll") for (int n = 0; n < 2; ++n) _Pragma("unroll") for (int k = 0; k < 2; ++k) dst[n][k] = *(const LAS bf16x8*)(lds + PG8_SB(b, h) + boff + n * 2048 + k * 1024); } while (0)
#define PG8_MMA(ai, bj, At, Bt) do { __builtin_amdgcn_s_setprio(1); _Pragma("unroll") for (int m = 0; m < 4; ++m) _Pragma("unroll") for (int n = 0; n < 2; ++n) _Pragma("unroll") for (int k = 0; k < 2; ++k) \
        acc[ai][bj][m][n] = __builtin_amdgcn_mfma_f32_16x16x32_bf16(Bt[n][k], At[m][k], acc[ai][bj][m][n], 0, 0, 0); __builtin_amdgcn_s_setprio(0); } while (0)
#define PG8_WAIT_V(n) asm volatile("s_waitcnt vmcnt(" #n ")" ::: "memory")
#define PG8_WAIT_L(n) asm volatile("s_waitcnt lgkmcnt(" #n ")" ::: "memory")
#define PG8_BAR __builtin_amdgcn_s_barrier()
#define PG8_SCHED __builtin_amdgcn_sched_barrier(0)
    Unit cur, nxt; int ui = 0; typename Epi::Pre pre = {};
    if (!S.next(0, cur)) return;
    f32x4 acc[2][2][4][2];
#pragma unroll
    for (int a = 0; a < 2; ++a)
#pragma unroll
        for (int b = 0; b < 2; ++b)
#pragma unroll
            for (int m = 0; m < 4; ++m)
#pragma unroll
                for (int n = 0; n < 2; ++n) acc[a][b][m][n] = (f32x4){0.f, 0.f, 0.f, 0.f};
    bf16x8 At[4][2], B0[2][2], B1[2][2];
    const char* cA = (const char*)g.A + (size_t)cur.pm * tstepA; const char* cB = (const char*)g.Bt + (size_t)cur.pn * tstepB;
    PG8_STAGE(PG8_SB(0, 0), cB, voffB); PG8_STAGE(PG8_SB(0, 1), cB + hstepB, voffB); PG8_STAGE(PG8_SA(0, 0), cA, voffA); PG8_STAGE(PG8_SA(0, 1), cA + hstepA, voffA);
    if (wr == 1) PG8_BAR;
    PG8_WAIT_V(2); PG8_BAR;
    PG8_STAGE(PG8_SB(1, 0), cB + kstep, voffB); PG8_STAGE(PG8_SA(1, 0), cA + kstep, voffA); PG8_STAGE(PG8_SB(1, 1), cB + hstepB + kstep, voffB);
    PG8_WAIT_V(6); PG8_BAR;
    for (;;) {
        const bool has_next = S.next(ui + 1, nxt);
        const char* nA = has_next ? (const char*)g.A + (size_t)nxt.pm * tstepA : cA; const char* nB = has_next ? (const char*)g.Bt + (size_t)nxt.pn * tstepB : cB;
#pragma unroll 1
        for (int t = 0; t < nt; t += 2) {
            const bool last = (t == nt - 2);
            const char* a1 = cA + (size_t)(t + 1) * kstep;
            const char* a2 = last ? nA : cA + (size_t)(t + 2) * kstep; const char* b2 = last ? nB : cB + (size_t)(t + 2) * kstep;
            const char* a3 = a2 + kstep; const char* b3 = b2 + kstep;
            if (last) E.pre(pre, cur, wc, fq);
            PG8_LDB(B0, 0, 0); PG8_LDB(B1, 0, 1); PG8_SCHED; PG8_LDA(At, 0, 0); PG8_STAGE(PG8_SA(1, 1), a1 + hstepA, voffA);
            PG8_WAIT_V(8); PG8_WAIT_L(0); PG8_BAR; PG8_MMA(0, 0, At, B0); PG8_MMA(0, 1, At, B1); PG8_BAR; PG8_SCHED;
            PG8_LDA(At, 0, 1); PG8_STAGE(PG8_SB(0, 0), b2, voffB); PG8_STAGE(PG8_SB(0, 1), b2 + hstepB, voffB); PG8_STAGE(PG8_SA(0, 0), a2, voffA);
            PG8_WAIT_V(8); PG8_WAIT_L(0); PG8_BAR; PG8_MMA(1, 0, At, B0); PG8_MMA(1, 1, At, B1); PG8_BAR; PG8_SCHED;
            PG8_LDB(B0, 1, 0); PG8_LDB(B1, 1, 1); PG8_SCHED; PG8_LDA(At, 1, 0); PG8_STAGE(PG8_SA(0, 1), a2 + hstepA, voffA);
            PG8_WAIT_V(8); PG8_WAIT_L(0); PG8_BAR; PG8_MMA(0, 0, At, B0); PG8_MMA(0, 1, At, B1); PG8_BAR; PG8_SCHED;
            PG8_LDA(At, 1, 1); PG8_STAGE(PG8_SB(1, 0), b3, voffB); PG8_STAGE(PG8_SB(1, 1), b3 + hstepB, voffB); PG8_STAGE(PG8_SA(1, 0), a3, voffA);
            PG8_WAIT_V(8); PG8_WAIT_L(0); PG8_BAR; PG8_MMA(1, 0, At, B0); PG8_MMA(1, 1, At, B1); PG8_BAR; PG8_SCHED;
        }
        if (wr == 0) PG8_BAR;
        E.fin(acc, cur, wr, wc, fr, fq, pre);
        if (!has_next) break;
#pragma unroll
        for (int a = 0; a < 2; ++a)
#pragma unroll
            for (int b = 0; b < 2; ++b)
#pragma unroll
                for (int m = 0; m < 4; ++m)
#pragma unroll
                    for (int n = 0; n < 2; ++n) acc[a][b][m][n] = (f32x4){0.f, 0.f, 0.f, 0.f};
        cur = nxt; cA = nA; cB = nB; ++ui;
        if (wr == 1) PG8_BAR;
    }
    PG8_WAIT_V(0);
    PG8_BAR;
#undef PG8_SA
#undef PG8_SB
#undef PG8_STAGE
#undef PG8_LDA
#undef PG8_LDB
#undef PG8_MMA
#undef PG8_WAIT_V
#undef PG8_WAIT_L
#undef PG8_BAR
#undef PG8_SCHED
}
template <class Epi, class Sched>
__device__ __forceinline__ void gemm_phase_mid(LAS unsigned char* lds, const Gemm g, const Sched& S, const Epi& E, int tid_in) {
    int tid_ = tid_in; asm volatile("" : "+v"(tid_));
    const int tid = tid_, wid = __builtin_amdgcn_readfirstlane(tid >> 6), lane = tid & 63, wr = wid >> 2, wc = wid & 3, fr = lane & 15, fq = lane >> 4;
    const int K = g.K, nt = K / BK;
    unsigned voffA[2], voffB[2];
#pragma unroll
    for (int i = 0; i < 2; ++i) { int R, C; stage_rc(tid * 16 + i * 8192, R, C); const int Rb = Epi::PERM ? ((R & ~31) + perm32(R & 31)) : R;
        voffA[i] = (unsigned)(R * g.lda + C) * 2u; voffB[i] = (unsigned)(Rb * g.ldb + C) * 2u; }
    const size_t kstep = (size_t)(BK * 2);
    const size_t hstepA = (size_t)HALF * g.lda * 2, hstepB = (size_t)HALF * g.ldb * 2;
    const size_t tstepA = 2 * hstepA, tstepB = 2 * hstepB;
    const unsigned ldsw = (unsigned)wid * 1024u;
    const int aoff = lds_byte(wr * 64 + fr, fq * 8), boff = lds_byte(wc * 32 + fr, fq * 8);
#define PG8_SA(b, h) (((b) * 2 + (h)) * HTB)
#define PG8_SB(b, h) ((4 + (b) * 2 + (h)) * HTB)
#define PG8_STAGE(bufoff, gbase, voff) do { _Pragma("unroll") for (int _i = 0; _i < 2; ++_i) \
        __builtin_amdgcn_global_load_lds((const unsigned*)((const char*)(gbase) + (voff)[_i]), (LAS unsigned*)(lds + (bufoff) + ldsw + _i * 8192), 16, 0, 0); } while (0)
#define PG8_LDA(dst, b, h) do { _Pragma("unroll") for (int m = 0; m < 4; ++m) _Pragma("unroll") for (int k = 0; k < 2; ++k) dst[m][k] = *(const LAS bf16x8*)(lds + PG8_SA(b, h) + aoff + m * 2048 + k * 1024); } while (0)
#define PG8_LDB(dst, b, h) do { _Pragma("unroll") for (int n = 0; n < 2; ++n) _Pragma("unroll") for (int k = 0; k < 2; ++k) dst[n][k] = *(const LAS bf16x8*)(lds + PG8_SB(b, h) + boff + n * 2048 + k * 1024); } while (0)
#define PG8_MMA(ai, bj, At, Bt) do { __builtin_amdgcn_s_setprio(1); _Pragma("unroll") for (int m = 0; m < 4; ++m) _Pragma("unroll") for (int n = 0; n < 2; ++n) _Pragma("unroll") for (int k = 0; k < 2; ++k) \
        acc[ai][bj][m][n] = __builtin_amdgcn_mfma_f32_16x16x32_bf16(Bt[n][k], At[m][k], acc[ai][bj][m][n], 0, 0, 0); __builtin_amdgcn_s_setprio(0); } while (0)
#define PG8_WAIT_V(n) asm volatile("s_waitcnt vmcnt(" #n ")" ::: "memory")
#define PG8_WAIT_L(n) asm volatile("s_waitcnt lgkmcnt(" #n ")" ::: "memory")
#define PG8_BAR __builtin_amdgcn_s_barrier()
#define PG8_SCHED __builtin_amdgcn_sched_barrier(0)
    Unit cur, nxt; int ui = 0;
    if (!S.next(0, cur)) return;
    f32x4 acc[2][2][4][2];
#pragma unroll
    for (int a = 0; a < 2; ++a)
#pragma unroll
        for (int b = 0; b < 2; ++b)
#pragma unroll
            for (int m = 0; m < 4; ++m)
#pragma unroll
                for (int n = 0; n < 2; ++n) acc[a][b][m][n] = (f32x4){0.f, 0.f, 0.f, 0.f};
    bf16x8 At[4][2], B0[2][2], B1[2][2];
    LAS float* midtab = (LAS float*)(lds + STAGE_BYTES + 1024);
    E.mid_table(midtab, cur, tid);
    const char* cA = (const char*)g.A + (size_t)cur.pm * tstepA; const char* cB = (const char*)g.Bt + (size_t)cur.pn * tstepB;
    PG8_STAGE(PG8_SB(0, 0), cB, voffB); PG8_STAGE(PG8_SB(0, 1), cB + hstepB, voffB); PG8_STAGE(PG8_SA(0, 0), cA, voffA); PG8_STAGE(PG8_SA(0, 1), cA + hstepA, voffA);
    if (wr == 1) PG8_BAR;
    PG8_WAIT_V(2); PG8_BAR;
    PG8_STAGE(PG8_SB(1, 0), cB + kstep, voffB); PG8_STAGE(PG8_SA(1, 0), cA + kstep, voffA); PG8_STAGE(PG8_SB(1, 1), cB + hstepB + kstep, voffB);
    PG8_WAIT_V(6); PG8_BAR;
    for (;;) {
        const bool has_next = S.next(ui + 1, nxt);
        const char* nA = has_next ? (const char*)g.A + (size_t)nxt.pm * tstepA : cA; const char* nB = has_next ? (const char*)g.Bt + (size_t)nxt.pn * tstepB : cB;
#pragma unroll 1
        for (int t = 0; t < nt; t += 2) {
            const bool last = (t == nt - 2);
            if (t == Epi::MID_T) {
#pragma unroll
                for (int a = 0; a < 2; ++a)
#pragma unroll
                    for (int mm = 0; mm < 4; ++mm) { const float sc = midtab[a * HALF + wr * 64 + mm * 16 + fr];
#pragma unroll
                        for (int b = 0; b < 2; ++b)
#pragma unroll
                            for (int n = 0; n < 2; ++n) acc[a][b][mm][n] = acc[a][b][mm][n] * sc; } }
            const char* a1 = cA + (size_t)(t + 1) * kstep;
            const char* a2 = last ? nA : cA + (size_t)(t + 2) * kstep; const char* b2 = last ? nB : cB + (size_t)(t + 2) * kstep;
            const char* a3 = a2 + kstep; const char* b3 = b2 + kstep;
            PG8_LDB(B0, 0, 0); PG8_LDB(B1, 0, 1); PG8_SCHED; PG8_LDA(At, 0, 0); PG8_STAGE(PG8_SA(1, 1), a1 + hstepA, voffA);
            PG8_WAIT_V(8); PG8_WAIT_L(0); PG8_BAR; PG8_MMA(0, 0, At, B0); PG8_MMA(0, 1, At, B1); PG8_BAR; PG8_SCHED;
            PG8_LDA(At, 0, 1); PG8_STAGE(PG8_SB(0, 0), b2, voffB); PG8_STAGE(PG8_SB(0, 1), b2 + hstepB, voffB); PG8_STAGE(PG8_SA(0, 0), a2, voffA);
            PG8_WAIT_V(8); PG8_WAIT_L(0); PG8_BAR; PG8_MMA(1, 0, At, B0); PG8_MMA(1, 1, At, B1); PG8_BAR; PG8_SCHED;
            PG8_LDB(B0, 1, 0); PG8_LDB(B1, 1, 1); PG8_SCHED; PG8_LDA(At, 1, 0); PG8_STAGE(PG8_SA(0, 1), a2 + hstepA, voffA);
            PG8_WAIT_V(8); PG8_WAIT_L(0); PG8_BAR; PG8_MMA(0, 0, At, B0); PG8_MMA(0, 1, At, B1); PG8_BAR; PG8_SCHED;
            PG8_LDA(At, 1, 1); PG8_STAGE(PG8_SB(1, 0), b3, voffB); PG8_STAGE(PG8_SB(1, 1), b3 + hstepB, voffB); PG8_STAGE(PG8_SA(1, 0), a3, voffA);
            PG8_WAIT_V(8); PG8_WAIT_L(0); PG8_BAR; PG8_MMA(1, 0, At, B0); PG8_MMA(1, 1, At, B1); PG8_BAR; PG8_SCHED;
        }
        if (wr == 0) PG8_BAR;
        E(acc, cur, wr, wc, fr, fq);
        if (!has_next) break;
#pragma unroll
        for (int a = 0; a < 2; ++a)
#pragma unroll
            for (int b = 0; b < 2; ++b)
#pragma unroll
                for (int m = 0; m < 4; ++m)
#pragma unroll
                    for (int n = 0; n < 2; ++n) acc[a][b][m][n] = (f32x4){0.f, 0.f, 0.f, 0.f};
        E.mid_table(midtab, nxt, tid);
        cur = nxt; cA = nA; cB = nB; ++ui;
        if (wr == 1) PG8_BAR;
    }
    PG8_WAIT_V(0);
    PG8_BAR;
#undef PG8_SA
#undef PG8_SB
#undef PG8_STAGE
#undef PG8_LDA
#undef PG8_LDB
#undef PG8_MMA
#undef PG8_WAIT_V
#undef PG8_WAIT_L
#undef PG8_BAR
#undef PG8_SCHED
}
struct EpiScaleBf16 {
    static constexpr bool PERM = true;
    bf16* O; int ldc; const float* rs; int rs_stride;
    __device__ __forceinline__ void operator()(const f32x4 (&acc)[2][2][4][2], const Unit& u, int wr, int wc, int fr, int fq) const {
        const int row0 = u.pm * BM + wr * 64 + fr, col0 = u.pn * BM + wc * 32 + 8 * fq;
#pragma unroll
        for (int ai = 0; ai < 2; ++ai)
#pragma unroll
            for (int m = 0; m < 4; ++m) { const int row = row0 + ai * HALF + m * 16; const float sc = rs ? rs[(size_t)row * rs_stride] : 1.0f; bf16* rowp = O + (size_t)row * ldc + col0;
#pragma unroll
                for (int bj = 0; bj < 2; ++bj) { const f32x4 v0 = acc[ai][bj][m][0] * sc, v1 = acc[ai][bj][m][1] * sc;
                    u32x4 w; w.x = cvtpk(v0[0], v0[1]); w.y = cvtpk(v0[2], v0[3]); w.z = cvtpk(v1[0], v1[1]); w.w = cvtpk(v1[2], v1[3]);
                    *(u32x4*)(rowp + bj * HALF) = w; } }
    }
};
struct EpiResF32 {
    static constexpr bool PERM = false;
    const float* base; float* out; int ldc;
    __device__ __forceinline__ void operator()(const f32x4 (&acc)[2][2][4][2], const Unit& u, int wr, int wc, int fr, int fq) const {
        const int row0 = u.pm * BM + wr * 64 + fr, col0 = u.pn * BM + wc * 32 + 4 * fq;
#pragma unroll
        for (int ai = 0; ai < 2; ++ai)
#pragma unroll
            for (int m = 0; m < 4; ++m) { const size_t off = (size_t)(row0 + ai * HALF + m * 16) * ldc + col0;
#pragma unroll
                for (int bj = 0; bj < 2; ++bj)
#pragma unroll
                    for (int n = 0; n < 2; ++n) { const f32x4 bs = *(const f32x4*)(base + off + bj * HALF + n * 16); *(f32x4*)(out + off + bj * HALF + n * 16) = bs + acc[ai][bj][m][n]; } }
    }
};
struct EpiResF32Bf16 {
    static constexpr bool PERM = false;
    const float* base; float* out; bf16* xb; float* ssq; int ldc;
    __device__ __forceinline__ void operator()(const f32x4 (&acc)[2][2][4][2], const Unit& u, int wr, int wc, int fr, int fq) const {
        const int row0 = u.pm * BM + wr * 64 + fr, col0 = u.pn * BM + wc * 32 + 4 * fq;
#pragma unroll
        for (int ai = 0; ai < 2; ++ai)
#pragma unroll
            for (int m = 0; m < 4; ++m) { const int row = row0 + ai * HALF + m * 16; const size_t off = (size_t)row * ldc + col0; float ss = 0.f;
#pragma unroll
                for (int bj = 0; bj < 2; ++bj)
#pragma unroll
                    for (int n = 0; n < 2; ++n) { const f32x4 v = *(const f32x4*)(base + off + bj * HALF + n * 16) + acc[ai][bj][m][n];
                        ss += (v[0] * v[0] + v[1] * v[1]) + (v[2] * v[2] + v[3] * v[3]);
                        u32x2 w; w.x = cvtpk(v[0], v[1]); w.y = cvtpk(v[2], v[3]); *(u32x2*)(xb + off + bj * HALF + n * 16) = w; }
                ss += shx<16>(ss); ss = sum32x(ss);
                if (fq == 0) ssq[(size_t)row * 16 + u.pn * 4 + wc] = ss; }
    }
};
struct EpiAddBf16 {
    static constexpr bool PERM = true;
    bf16* xb; int ldc;
    __device__ __forceinline__ void operator()(const f32x4 (&acc)[2][2][4][2], const Unit& u, int wr, int wc, int fr, int fq) const {
        const int row0 = u.pm * BM + wr * 64 + fr, col0 = u.pn * BM + wc * 32 + 8 * fq;
#pragma unroll
        for (int ai = 0; ai < 2; ++ai)
#pragma unroll
            for (int m = 0; m < 4; ++m) { bf16* rowp = xb + (size_t)(row0 + ai * HALF + m * 16) * ldc + col0;
#pragma unroll
                for (int bj = 0; bj < 2; ++bj) { const u32x4 o = *(const u32x4*)(rowp + bj * HALF); const f32x4 a0 = acc[ai][bj][m][0], a1 = acc[ai][bj][m][1];
                    u32x4 w; w.x = cvtpk(__uint_as_float(o.x << 16) + a0[0], __uint_as_float(o.x & 0xffff0000u) + a0[1]); w.y = cvtpk(__uint_as_float(o.y << 16) + a0[2], __uint_as_float(o.y & 0xffff0000u) + a0[3]);
                    w.z = cvtpk(__uint_as_float(o.z << 16) + a1[0], __uint_as_float(o.z & 0xffff0000u) + a1[1]); w.w = cvtpk(__uint_as_float(o.w << 16) + a1[2], __uint_as_float(o.w & 0xffff0000u) + a1[3]);
                    *(u32x4*)(rowp + bj * HALF) = w; } }
    }
};
struct EpiAddBf16Ssq {
    static constexpr bool PERM = true;
    bf16* xb; int ldc; float* ssq;
    __device__ __forceinline__ void operator()(const f32x4 (&acc)[2][2][4][2], const Unit& u, int wr, int wc, int fr, int fq) const {
        const int row0 = u.pm * BM + wr * 64 + fr, col0 = u.pn * BM + wc * 32 + 8 * fq;
#pragma unroll
        for (int ai = 0; ai < 2; ++ai)
#pragma unroll
            for (int m = 0; m < 4; ++m) { const int row = row0 + ai * HALF + m * 16; bf16* rowp = xb + (size_t)row * ldc + col0; float ss = 0.f;
#pragma unroll
                for (int bj = 0; bj < 2; ++bj) { const u32x4 o = *(const u32x4*)(rowp + bj * HALF); const f32x4 a0 = acc[ai][bj][m][0], a1 = acc[ai][bj][m][1];
                    const float v0 = __uint_as_float(o.x << 16) + a0[0], v1 = __uint_as_float(o.x & 0xffff0000u) + a0[1], v2 = __uint_as_float(o.y << 16) + a0[2], v3 = __uint_as_float(o.y & 0xffff0000u) + a0[3];
                    const float v4 = __uint_as_float(o.z << 16) + a1[0], v5 = __uint_as_float(o.z & 0xffff0000u) + a1[1], v6 = __uint_as_float(o.w << 16) + a1[2], v7 = __uint_as_float(o.w & 0xffff0000u) + a1[3];
                    ss += ((v0 * v0 + v1 * v1) + (v2 * v2 + v3 * v3)) + ((v4 * v4 + v5 * v5) + (v6 * v6 + v7 * v7));
                    u32x4 w; w.x = cvtpk(v0, v1); w.y = cvtpk(v2, v3); w.z = cvtpk(v4, v5); w.w = cvtpk(v6, v7);
                    *(u32x4*)(rowp + bj * HALF) = w; }
                ss += shx<16>(ss); ss = sum32x(ss);
                if (fq == 0) ssq[(size_t)row * 16 + u.pn * 4 + wc] = ss; }
    }
};
struct EpiOutProj {
    static constexpr bool PERM = true; static constexpr int MID_T = 8;
    bf16* xb; int ldc; float* ssq; const float* ssy; LAS float* tab;
    __device__ __forceinline__ void mid_table(LAS float* tab_, const Unit& u, int tid) const {
        if (tid < 256) { const f32x4* sp = (const f32x4*)(ssy + (size_t)(u.pm * BM + tid) * 16); const f32x4 a = sp[0], b = sp[1], c = sp[2], d = sp[3];
            const float vm = (((a[0] + a[1]) + (a[2] + a[3])) + ((b[0] + b[1]) + (b[2] + b[3]))) * (1.0f / 512) + EPS, vn = (((c[0] + c[1]) + (c[2] + c[3])) + ((d[0] + d[1]) + (d[2] + d[3]))) * (1.0f / 512) + EPS;
            tab_[tid] = __builtin_amdgcn_sqrtf(vn * __builtin_amdgcn_rcpf(vm)); tab_[256 + tid] = 1.0f / sqrtf(vn); }
        asm volatile("s_waitcnt vmcnt(0) lgkmcnt(0)" ::: "memory"); }
    __device__ __forceinline__ void operator()(const f32x4 (&acc)[2][2][4][2], const Unit& u, int wr, int wc, int fr, int fq) const {
        int rl0 = wr * 64 + fr, col0 = u.pn * BM + wc * 32 + 8 * fq;
        asm volatile("" : "+v"(rl0), "+v"(col0));
        bf16* base = xb + (size_t)(u.pm * BM + rl0) * ldc + col0;
        u32x4 on[2];
#pragma unroll
        for (int bj = 0; bj < 2; ++bj) on[bj] = *(const u32x4*)(base + bj * HALF);
#pragma unroll
        for (int i = 0; i < 8; ++i) { const int ai = i >> 2, m = i & 3, rl = rl0 + ai * HALF + m * 16; bf16* rowp = base + (size_t)(ai * HALF + m * 16) * ldc; float ss = 0.f;
            const float rn = tab[256 + rl]; u32x4 oc[2] = {on[0], on[1]};
            if (i < 7) { const int a2 = (i + 1) >> 2, m2 = (i + 1) & 3;
#pragma unroll
                for (int bj = 0; bj < 2; ++bj) on[bj] = *(const u32x4*)(base + (size_t)(a2 * HALF + m2 * 16) * ldc + bj * HALF); }
#pragma unroll
            for (int bj = 0; bj < 2; ++bj) { const u32x4 o = oc[bj]; const f32x4 a0 = acc[ai][bj][m][0] * rn, a1 = acc[ai][bj][m][1] * rn;
                const float v0 = __uint_as_float(o.x << 16) + a0[0], v1 = __uint_as_float(o.x & 0xffff0000u) + a0[1], v2 = __uint_as_float(o.y << 16) + a0[2], v3 = __uint_as_float(o.y & 0xffff0000u) + a0[3];
                const float v4 = __uint_as_float(o.z << 16) + a1[0], v5 = __uint_as_float(o.z & 0xffff0000u) + a1[1], v6 = __uint_as_float(o.w << 16) + a1[2], v7 = __uint_as_float(o.w & 0xffff0000u) + a1[3];
                ss += ((v0 * v0 + v1 * v1) + (v2 * v2 + v3 * v3)) + ((v4 * v4 + v5 * v5) + (v6 * v6 + v7 * v7));
                u32x4 w; w.x = cvtpk(v0, v1); w.y = cvtpk(v2, v3); w.z = cvtpk(v4, v5); w.w = cvtpk(v6, v7);
                *(u32x4*)(rowp + bj * HALF) = w; }
            ss += shx<16>(ss); ss = sum32x(ss);
            if (fq == 0) ssq[(size_t)(u.pm * BM + rl) * 16 + u.pn * 4 + wc] = ss; }
    }
};
struct EpiSsqScaleBf16 {
    static constexpr bool PERM = true;
    bf16* O; int ldc; const float* ssq;
    __device__ __forceinline__ void operator()(const f32x4 (&acc)[2][2][4][2], const Unit& u, int wr, int wc, int fr, int fq) const {
        const int row0 = u.pm * BM + wr * 64 + fr, col0 = u.pn * BM + wc * 32 + 8 * fq;
#pragma unroll
        for (int ai = 0; ai < 2; ++ai)
#pragma unroll
            for (int m = 0; m < 4; ++m) { const int row = row0 + ai * HALF + m * 16; const f32x4* sp = (const f32x4*)(ssq + (size_t)row * 16);
                const f32x4 s0 = sp[0], s1 = sp[1], s2 = sp[2], s3 = sp[3];
                const float tot = ((s0[0] + s0[1]) + (s0[2] + s0[3])) + ((s1[0] + s1[1]) + (s1[2] + s1[3])) + ((s2[0] + s2[1]) + (s2[2] + s2[3])) + ((s3[0] + s3[1]) + (s3[2] + s3[3]));
                const float sc = 1.0f / sqrtf(tot * (1.0f / 1024) + EPS); bf16* rowp = O + (size_t)row * ldc + col0;
#pragma unroll
                for (int bj = 0; bj < 2; ++bj) { const f32x4 v0 = acc[ai][bj][m][0] * sc, v1 = acc[ai][bj][m][1] * sc;
                    u32x4 w; w.x = cvtpk(v0[0], v0[1]); w.y = cvtpk(v0[2], v0[3]); w.z = cvtpk(v1[0], v1[1]); w.w = cvtpk(v1[2], v1[3]);
                    *(u32x4*)(rowp + bj * HALF) = w; } }
    }
};
struct EpiSwiglu {
    static constexpr bool PERM = true;
    bf16* act; const float* bgu;
    struct Pre { f32x4 b[2][2]; };
    __device__ __forceinline__ void pre(Pre& p, const Unit& u, int wc, int fq) const { const int e = u.aux, c0 = (u.pn - e * 8) * BM + wc * 32 + 8 * fq;
#pragma unroll
        for (int bj = 0; bj < 2; ++bj) { p.b[bj][0] = *(const f32x4*)(bgu + (size_t)e * 2048 + c0 + bj * HALF); p.b[bj][1] = *(const f32x4*)(bgu + (size_t)e * 2048 + c0 + bj * HALF + 4); } }
    __device__ __forceinline__ void fin(const f32x4 (&acc)[2][2][4][2], const Unit& u, int wr, int wc, int fr, int fq, const Pre& p) const {
        const int e = u.aux, pnl = u.pn - e * 8;
        const int row0 = u.pm * BM + wr * 64 + fr, c0 = pnl * BM + wc * 32 + 8 * fq;
#pragma unroll
        for (int bj = 0; bj < 2; ++bj) { const f32x4 b0 = p.b[bj][0], b1 = p.b[bj][1];
#pragma unroll
            for (int ai = 0; ai < 2; ++ai) { u32x2 w[4];
#pragma unroll
                for (int m = 0; m < 4; ++m) { const f32x4 v0 = acc[ai][bj][m][0] + b0, v1 = acc[ai][bj][m][1] + b1; float o[4];
#pragma unroll
                    for (int j = 0; j < 4; ++j) { float gt = j < 2 ? v0[2 * j] : v1[2 * j - 4], up = j < 2 ? v0[2 * j + 1] : v1[2 * j - 3];
                        gt = fminf(gt, 7.0f); up = fminf(fmaxf(up, -7.0f), 7.0f);
                        const float sg = __builtin_amdgcn_rcpf(1.0f + __builtin_amdgcn_exp2f(-1.702f * LOG2E * gt));
                        o[j] = (up + 1.0f) * gt * sg; }
                    w[m].x = cvtpk(o[0], o[1]); w[m].y = cvtpk(o[2], o[3]); }
                const bool odd = (fq & 1) != 0;
#pragma unroll
                for (int mp = 0; mp < 4; mp += 2) { const u32x2 snd = odd ? w[mp] : w[mp + 1]; u32x2 rcv; rcv.x = (unsigned)shxi<16>((int)snd.x); rcv.y = (unsigned)shxi<16>((int)snd.y);
                    u32x4 st; st.x = odd ? rcv.x : w[mp].x; st.y = odd ? rcv.y : w[mp].y; st.z = odd ? w[mp + 1].x : rcv.x; st.w = odd ? w[mp + 1].y : rcv.y;
                    const int row = row0 + ai * HALF + (mp + (odd ? 1 : 0)) * 16;
                    *(u32x4*)(act + (size_t)row * 1024 + ((c0 + bj * HALF) >> 1) - (odd ? 4 : 0)) = st; } } }
    }
};
struct EpiDown {
    static constexpr bool PERM = true;
    bf16* Y; const float* bd;
    struct Pre { f32x4 b[2][2]; };
    __device__ __forceinline__ void pre(Pre& p, const Unit& u, int wc, int fq) const { const int e = u.aux, c0 = (u.pn - e * 4) * BM + wc * 32 + 8 * fq;
#pragma unroll
        for (int bj = 0; bj < 2; ++bj) { p.b[bj][0] = *(const f32x4*)(bd + (size_t)e * 1024 + c0 + bj * HALF); p.b[bj][1] = *(const f32x4*)(bd + (size_t)e * 1024 + c0 + bj * HALF + 4); } }
    __device__ __forceinline__ void fin(const f32x4 (&acc)[2][2][4][2], const Unit& u, int wr, int wc, int fr, int fq, const Pre& p) const {
        const int e = u.aux, pnl = u.pn - e * 4;
        const int row0 = u.pm * BM + wr * 64 + fr, c0 = pnl * BM + wc * 32 + 8 * fq;
#pragma unroll
        for (int bj = 0; bj < 2; ++bj) { const f32x4 b0 = p.b[bj][0], b1 = p.b[bj][1];
#pragma unroll
            for (int ai = 0; ai < 2; ++ai)
#pragma unroll
                for (int m = 0; m < 4; ++m) { const int row = row0 + ai * HALF + m * 16; const f32x4 v0 = acc[ai][bj][m][0] + b0, v1 = acc[ai][bj][m][1] + b1;
                    u32x4 w; w.x = cvtpk(v0[0], v0[1]); w.y = cvtpk(v0[2], v0[3]); w.z = cvtpk(v1[0], v1[1]); w.w = cvtpk(v1[2], v1[3]);
                    *(u32x4*)(Y + (size_t)row * 1024 + c0 + bj * HALF) = w; } }
    }
};
}

#define XB_TMO      128
#define XB_XCNT(j)  (256  + 64 * (j))
#define XB_XSUB(j)  (1280 + 64 * (j))
#define XB_XGEN(j)  (2304 + 64 * (j))
#define XB_TOP      3328
#define XB_TOPGEN   3392
#define XCD_BAR_WORDS 3456
#define XB_SPIN_CAP (1u << 18)
__device__ __forceinline__ unsigned xb_ld(unsigned* p)              { return __hip_atomic_load(p, __ATOMIC_RELAXED, __HIP_MEMORY_SCOPE_AGENT); }
__device__ __forceinline__ unsigned xb_add(unsigned* p, unsigned v) { return __hip_atomic_fetch_add(p, v, __ATOMIC_RELAXED, __HIP_MEMORY_SCOPE_AGENT); }
__device__ __forceinline__ unsigned xb_xcc_id() { return (unsigned)__builtin_amdgcn_s_getreg((3 << 11) | 20) & 0xFu; }
#define XB_SPIN(cond, bar) do { unsigned _sp = 0; while (cond) { __builtin_amdgcn_s_sleep(1); \
    if ((++_sp & 255u) == 0u) { if (xb_ld(&(bar)[XB_TMO])) break; if (_sp > XB_SPIN_CAP) { atomicAdd(&(bar)[XB_TMO], 1u); break; } } } } while (0)
struct XcdBarrier { unsigned* bar; unsigned x; volatile LAS unsigned* st; };
__device__ __forceinline__ XcdBarrier xcd_barrier_post(unsigned* bar, volatile LAS unsigned* st) {
    XcdBarrier b; b.bar = bar; b.x = xb_xcc_id(); b.st = st;
    if (threadIdx.x == 0) (void)xb_add(&bar[XB_XCNT(b.x)], 1u);
    return b;
}
__device__ __forceinline__ void xcd_barrier_complete(unsigned* bar, unsigned x, unsigned& nloc, unsigned& nx) {
    const unsigned G = gridDim.x * gridDim.y * gridDim.z;
    unsigned sum, cnt, mine, sp = 0u;
    for (;;) {
        sum = 0u; cnt = 0u; mine = 0u;
#pragma unroll
        for (unsigned j = 0; j < 16; ++j) { const unsigned c = xb_ld(&bar[XB_XCNT(j)]); sum += c; cnt += (c > 0u) ? 1u : 0u; mine = (j == x) ? c : mine; }
        if (sum == G) break;
        __builtin_amdgcn_s_sleep(1);
        if ((++sp & 255u) == 0u) { if (xb_ld(&bar[XB_TMO])) break; if (sp > XB_SPIN_CAP) { atomicAdd(&bar[XB_TMO], 1u); break; } }
    }
    nloc = mine > 0u ? mine : 1u; nx = cnt > 0u ? cnt : 1u;
}
__device__ __forceinline__ void xcd_barrier(const XcdBarrier& b, bool leader) {
    asm volatile("s_waitcnt vmcnt(0)" ::: "memory");
    __syncthreads();
    if (leader) {
        unsigned* bar = b.bar;
        __builtin_amdgcn_s_waitcnt(0);
        unsigned nloc = b.st[0], nx = b.st[1];
        if (nloc == 0u) { xcd_barrier_complete(bar, b.x, nloc, nx); b.st[0] = nloc; b.st[1] = nx; }
        const unsigned old = xb_add(&bar[XB_XSUB(b.x)], 1u);
        const unsigned gen = old / nloc;
        if (old + 1u == (gen + 1u) * nloc) {
            __builtin_amdgcn_fence(__ATOMIC_RELEASE, "agent");
            asm volatile("s_waitcnt vmcnt(0)" ::: "memory");
            const unsigned og = xb_add(&bar[XB_TOP], 1u);
            const unsigned tg = og / nx;
            if (og + 1u == (tg + 1u) * nx) xb_add(&bar[XB_TOPGEN], 1u);
            else XB_SPIN(xb_ld(&bar[XB_TOPGEN]) == tg, bar);
            __builtin_amdgcn_fence(__ATOMIC_ACQUIRE, "agent");
            xb_add(&bar[XB_XGEN(b.x)], 1u);
            asm volatile("s_waitcnt vmcnt(0)" ::: "memory");
        } else {
            XB_SPIN(xb_ld(&bar[XB_XGEN(b.x)]) == gen, bar);
            __builtin_amdgcn_fence(__ATOMIC_ACQUIRE, "agent");
            asm volatile("s_waitcnt vmcnt(0)" ::: "memory");
        }
    }
    __syncthreads();
}

struct Args { const float* in[36]; float* out; unsigned char* ws; };
struct Frame {
    LAS unsigned char* lds; int tid, lane, wave, G, bid, gw, ngw;
    const float* const* in; float* out; unsigned char* ws;
};
#ifndef PRB_BLK
#define PRB_BLK 0
#endif
#ifndef PRB_E
#define PRB_E (PRB_A + 1)
#endif
#ifndef PRB_A
#define PRB_A -1
#endif
#ifndef PRB_B
#define PRB_B -1
#endif
#define FSTAMP(F, k) do { if (PRB_A >= 0 && (F).bid == PRB_BLK && (F).tid == 0) ((volatile LAS unsigned long long*)((F).lds + LDSCTL_OFF + 128))[k] = __builtin_amdgcn_s_memrealtime(); } while (0)
#define WSP(T, off) ((T*)(F.ws + (off)))

struct TrItem { const float* wp; const float* gp; bf16* dst; int ldw, ldd; float msk; int fragS, n0, k0; };
__device__ __forceinline__ void tr_decode(Frame& F, int it, TrItem& d) {
    const float* const* in = F.in; const float* nog = nullptr;
    constexpr int I0 = 16 * 28, I1 = 4 * 12, I2 = 2 * 16, I3 = 16 * 16, I4 = 16 * 4, I5 = 4 * 16, I6 = 32 * 16 * 32, I7 = 32 * 16 * 16;
    int r = it; const float* W; int ldw, kvalid, nvalid, gsplit = 1 << 30, ldd, kb, nb, fragS = 0; const float* g1 = nog; const float* g2 = nog; bf16* WT;
    if (r < I0) { kb = r / 28; nb = r % 28; W = in[3]; ldw = 1720; kvalid = 1024; nvalid = 1720; g1 = in[2]; g2 = in[2]; WT = WSP(bf16, WS_WIN); ldd = 1024; }
    else if ((r -= I0) < I1) { kb = r / 12; nb = r % 12; W = in[5]; ldw = 768; kvalid = 256; nvalid = 768; g1 = in[4]; g2 = in[4]; WT = WSP(bf16, WS_WUQ); ldd = 256; fragS = 16; }
    else if ((r -= I1) < I2) { kb = r / 16; nb = r % 16; W = in[7]; ldw = 1024; kvalid = 128; nvalid = 1024; g1 = in[6]; g2 = in[6]; WT = WSP(bf16, WS_WUKV); ldd = 128; fragS = 8; }
    else if ((r -= I2) < I3) { kb = r / 16; nb = r % 16; W = in[21]; ldw = 1024; kvalid = 1024; nvalid = 1024; g1 = in[19]; g2 = in[20]; gsplit = 512; WT = WSP(bf16, WS_WOUT); ldd = 1024; }
    else if ((r -= I3) < I4) { kb = r / 4; nb = r % 4; W = in[24]; ldw = 256; kvalid = 1024; nvalid = 256; g1 = in[22]; g2 = in[22]; WT = WSP(bf16, WS_WMQ); ldd = 1024; fragS = 64; }
    else if ((r -= I4) < I5) { kb = r / 16; nb = r % 16; W = in[28]; ldw = 1024; kvalid = 256; nvalid = 1024; WT = WSP(bf16, WS_WMO); ldd = 256; fragS = 16; }
    else if ((r -= I5) < 128) { const int kv = r / 64, q = r % 64; kb = q / 2; nb = q % 2; W = in[kv ? 14 : 11]; ldw = 128; kvalid = 2048; nvalid = 128; WT = WSP(bf16, WS_W1T) + (size_t)kv * 128 * 2048; ldd = 2048; fragS = -1; }
    else if ((r -= 128) < 128) { kb = r / 8; nb = r % 8; W = in[25]; ldw = 512; kvalid = 1024; nvalid = 512; g1 = in[23]; g2 = in[23]; WT = WSP(bf16, WS_WMKVT); ldd = 1024; }
    else if ((r -= 128) < I6) { const int e = r / 512, q = r % 512; kb = q / 32; nb = q % 32; W = in[32] + (size_t)e * 1024 * 2048; ldw = 2048; kvalid = 1024; nvalid = 2048; g1 = in[29]; g2 = in[29]; WT = WSP(bf16, WS_WGU) + (size_t)e * 2048 * 1024; ldd = 1024; }
    else { r -= I6; const int e = r / 256, q = r % 256; kb = q / 16; nb = q % 16; W = in[34] + (size_t)e * 1024 * 1024; ldw = 1024; kvalid = 1024; nvalid = 1024; WT = WSP(bf16, WS_WD) + (size_t)e * 1024 * 1024; ldd = 1024; }
    const int k0 = 64 * kb, n0 = 64 * nb, cg = F.lane & 15, rp = F.lane >> 4, nc = n0 + 4 * cg;
    const bool ok = (nc < nvalid) && (k0 < kvalid);
    d.gp = g1 ? ((k0 < gsplit ? g1 + k0 : g2 + (k0 - gsplit)) + 2 * rp) : nullptr;
    d.wp = W + (ok ? (size_t)(k0 + 2 * rp) * ldw + nc : (size_t)0);
    d.msk = ok ? 1.0f : 0.0f; d.ldw = ldw; d.ldd = ldd; d.fragS = fragS; d.n0 = n0; d.k0 = k0; d.dst = fragS ? WT : WT + (size_t)n0 * ldd + k0;
}
__device__ __forceinline__ void tr_load(const TrItem& d, f32x4 (&a)[8], f32x4 (&b)[8], f32x2_t (&gn)[8]) {
#pragma unroll
    for (int j = 0; j < 8; ++j) { a[j] = __builtin_nontemporal_load((const f32x4*)(d.wp + (size_t)(8 * j) * d.ldw)); b[j] = __builtin_nontemporal_load((const f32x4*)(d.wp + (size_t)(8 * j + 1) * d.ldw)); }
    if (d.gp) {
#pragma unroll
        for (int j = 0; j < 8; ++j) gn[j] = *(const f32x2_t*)(d.gp + 8 * j); }
    else {
#pragma unroll
        for (int j = 0; j < 8; ++j) gn[j] = (f32x2_t){1.0f, 1.0f}; }
}
__device__ __forceinline__ void tr_finish(const TrItem& d, f32x4 (&a)[8], f32x4 (&b)[8], const f32x2_t (&gn)[8], LAS unsigned* scr, int lane) {
    const int cg = lane & 15, rp = lane >> 4;
#pragma unroll
    for (int j = 0; j < 8; ++j) {
        const float ga = d.msk * gn[j].x, gb = d.msk * gn[j].y;
        a[j] = a[j] * ga; b[j] = b[j] * gb;
        LAS unsigned* q = scr + (4 * cg) * 36 + 4 * j + rp;
        q[0] = cvtpk(a[j].x, b[j].x); q[36] = cvtpk(a[j].y, b[j].y); q[72] = cvtpk(a[j].z, b[j].z); q[108] = cvtpk(a[j].w, b[j].w); }
    LDS_WAIT(); asm volatile("" ::: "memory");
#pragma unroll
    for (int i = 0; i < 8; ++i) { const int n = 8 * i + (lane >> 3), c = lane & 7;
        const u32x4 v = *(const LAS u32x4*)(scr + n * 36 + 4 * c);
        if (d.fragS < 0) {
            const int ng = d.n0 + n, kg = d.k0 + 8 * c; *(u32x4*)(d.dst + ((size_t)((kg >> 5) * 8 + (ng >> 4)) * 64 + (ng & 15) + 16 * ((kg >> 3) & 3)) * 8) = v;
        } else if (d.fragS) {
            const int ng = d.n0 + n, kg = d.k0 + 8 * c; *(u32x4*)(d.dst + ((size_t)((ng >> 5) * d.fragS + (kg >> 4)) * 64 + (ng & 31) + 32 * ((kg >> 3) & 1)) * 8) = v;
        } else __builtin_nontemporal_store(v, (u32x4*)(d.dst + (size_t)n * d.ldd + 8 * c)); }
    LDS_WAIT(); asm volatile("" ::: "memory");
}

constexpr int TR_NSMALL = 16 * 28 + 4 * 12 + 2 * 16 + 16 * 16 + 16 * 4 + 4 * 16 + 2 * 32 * 2 + 16 * 8;
constexpr int TR_NITEMS = TR_NSMALL + 32 * 16 * 32 + 32 * 16 * 16;
__device__ __forceinline__ void tr_run(Frame& F, int first, int end, int stride) {
    LAS unsigned* scr = (LAS unsigned*)(F.lds + F.wave * 16384);
    TrItem d0, d1; f32x4 a0[8], b0[8], a1[8], b1[8]; f32x2_t g0[8], g1[8];
    int it = first; if (it < end) { tr_decode(F, it, d0); tr_load(d0, a0, b0, g0); }
#pragma unroll 1
    while (it < end) {
        const int it1 = it + stride; if (it1 < end) { tr_decode(F, it1, d1); tr_load(d1, a1, b1, g1); }
        tr_finish(d0, a0, b0, g0, scr, F.lane);
        if (it1 >= end) break;
        const int it2 = it1 + stride; if (it2 < end) { tr_decode(F, it2, d0); tr_load(d0, a0, b0, g0); }
        tr_finish(d1, a1, b1, g1, scr, F.lane);
        it = it2;
    }
}
constexpr int TR_POOL0 = TR_NSMALL + 32 * 16 * 32, TR_CHUNK = 8, CW_POOL = 30000;
__device__ __forceinline__ void moe_convert(Frame& F) { __syncthreads(); tr_run(F, TR_NSMALL + F.gw, TR_POOL0, F.ngw); __syncthreads(); }
__device__ __forceinline__ void moe_pool(Frame& F) {
    volatile LAS int* slot = (volatile LAS int*)(F.lds + LDSX_OFF + 2048);
    unsigned* ctr = (unsigned*)(F.ws + WS_CTL) + CW_POOL;
    for (;;) {
        __syncthreads();
        if (F.tid == 0) *slot = (int)__hip_atomic_fetch_add(ctr, 1u, __ATOMIC_RELAXED, __HIP_MEMORY_SCOPE_AGENT);
        __syncthreads();
        const int begin = TR_POOL0 + __builtin_amdgcn_readfirstlane(*slot) * TR_CHUNK;
        if (begin >= TR_NITEMS) break;
        tr_run(F, begin + F.wave, begin + TR_CHUNK < TR_NITEMS ? begin + TR_CHUNK : TR_NITEMS, 8);
    }
    __syncthreads();
}

__device__ __forceinline__ void p0_prologue(Frame& F) {
    const float* const* in = F.in;
    tr_run(F, (F.G - 1 - F.bid) * 8 + F.wave, TR_NSMALL, F.ngw);
    FSTAMP(F, 32);
    { float* RS = WSP(float, WS_RS); bf16* XB = WSP(bf16, WS_XB);
      for (int m0 = F.gw; m0 < NTOK; m0 += 4 * F.ngw) {
        f32x4 v[4][4];
#pragma unroll
        for (int q = 0; q < 4; ++q) { const int m = m0 + q * F.ngw; const f32x4* xr = (const f32x4*)(in[0] + (size_t)(m < NTOK ? m : m0) * D) + F.lane;
#pragma unroll
            for (int j = 0; j < 4; ++j) v[q][j] = __builtin_nontemporal_load(xr + 64 * j); }
#pragma unroll
        for (int q = 0; q < 4; ++q) { const int m = m0 + q * F.ngw; if (m < NTOK) { float s = 0.f;
#pragma unroll
            for (int j = 0; j < 4; ++j) s += (v[q][j].x * v[q][j].x + v[q][j].y * v[q][j].y) + (v[q][j].z * v[q][j].z + v[q][j].w * v[q][j].w);
            s = wave_sum(s); if (F.lane == 0) RS[m * 4 + 0] = 1.0f / sqrtf(s * (1.0f / D) + EPS);
            u32x2* o8 = (u32x2*)(XB + (size_t)m * D) + F.lane;
#pragma unroll
            for (int j = 0; j < 4; ++j) { u32x2 w; w.x = cvtpk(v[q][j].x, v[q][j].y); w.y = cvtpk(v[q][j].z, v[q][j].w); o8[64 * j] = w; } } }
      } }
    { float* RSM = WSP(float, WS_RSM); bf16* MB = WSP(bf16, WS_MEMB);
      for (int m = F.gw; m < 512; m += F.ngw) {
        const f32x4* xr = (const f32x4*)(in[1] + (size_t)m * D) + F.lane; f32x4 v[4]; float s = 0.f;
#pragma unroll
        for (int j = 0; j < 4; ++j) { v[j] = xr[64 * j]; s += (v[j].x * v[j].x + v[j].y * v[j].y) + (v[j].z * v[j].z + v[j].w * v[j].w); }
        s = wave_sum(s); if (F.lane == 0) RSM[m] = 1.0f / sqrtf(s * (1.0f / D) + EPS);
        u32x2* o8 = (u32x2*)(MB + (size_t)m * D) + F.lane;
#pragma unroll
        for (int j = 0; j < 4; ++j) { u32x2 w; w.x = cvtpk(v[j].x, v[j].y); w.y = cvtpk(v[j].z, v[j].w); o8[64 * j] = w; }
      } }
    FSTAMP(F, 33);
    if (F.bid < 32) { const int kv = F.bid >> 4, part = (F.bid & 15) * 4 + (F.tid >> 7), f = F.tid & 127;
        const float* pos = in[kv ? 13 : 10] + 32 * part; const float* w1 = in[kv ? 14 : 11] + (size_t)(32 * part) * 128 + f; float wv[32], acc = 0.f;
#pragma unroll
        for (int k = 0; k < 32; ++k) wv[k] = w1[(size_t)k * 128];
#pragma unroll
        for (int k = 0; k < 32; ++k) acc += pos[k] * wv[k];
        WSP(float, WS_CONST)[CF_CPP + (kv * 64 + part) * 128 + f] = acc; }
    if (F.bid >= 64 && F.bid < 128) { const float* rw = in[30]; const float* gm = in[29]; bf16* WH = WSP(bf16, WS_WRH); bf16* WL = WSP(bf16, WS_WRL);
        { const int i = (F.bid - 64) * 512 + F.tid; const int k = i >> 5, e = i & 31; const float v = rw[i] * gm[k];
            const unsigned hb = cvtpk(v, 0.f) & 0xffffu; const float lo = v - bf2f(hb);
            const int fi = ((k >> 4) * 64 + e + 32 * ((k >> 3) & 1)) * 8 + (k & 7);
            WH[fi] = (bf16)hb; WL[fi] = (bf16)(cvtpk(lo, 0.f) & 0xffffu); } }
    float* CF = WSP(float, WS_CONST);
    if (F.bid == 0 && F.wave == 1) {
        const int l = F.lane;
        float m1 = 0.f; for (int i = l; i < 96; i += 64) m1 = fmaxf(m1, fabsf(in[9][i])); m1 = wave_max(m1);
        float m2 = wave_max(fabsf(in[17][l])); float m3 = wave_max(fabsf(in[27][l]));
        if (l == 0) { CF[CF_KBM] = sqrtf(96.f) * m1; CF[CF_KBN] = 8.f * m2; CF[CF_KBMEM] = 8.f * m3; }
        if (l < 8) { float mb = -1e30f; for (int b = 0; b < 32; ++b) mb = fmaxf(mb, in[18][b * 8 + l]); CF[CF_MAXB2 + l] = mb * LOG2E; }
        for (int i = l; i < 256; i += 64) CF[CF_BIAS2 + i] = in[18][i] * LOG2E;
        for (int n = l; n < 512; n += 64) { int bk; if (n < 16) bk = n; else { bk = 16 + (int)(logf((float)n / 16.0f) / logf(32.0f) * 16.0f); bk = bk < 31 ? bk : 31; } CF[CF_LUT + n] = (float)bk; }
    }
}
__device__ __forceinline__ void unpack8(const u32x4 w, float (&v)[8]) {
    v[0] = bf2f(w.x & 0xffff); v[1] = bf2f(w.x >> 16); v[2] = bf2f(w.y & 0xffff); v[3] = bf2f(w.y >> 16);
    v[4] = bf2f(w.z & 0xffff); v[5] = bf2f(w.z >> 16); v[6] = bf2f(w.w & 0xffff); v[7] = bf2f(w.w >> 16);
}
__device__ __forceinline__ u32x4 pack8f(const float (&v)[8]) { u32x4 w; w.x = cvtpk(v[0], v[1]); w.y = cvtpk(v[2], v[3]); w.z = cvtpk(v[4], v[5]); w.w = cvtpk(v[6], v[7]); return w; }

__device__ __forceinline__ void tp_a(Frame& F) {
    const float* CF = WSP(float, WS_CONST); const float kbn = CF[CF_KBN];
    const bf16* PB = WSP(bf16, WS_PB); float* RS = WSP(float, WS_RS);
    const int l = F.lane;
    const float* gq = F.in[16]; const float* gk = F.in[17];
    float gqv[8], gkv[8];
#pragma unroll
    for (int j = 0; j < 8; ++j) { gqv[j] = gq[(8 * l + j) & 63]; gkv[j] = gk[(8 * l + j) & 63]; }
    for (int t = F.gw; t < NTOK; t += F.ngw) {
        const bf16* pr = PB + (size_t)t * NINP; const int b = t >> 13, s = t & 8191;
        { float v[8]; unpack8(*(const u32x4*)(pr + C_QN + 8 * l), v); float ss = 0.f;
#pragma unroll
          for (int j = 0; j < 8; ++j) ss += v[j] * v[j];
          ss = grp8_sum(ss); const float rinv = 1.0f / sqrtf(ss * (1.0f / 64) + EPS) * (0.125f * LOG2E); float n2 = 0.f;
#pragma unroll
          for (int j = 0; j < 8; ++j) { v[j] = v[j] * rinv * gqv[j]; n2 += v[j] * v[j]; }
          n2 = grp8_sum(n2);
          const int h = l >> 3, g = h >> 2, hp = h & 3; const size_t ridx = (((size_t)(b * 2 + g) * S + s) * 4 + hp);
          *(u32x4*)(WSP(bf16, WS_QN) + ridx * 64 + (8 * l & 63)) = pack8f(v);
          if ((l & 7) == 0) WSP(float, WS_QBN)[ridx] = sqrtf(n2) * kbn + CF[CF_MAXB2 + h]; }
        { float v[8]; unpack8(*(const u32x4*)(pr + C_KS + 8 * l), v); const int seg = l >> 4, i = l & 15, g = i >> 3, d0 = (i & 7) * 8;
          float ss = 0.f;
#pragma unroll
          for (int j = 0; j < 8; ++j) ss += v[j] * v[j];
          ss = grp8_sum(ss);
          if ((seg & 1) == 0) { const float rinv = 1.0f / sqrtf(ss * (1.0f / 64) + EPS);
#pragma unroll
              for (int j = 0; j < 8; ++j) v[j] = v[j] * rinv * gkv[j]; }
          bf16* dst = WSP(bf16, seg == 0 ? WS_KS : seg == 1 ? WS_VS : seg == 2 ? WS_KW : WS_VW);
          *(u32x4*)(dst + ((size_t)(b * 2 + g) * S + s) * 64 + d0) = pack8f(v); }
        if (l < 24) { const float x = bf2f(pr[C_GT + l]); WSP(float, WS_GATE)[t * 24 + l] = 1.0f / (1.0f + __expf(-x)); }
    }
}

__device__ __forceinline__ void compress_phase(Frame& F) {
    const float* CF = WSP(float, WS_CONST);
    const bf16* PB = WSP(bf16, WS_PB);
    LAS float* red = (LAS float*)F.lds;
    LAS float* hid = (LAS float*)(F.lds + 65536);
    LAS float* ob = (LAS float*)(F.lds + 65536 + 8192);
    const int lane = F.lane, row = lane & 15, kq = lane >> 4;
    LAS float* cps = (LAS float*)(F.lds + 65536 + 8192 + 4096);
    LAS float* w2s = (LAS float*)(F.lds + 81920);
    __syncthreads();
    { const int o = F.tid & 255, hp = F.tid >> 8; const float* cp = CF + CF_CPP + (o >> 7) * 64 * 128 + (o & 127) + hp * 32 * 128; float pv[32];
#pragma unroll
      for (int p = 0; p < 32; ++p) pv[p] = cp[p * 128];
      float a = 0.f;
#pragma unroll
      for (int p = 0; p < 32; ++p) a += pv[p];
      cps[F.tid] = a; }
    for (int it = F.bid; it < 256; it += F.G) {
        const int kv = it >> 7, slab = (it >> 5) & 3, n0 = (it & 31) * 16, b = slab >> 1, g = slab & 1;
        const int n = n0 + row;
        int tok0 = 16 * n + 4 * F.wave; if (tok0 > S - 4) tok0 = S - 4;
        const bf16* ap = PB + (size_t)(b * S + tok0) * NINP + (kv ? C_VC : C_KC) + g * 64 + 8 * kq;
        const bf16* bp = WSP(bf16, WS_W1T) + (size_t)kv * 128 * 2048 + (size_t)(8 * F.wave) * 8 * 512 + lane * 8;
        f32x4 acc[8];
#pragma unroll
        for (int i = 0; i < 8; ++i) acc[i] = (f32x4){0.f, 0.f, 0.f, 0.f};
        f32x4 w2r[4];
#pragma unroll
        for (int i = 0; i < 4; ++i) w2r[i] = ((const f32x4*)F.in[kv ? 15 : 12])[F.tid + 512 * i];
#pragma unroll
        for (int hb = 0; hb < 2; ++hb) {
            bf16x8 af[4], bf[4][8];
#pragma unroll
            for (int s = 0; s < 4; ++s) { const int ks = hb * 4 + s;
                af[s] = *(const bf16x8*)(ap + (size_t)(ks >> 1) * NINP + 32 * (ks & 1));
#pragma unroll
                for (int fb = 0; fb < 8; ++fb) bf[s][fb] = *(const bf16x8*)(bp + (size_t)(ks * 8 + fb) * 512); }
#pragma unroll
            for (int s = 0; s < 4; ++s)
#pragma unroll
                for (int fb = 0; fb < 8; ++fb) acc[fb] = __builtin_amdgcn_mfma_f32_16x16x32_bf16(af[s], bf[s][fb], acc[fb], 0, 0, 0);
        }
        __syncthreads();
#pragma unroll
        for (int i = 0; i < 4; ++i) ((LAS f32x4*)w2s)[F.tid + 512 * i] = w2r[i];
#pragma unroll
        for (int fb = 0; fb < 8; ++fb)
#pragma unroll
            for (int i = 0; i < 4; ++i) red[(F.wave * 16 + 4 * kq + i) * 128 + fb * 16 + row] = acc[fb][i];
        __syncthreads();
        { const float c0 = 0.7978845608028654f, c1 = 0.044715f;
#pragma unroll
          for (int q = 0; q < 4; ++q) { const int idx = F.tid + 512 * q; float a = cps[kv * 128 + (idx & 127)] + cps[256 + kv * 128 + (idx & 127)];
#pragma unroll
              for (int ww = 0; ww < 8; ++ww) a += red[ww * 2048 + idx];
              hid[idx] = 0.5f * a * (1.f + tanhf(c0 * (a + c1 * a * a * a))); } }
        __syncthreads();
        {
#pragma unroll
          for (int q = 0; q < 2; ++q) { const int idx = F.tid + 512 * q, r = idx >> 6, d = idx & 63; float o = 0.f;
#pragma unroll 16
              for (int f = 0; f < 128; ++f) o += hid[r * 128 + f] * w2s[f * 64 + d];
              if (kv == 0) { const float ss = wave_sum(o * o); o = o * (1.0f / sqrtf(ss * (1.0f / 64) + EPS)) * F.in[17][d]; }
              const int nn = n0 + r; if (nn >= 511) o = 0.f;
              WSP(bf16, kv ? WS_VCMP : WS_KCMP)[((size_t)slab * 512 + nn) * 64 + d] = (bf16)(cvtpk(o, 0.f) & 0xffff); } }
    }
    __syncthreads();
}

__device__ __forceinline__ void tp_b(Frame& F) {
    const float* CF = WSP(float, WS_CONST); const float kbm = CF[CF_KBM];
    const bf16* PB = WSP(bf16, WS_PB); const bf16* QR = WSP(bf16, WS_QRAW); const bf16* KVR = WSP(bf16, WS_KVRAW);
    const int l = F.lane, h = l >> 3, c = l & 7;
    const float* gq = F.in[8]; const float* gk = F.in[9];
    float gqn[8], gkn[8], gqr[4], gkr[4];
#pragma unroll
    for (int j = 0; j < 8; ++j) { gqn[j] = gq[8 * c + j]; gkn[j] = gk[8 * c + j]; }
    gqr[0] = gq[64 + 2 * c]; gqr[1] = gq[65 + 2 * c]; gqr[2] = gq[80 + 2 * c]; gqr[3] = gq[81 + 2 * c];
    gkr[0] = gk[64 + 2 * c]; gkr[1] = gk[65 + 2 * c]; gkr[2] = gk[80 + 2 * c]; gkr[3] = gk[81 + 2 * c];
    const float if0 = exp2f(-(float)(2 * c) * (13.287712379549449f / 16.0f)), if1 = exp2f(-(float)(2 * c + 1) * (13.287712379549449f / 16.0f));
    const float cq = 0.10206207261596575f * LOG2E;
    for (int t = F.gw; t < NTOK; t += F.ngw) {
        const int b = t >> 13, s = t & 8191; const size_t hrow = ((size_t)(b * 8 + h) * S + s);
        const float rcq = WSP(float, WS_RS)[t * 4 + 1], rckv = WSP(float, WS_RS)[t * 4 + 2];
        const float rv0 = __builtin_amdgcn_fractf((float)s * if0 * 0.15915494309189535f), rv1 = __builtin_amdgcn_fractf((float)s * if1 * 0.15915494309189535f);
        const float sn0 = __builtin_amdgcn_sinf(rv0), cs0 = __builtin_amdgcn_cosf(rv0), sn1 = __builtin_amdgcn_sinf(rv1), cs1 = __builtin_amdgcn_cosf(rv1);
        {
          float v[8]; unpack8(*(const u32x4*)(QR + (size_t)t * 768 + h * 96 + 8 * c), v);
          const unsigned wa = *(const unsigned*)(QR + (size_t)t * 768 + h * 96 + 64 + 2 * c), wb = *(const unsigned*)(QR + (size_t)t * 768 + h * 96 + 80 + 2 * c);
          float r0 = bf2f(wa & 0xffff), r1 = bf2f(wa >> 16), r2 = bf2f(wb & 0xffff), r3 = bf2f(wb >> 16);
          float ss = r0 * r0 + r1 * r1 + r2 * r2 + r3 * r3;
#pragma unroll
          for (int j = 0; j < 8; ++j) ss += v[j] * v[j];
          ss = grp8_sum(ss) * rcq * rcq; const float rinv = rcq / sqrtf(ss * (1.0f / 96) + EPS) * cq; float n2 = 0.f;
#pragma unroll
          for (int j = 0; j < 8; ++j) { v[j] = v[j] * rinv * gqn[j]; n2 += v[j] * v[j]; }
          r0 *= rinv * gqr[0]; r1 *= rinv * gqr[1]; r2 *= rinv * gqr[2]; r3 *= rinv * gqr[3];
          const float y0 = r0 * cs0 - r2 * sn0, y2 = r2 * cs0 + r0 * sn0, y1 = r1 * cs1 - r3 * sn1, y3 = r3 * cs1 + r1 * sn1;
          n2 += y0 * y0 + y1 * y1 + y2 * y2 + y3 * y3; n2 = grp8_sum(n2);
          bf16* dst = WSP(bf16, WS_QM) + hrow * 96;
          *(u32x4*)(dst + 8 * c) = pack8f(v); *(unsigned*)(dst + 64 + 2 * c) = cvtpk(y0, y1); *(unsigned*)(dst + 80 + 2 * c) = cvtpk(y2, y3);
          if (c == 0) WSP(float, WS_QBM)[hrow] = sqrtf(n2) * kbm; }
        {
          float v[8]; unpack8(*(const u32x4*)(KVR + (size_t)t * 1024 + h * 128 + 8 * c), v);
          const unsigned wa = *(const unsigned*)(PB + (size_t)t * NINP + C_KR + 2 * c), wb = *(const unsigned*)(PB + (size_t)t * NINP + C_KR + 16 + 2 * c);
          float r0 = bf2f(wa & 0xffff), r1 = bf2f(wa >> 16), r2 = bf2f(wb & 0xffff), r3 = bf2f(wb >> 16);
          float ss = r0 * r0 + r1 * r1 + r2 * r2 + r3 * r3;
#pragma unroll
          for (int j = 0; j < 8; ++j) { v[j] *= rckv; ss += v[j] * v[j]; }
          ss = grp8_sum(ss); const float rinv = 1.0f / sqrtf(ss * (1.0f / 96) + EPS);
#pragma unroll
          for (int j = 0; j < 8; ++j) v[j] = v[j] * rinv * gkn[j];
          r0 *= rinv * gkr[0]; r1 *= rinv * gkr[1]; r2 *= rinv * gkr[2]; r3 *= rinv * gkr[3];
          const float y0 = r0 * cs0 - r2 * sn0, y2 = r2 * cs0 + r0 * sn0, y1 = r1 * cs1 - r3 * sn1, y3 = r3 * cs1 + r1 * sn1;
          bf16* dst = WSP(bf16, WS_KM) + hrow * 96;
          *(u32x4*)(dst + 8 * c) = pack8f(v); *(unsigned*)(dst + 64 + 2 * c) = cvtpk(y0, y1); *(unsigned*)(dst + 80 + 2 * c) = cvtpk(y2, y3); }
        { float vv[8]; unpack8(*(const u32x4*)(KVR + (size_t)t * 1024 + h * 128 + 64 + 8 * c), vv);
#pragma unroll
          for (int j = 0; j < 8; ++j) vv[j] *= rckv;
          *(u32x4*)(WSP(bf16, WS_VM) + hrow * 64 + 8 * c) = pack8f(vv); }
    }
}

__device__ __forceinline__ void tp_c0(Frame& F) {
    bf16* Y = WSP(bf16, WS_Y); const int l = F.lane;
    for (int t = F.gw; t < NTOK; t += F.ngw) {
        u32x4* p = (u32x4*)(Y + (size_t)t * 1024 + 16 * l); float v0[8], v1[8]; unpack8(p[0], v0); unpack8(p[1], v1); float ss = 0.f;
#pragma unroll
        for (int j = 0; j < 8; ++j) ss += v0[j] * v0[j] + v1[j] * v1[j];
        ss += shx<1>(ss); ss += shx<2>(ss); ss += shx<4>(ss); ss += shx<8>(ss); ss += shx<16>(ss);
        const float rinv = 1.0f / sqrtf(ss * (1.0f / 512) + EPS);
#pragma unroll
        for (int j = 0; j < 8; ++j) { v0[j] *= rinv; v1[j] *= rinv; }
        p[0] = pack8f(v0); p[1] = pack8f(v1);
    }
}
__device__ __forceinline__ void tp_c(Frame& F) {
    float* RS = WSP(float, WS_RS); bf16* XB = WSP(bf16, WS_XB);
    for (int m = F.gw; m < NTOK; m += F.ngw) {
        const f32x4* xr = (const f32x4*)(F.out + (size_t)m * D) + F.lane; f32x4 v[4]; float s = 0.f;
#pragma unroll
        for (int j = 0; j < 4; ++j) { v[j] = xr[64 * j]; s += (v[j].x * v[j].x + v[j].y * v[j].y) + (v[j].z * v[j].z + v[j].w * v[j].w); }
        s = wave_sum(s); if (F.lane == 0) RS[m * 4 + 3] = 1.0f / sqrtf(s * (1.0f / D) + EPS);
        u32x2* o8 = (u32x2*)(XB + (size_t)m * D) + F.lane;
#pragma unroll
        for (int j = 0; j < 4; ++j) { u32x2 w; w.x = cvtpk(v[j].x, v[j].y); w.y = cvtpk(v[j].z, v[j].w); o8[64 * j] = w; }
    }
}

__device__ __forceinline__ int crow(int r, int hi) { return (r & 3) + 8 * (r >> 2) + 4 * hi; }
typedef short v4i16_t __attribute__((ext_vector_type(4)));
__device__ __forceinline__ s16x4 vtr(const LAS char* p) { return __builtin_bit_cast(s16x4, __builtin_amdgcn_ds_read_tr16_b64_v4i16((LAS v4i16_t*)p)); }

template <int ROWB> struct TileRegs { u32x4 r[(64 * ROWB / 16 + 511) / 512]; };
__device__ __forceinline__ const GAS char* uni_ptr(const char* p) { const unsigned long long v = (unsigned long long)p; const unsigned lo = __builtin_amdgcn_readfirstlane((unsigned)v), hi = __builtin_amdgcn_readfirstlane((unsigned)(v >> 32)); return (const GAS char*)(((unsigned long long)hi << 32) | lo); }
template <int ROWB> __device__ __forceinline__ void tile_load(TileRegs<ROWB>& T, const char* g_, int tid) {
    constexpr int NCH = 64 * ROWB / 16; const GAS char* g = uni_ptr(g_);
#pragma unroll
    for (int i = 0; i < (NCH + 511) / 512; ++i) { const int c = tid + 512 * i; const unsigned off = (unsigned)c * 16u; if (c < NCH) T.r[i] = *(const GAS u32x4*)(g + off); }
}
template <int ROWB, int STR> __device__ __forceinline__ void tile_store(const TileRegs<ROWB>& T, LAS char* l, int tid) {
    constexpr int NCH = 64 * ROWB / 16, CPR = ROWB / 16;
#pragma unroll
    for (int i = 0; i < (NCH + 511) / 512; ++i) { const int c = tid + 512 * i; if (c < NCH) *(LAS u32x4*)(l + (c / CPR) * STR + (c % CPR) * 16) = T.r[i]; }
}
template <int DK, int KSTR> __device__ __forceinline__ void qk_tile(f32x16& p0, f32x16& p1, const LAS char* Kt, const bf16x8* q, int lane, float cinit = 0.f) {
    const LAS char* kb = Kt + (lane & 31) * KSTR + (lane >> 5) * 16;
#pragma unroll
    for (int r = 0; r < 16; ++r) { p0[r] = cinit; p1[r] = cinit; }
#pragma unroll
    for (int s = 0; s < DK / 16; ++s) {
        const bf16x8 a0 = *(const LAS bf16x8*)(kb + s * 32), a1 = *(const LAS bf16x8*)(kb + 32 * KSTR + s * 32);
        p0 = __builtin_amdgcn_mfma_f32_32x32x16_bf16(a0, q[s], p0, 0, 0, 0);
        p1 = __builtin_amdgcn_mfma_f32_32x32x16_bf16(a1, q[s], p1, 0, 0, 0);
    }
    __builtin_amdgcn_sched_barrier(0);
}
__device__ __forceinline__ bf16x8 packp(const f32x16& p, int b) {
    u32x4 w; w.x = cvtpk(p[b], p[b + 1]); w.y = cvtpk(p[b + 2], p[b + 3]); w.z = cvtpk(p[b + 4], p[b + 5]); w.w = cvtpk(p[b + 6], p[b + 7]); return __builtin_bit_cast(bf16x8, w);
}
template <int VSTR> __device__ __forceinline__ void pv_tile(f32x16 (&o)[2], const LAS char* Vt, const f32x16& p0, const f32x16& p1, int lane) {
    const int i = lane & 15, g16 = lane >> 4, hi = g16 >> 1, dblk = (g16 & 1) * 16, q_ = i >> 2, p_ = i & 3;
    const LAS char* vb = Vt + (4 * hi + q_) * VSTR + (dblk + 4 * p_) * 2;
    __builtin_amdgcn_sched_barrier(0);
#pragma unroll
    for (int s = 0; s < 4; ++s) {
        const bf16x8 pa = packp(s < 2 ? p0 : p1, (s & 1) * 8);
#pragma unroll
        for (int d0 = 0; d0 < 2; ++d0) {
            const s16x4 lo = vtr(vb + (16 * s) * VSTR + d0 * 64), h8 = vtr(vb + (16 * s + 8) * VSTR + d0 * 64);
            const bf16x8 bv = {lo[0], lo[1], lo[2], lo[3], h8[0], h8[1], h8[2], h8[3]};
            o[d0] = __builtin_amdgcn_mfma_f32_32x32x16_bf16(pa, bv, o[d0], 0, 0, 0);
        }
        __builtin_amdgcn_sched_barrier(0);
    }
}
template <int DK, int KSTR> __device__ __forceinline__ void qk_half(f32x16& p, const LAS char* Kt, const bf16x8* q, int lane, float cinit, int hf) {
    const LAS char* kb = Kt + ((lane & 31) + 32 * hf) * KSTR + (lane >> 5) * 16;
#pragma unroll
    for (int r = 0; r < 16; ++r) p[r] = cinit;
#pragma unroll
    for (int s = 0; s < DK / 16; ++s) { const bf16x8 a = *(const LAS bf16x8*)(kb + s * 32); p = __builtin_amdgcn_mfma_f32_32x32x16_bf16(a, q[s], p, 0, 0, 0); }
    __builtin_amdgcn_sched_barrier(0);
}
template <int VSTR> __device__ __forceinline__ void pv_half(f32x16 (&o)[2], const LAS char* Vt, const f32x16& p, int lane, int hf) {
    const int i = lane & 15, g16 = lane >> 4, hi = g16 >> 1, dblk = (g16 & 1) * 16, q_ = i >> 2, p_ = i & 3;
    const LAS char* vb = Vt + (32 * hf + 4 * hi + q_) * VSTR + (dblk + 4 * p_) * 2;
    __builtin_amdgcn_sched_barrier(0);
#pragma unroll
    for (int s = 0; s < 2; ++s) {
        const bf16x8 pa = packp(p, s * 8);
#pragma unroll
        for (int d0 = 0; d0 < 2; ++d0) {
            const s16x4 lo = vtr(vb + (16 * s) * VSTR + d0 * 64), h8 = vtr(vb + (16 * s + 8) * VSTR + d0 * 64);
            const bf16x8 bv = {lo[0], lo[1], lo[2], lo[3], h8[0], h8[1], h8[2], h8[3]};
            o[d0] = __builtin_amdgcn_mfma_f32_32x32x16_bf16(pa, bv, o[d0], 0, 0, 0);
        }
        __builtin_amdgcn_sched_barrier(0);
    }
}
__device__ __forceinline__ float sum16(const f32x16& p) {
    const float a = (p[0] + p[1]) + (p[2] + p[3]), b = (p[4] + p[5]) + (p[6] + p[7]), c = (p[8] + p[9]) + (p[10] + p[11]), d = (p[12] + p[13]) + (p[14] + p[15]); return (a + b) + (c + d);
}
template <int DK, int KSTR> __device__ __forceinline__ void kf_load(bf16x8 (&kf)[DK / 16], const LAS char* Kt, int lane, int hf) {
    const LAS char* kb = Kt + ((lane & 31) + 32 * hf) * KSTR + (lane >> 5) * 16;
#pragma unroll
    for (int s = 0; s < DK / 16; ++s) kf[s] = *(const LAS bf16x8*)(kb + s * 32);
}
template <int VSTR> __device__ __forceinline__ void vf_load(bf16x8 (&vf)[2][2], const LAS char* Vt, int lane, int hf) {
    const int i = lane & 15, g16 = lane >> 4, hi = g16 >> 1, dblk = (g16 & 1) * 16, q_ = i >> 2, p_ = i & 3;
    const LAS char* vb = Vt + (32 * hf + 4 * hi + q_) * VSTR + (dblk + 4 * p_) * 2;
#pragma unroll
    for (int s = 0; s < 2; ++s)
#pragma unroll
        for (int d0 = 0; d0 < 2; ++d0) { const s16x4 lo = vtr(vb + (16 * s) * VSTR + d0 * 64), h8 = vtr(vb + (16 * s + 8) * VSTR + d0 * 64);
            vf[s][d0] = (bf16x8){lo[0], lo[1], lo[2], lo[3], h8[0], h8[1], h8[2], h8[3]}; }
}
template <int DK, int KSTR, int VSTR, class CI, class EF>
__device__ __forceinline__ void attn_tile(const LAS char* Kb, const LAS char* Vb, const bf16x8* q, f32x16 (&o)[2], int lane, CI cinit, EF elem, bool act0 = true, bool act1 = true) {
    bf16x8 kf[DK / 16];
    if (act0) kf_load<DK, KSTR>(kf, Kb, lane, 0); else if (act1) kf_load<DK, KSTR>(kf, Kb, lane, 1);
#pragma unroll
    for (int hf = 0; hf < 2; ++hf) {
        if (!(hf ? act1 : act0)) continue;
        f32x16 p; const float ci = cinit(hf);
#pragma unroll
        for (int r = 0; r < 16; ++r) p[r] = ci;
        __builtin_amdgcn_sched_barrier(0);
#pragma unroll
        for (int s = 0; s < DK / 16; ++s) p = __builtin_amdgcn_mfma_f32_32x32x16_bf16(kf[s], q[s], p, 0, 0, 0);
        __builtin_amdgcn_sched_barrier(0);
        bf16x8 vf[2][2]; vf_load<VSTR>(vf, Vb, lane, hf);
        if (hf == 0 && act1) kf_load<DK, KSTR>(kf, Kb, lane, 1);
        __builtin_amdgcn_sched_barrier(0);
        elem(p, hf);
        __builtin_amdgcn_sched_barrier(0);
#pragma unroll
        for (int s = 0; s < 2; ++s) { const bf16x8 pa = packp(p, s * 8);
#pragma unroll
            for (int d0 = 0; d0 < 2; ++d0) o[d0] = __builtin_amdgcn_mfma_f32_32x32x16_bf16(pa, vf[s][d0], o[d0], 0, 0, 0); }
        __builtin_amdgcn_sched_barrier(0);
    }
}
constexpr int BCAST_OFF = LDSX_OFF + 4096;
__device__ __forceinline__ void bcast_rows(float v, LAS unsigned char* lds, int wave, int lane, float (&out)[16]) {
    LAS float* wsf = (LAS float*)(lds + BCAST_OFF) + wave * 32;
    wsf[lane & 31] = v;
    LDS_WAIT(); asm volatile("" ::: "memory");
    const LAS float* rp = wsf + 4 * (lane >> 5);
#pragma unroll
    for (int r = 0; r < 16; ++r) out[r] = rp[(r & 3) + 8 * (r >> 2)];
    LDS_WAIT(); asm volatile("" ::: "memory");
}
constexpr int KSTR64 = 144, KSTR96 = 208, VSTR64 = 192;

__device__ __forceinline__ void store_rows64(const LAS float* img, bf16* ybase, float* ssq_base, int lane) {
#pragma unroll
    for (int i = 0; i < 4; ++i) { const int idx = lane + 64 * i, row = idx >> 3, c8 = idx & 7, hi_ = (row >> 2) & 1, r = (row & 3) + 4 * (row >> 3), nb = c8 >> 2;
        const LAS float* p = img + (16 * nb + r) * 64 + 32 * hi_ + 8 * (c8 & 3);
        const f32x4 a = *(const LAS f32x4*)p, b = *(const LAS f32x4*)(p + 4);
        float ss = ((a[0] * a[0] + a[1] * a[1]) + (a[2] * a[2] + a[3] * a[3])) + ((b[0] * b[0] + b[1] * b[1]) + (b[2] * b[2] + b[3] * b[3]));
        ss = grp8_sum(ss);
        u32x4 w; w.x = cvtpk(a[0], a[1]); w.y = cvtpk(a[2], a[3]); w.z = cvtpk(b[0], b[1]); w.w = cvtpk(b[2], b[3]);
        *(u32x4*)(ybase + (size_t)row * 1024 + 8 * c8) = w;
        if (c8 == 0) ssq_base[row * 16] = ss; }
}
__device__ __forceinline__ void mla_unit(Frame& F, int bh, int qb) {
    const int lane = F.lane, hi = lane >> 5, w = F.wave;
    const int q0 = qb * 256, qpos = q0 + 32 * w + (lane & 31);
    const bf16* Qm = WSP(bf16, WS_QM) + ((size_t)bh * S + qpos) * 96;
    const char* Kg = (const char*)(WSP(bf16, WS_KM) + (size_t)bh * S * 96); const char* Vg = (const char*)(WSP(bf16, WS_VM) + (size_t)bh * S * 64);
    bf16x8 qf[6];
#pragma unroll
    for (int s = 0; s < 6; ++s) qf[s] = *(const bf16x8*)(Qm + 16 * s + 8 * hi);
    const float bound = WSP(float, WS_QBM)[(size_t)bh * S + qpos];
    LAS char* KT[2] = {(LAS char*)F.lds, (LAS char*)F.lds + 64 * KSTR96}; LAS char* VT[2] = {(LAS char*)F.lds + 2 * 64 * KSTR96, (LAS char*)F.lds + 2 * 64 * KSTR96 + 64 * VSTR64};
    f32x16 o[2]; float lsum = 0.f;
#pragma unroll
    for (int r = 0; r < 16; ++r) { o[0][r] = 0.f; o[1][r] = 0.f; }
    const int NT = (q0 + 256) / 64; const int wq0 = q0 + 32 * w;
    TileRegs<192> krA; TileRegs<128> vrA;
    auto mla_compute = [&](int t, const LAS char* Kb, const LAS char* Vb) {
        if (64 * t <= wq0 + 31) {
            const bool diag = (64 * t + 63 > wq0);
            if (diag) {
                attn_tile<96, KSTR96, VSTR64>(Kb, Vb, qf, o, lane, [&](int) { return -bound; },
                    [&](f32x16& p, int hf) {
                        const int dl = qpos - 64 * t - 32 * hf - 4 * hi;
#pragma unroll
                        for (int r = 0; r < 16; ++r) { float e = __builtin_amdgcn_exp2f(p[r]); if ((r & 3) + 8 * (r >> 2) > dl) e = 0.f; p[r] = e; }
                        lsum += sum16(p); },
                    true, 64 * t + 32 <= wq0 + 31);
            } else {
                attn_tile<96, KSTR96, VSTR64>(Kb, Vb, qf, o, lane, [&](int) { return -bound; },
                    [&](f32x16& p, int) {
#pragma unroll
                        for (int r = 0; r < 16; ++r) p[r] = __builtin_amdgcn_exp2f(p[r]);
                        lsum += sum16(p); });
            }
        } };
    __syncthreads();
    tile_load<192>(krA, Kg, F.tid); tile_load<128>(vrA, Vg, F.tid);
    tile_store<192, KSTR96>(krA, KT[0], F.tid); tile_store<128, VSTR64>(vrA, VT[0], F.tid);
    __syncthreads();
    for (int t = 0; t < NT; ++t) {
        if (t + 1 < NT) { tile_load<192>(krA, Kg + (size_t)(t + 1) * 64 * 192, F.tid); tile_load<128>(vrA, Vg + (size_t)(t + 1) * 64 * 128, F.tid); }
        mla_compute(t, KT[t & 1], VT[t & 1]);
        if (t + 1 < NT) { tile_store<192, KSTR96>(krA, KT[(t + 1) & 1], F.tid); tile_store<128, VSTR64>(vrA, VT[(t + 1) & 1], F.tid); }
        __syncthreads();
    }
    lsum = sum32x(lsum); const float linv = lsum > 0.f ? 1.0f / lsum : 0.f;
    bf16* Y = WSP(bf16, WS_Y); const int b = bh >> 3, h = bh & 7;
    float fr_[16]; bcast_rows(linv, F.lds, w, lane, fr_);
    LAS float* img = (LAS float*)(F.lds + 8192 * w);
#pragma unroll
    for (int r = 0; r < 16; ++r) { const float f = fr_[r]; img[r * 64 + lane] = o[0][r] * f; img[(16 + r) * 64 + lane] = o[1][r] * f; }
    LDS_WAIT(); asm volatile("" ::: "memory");
    store_rows64(img, Y + ((size_t)b * S + wq0) * 1024 + h * 64, WSP(float, WS_VMEM) + ((size_t)b * S + wq0) * 16 + h, lane);
}

__device__ __forceinline__ void nsa_unit(Frame& F, int bg, int cur, bool build_tables) {
    const int lane = F.lane, hi = lane >> 5, w = F.wave, hp = w & 3, qs = w >> 2;
    const int b = bg >> 1, g = bg & 1, h = g * 4 + hp;
    const int q0 = 64 * cur, qi = 32 * qs + (lane & 31), qpos = q0 + qi;
    const float* CF = WSP(float, WS_CONST);
    constexpr int TBL = 712; constexpr float NEGB = -3.0e38f;
    LAS char* KT[2] = {(LAS char*)F.lds, (LAS char*)F.lds + 64 * KSTR64}; LAS char* VT[2] = {(LAS char*)F.lds + 2 * 64 * KSTR64, (LAS char*)F.lds + 2 * 64 * KSTR64 + 64 * VSTR64};
    LAS float* TW = (LAS float*)(F.lds + 43008);
    LAS float* TS = TW + 4 * TBL;
    LAS unsigned* MSK = (LAS unsigned*)(F.lds + 43008 + 2 * 4 * TBL * 4);
    LAS float* PL = (LAS float*)(F.lds + 66816);
    LAS float* IMP = (LAS float*)(F.lds + 66816 + 17408);
    LAS float* PARK = (LAS float*)(F.lds + 66816) + w * 2048 + lane;
    __syncthreads();
    if (build_tables)
    for (int i = F.tid; i < 4 * TBL; i += 512) { const int hh = i / TBL, x = i - hh * TBL, dist = 639 - x; const bool in = dist >= 0 && dist < 512;
        const float bv = CF[CF_BIAS2 + (in ? (int)CF[CF_LUT + dist] : 31) * 8 + g * 4 + hh];
        TW[i] = in ? bv : NEGB; TS[i] = dist < 0 ? NEGB : bv; }
    const float bias31 = CF[CF_BIAS2 + 31 * 8 + h];
    const size_t qrow = ((size_t)bg * S + qpos) * 4 + hp;
    bf16x8 qf[4];
    { const GAS char* qb = uni_ptr((const char*)(F.ws + WS_QN)); const unsigned qoff = (unsigned)qrow * 128u + 16u * hi;
#pragma unroll
      for (int s = 0; s < 4; ++s) qf[s] = *(const GAS bf16x8*)(qb + qoff + 32 * s); }
    const float bound = *(const GAS float*)(uni_ptr((const char*)(F.ws + WS_QBN)) + (unsigned)qrow * 4u);
    const float* GT = WSP(float, WS_GATE); const int gto = (b * S + qpos) * 24 + h * 3;
    const LAS float* tsl = TS + hp * TBL; const LAS float* twl = TW + hp * TBL;
    const float cfar = bias31 - bound;
    TileRegs<128> kr, vr;
    f32x16 ocmp[2];
    const int ncmp = 4 * cur + 3 < 511 ? 4 * cur + 3 : 511, nct = (ncmp + 63) / 64;
    const char* Kc = (const char*)(WSP(bf16, WS_KCMP) + (size_t)bg * 512 * 64); const char* Vc = (const char*)(WSP(bf16, WS_VCMP) + (size_t)bg * 512 * 64);
#define NSA_CMP_EXP(T_, HF_, P_, SCALE_) do { \
        if (q0 - (16 * (64 * (T_) + 63) + 31) >= 512) { \
            _Pragma("unroll") for (int r = 0; r < 16; ++r) P_[r] = __builtin_amdgcn_exp2f(P_[r]) * (SCALE_); \
        } else { \
            _Pragma("unroll") for (int r = 0; r < 16; ++r) { const int n = 64 * (T_) + 32 * (HF_) + crow(r, hi); const int dist = qpos - (16 * n + 31); \
                const float bs = dist < 512 ? tsl[639 - (dist < 0 ? 0 : dist)] - bias31 : 0.f; const float sv = P_[r] + bs; \
                P_[r] = dist >= 0 ? __builtin_amdgcn_exp2f(sv) * (SCALE_) : 0.f; \
                if ((r & 3) == 3) __builtin_amdgcn_sched_barrier(0); } \
        } } while (0)
    float lc = 0.f;
    __syncthreads();
    for (int t = 0; t < nct; ++t) {
        tile_load<128>(kr, Kc + (size_t)t * 8192, F.tid); tile_store<128, KSTR64>(kr, KT[0], F.tid); __syncthreads();
        { bf16x8 kf[4]; kf_load<64, KSTR64>(kf, KT[0], lane, 0);
#pragma unroll
          for (int hf = 0; hf < 2; ++hf) { f32x16 p;
#pragma unroll
            for (int r = 0; r < 16; ++r) p[r] = cfar;
#pragma unroll
            for (int s = 0; s < 4; ++s) p = __builtin_amdgcn_mfma_f32_32x32x16_bf16(kf[s], qf[s], p, 0, 0, 0);
            __builtin_amdgcn_sched_barrier(0);
            if (hf == 0) kf_load<64, KSTR64>(kf, KT[0], lane, 1);
            NSA_CMP_EXP(t, hf, p, 1.0f);
            lc += sum16(p); } }
        __syncthreads();
    }
    lc = sum32x(lc); const float lcinv = lc > 0.f ? 1.0f / lc : 0.f;
    {
        f32x16 o[2];
#pragma unroll
        for (int r = 0; r < 16; ++r) { o[0][r] = 0.f; o[1][r] = 0.f; }
        float carry = 0.f;
        for (int t = 0; t < nct; ++t) {
            tile_load<128>(kr, Kc + (size_t)t * 8192, F.tid); tile_load<128>(vr, Vc + (size_t)t * 8192, F.tid);
            tile_store<128, KSTR64>(kr, KT[0], F.tid); tile_store<128, VSTR64>(vr, VT[0], F.tid); __syncthreads();
            float yprev = carry; f32x16 ph[2];
            bf16x8 kf[4]; kf_load<64, KSTR64>(kf, KT[0], lane, 0);
#pragma unroll
            for (int hf = 0; hf < 2; ++hf) {
#pragma unroll
                for (int r = 0; r < 16; ++r) ph[hf][r] = cfar;
#pragma unroll
                for (int s = 0; s < 4; ++s) ph[hf] = __builtin_amdgcn_mfma_f32_32x32x16_bf16(kf[s], qf[s], ph[hf], 0, 0, 0);
                __builtin_amdgcn_sched_barrier(0);
                if (hf == 0) kf_load<64, KSTR64>(kf, KT[0], lane, 1);
                NSA_CMP_EXP(t, hf, ph[hf], lcinv);
#pragma unroll
                for (int gi = 0; gi < 4; ++gi) { const f32x16& P = ph[hf]; const float x = P[4 * gi + 3]; const float y = shx<32>(x);
                    const float prev = hi ? y : yprev; PL[(hp * 64 + qi) * 17 + 8 * hf + 2 * gi + hi] = (P[4 * gi] + P[4 * gi + 1]) + (P[4 * gi + 2] + x) + prev; yprev = y; } }
            carry = yprev;
            __syncthreads();
#pragma unroll
            for (int q2 = 0; q2 < 2; ++q2) { const int idx = F.tid + 512 * q2, qq = idx >> 4, jl = idx & 15;
                IMP[qq * 128 + 16 * t + jl] = (PL[(0 * 64 + qq) * 17 + jl] + PL[(1 * 64 + qq) * 17 + jl]) + (PL[(2 * 64 + qq) * 17 + jl] + PL[(3 * 64 + qq) * 17 + jl]); }
#pragma unroll
            for (int hf = 0; hf < 2; ++hf) { bf16x8 vf[2][2]; vf_load<VSTR64>(vf, VT[0], lane, hf);
#pragma unroll
                for (int s = 0; s < 2; ++s) { const bf16x8 pa = packp(ph[hf], s * 8);
#pragma unroll
                    for (int d0 = 0; d0 < 2; ++d0) o[d0] = __builtin_amdgcn_mfma_f32_32x32x16_bf16(pa, vf[s][d0], o[d0], 0, 0, 0); } }
            __syncthreads();
        }
        const float g0 = GT[gto];
        float fr_[16]; bcast_rows(g0, F.lds, w, lane, fr_);
#pragma unroll
        for (int r = 0; r < 16; ++r) { const float f = fr_[r]; ocmp[0][r] = o[0][r] * f; ocmp[1][r] = o[1][r] * f; }
    }
#undef NSA_CMP_EXP
    {
        for (int i8 = 0; i8 < 8; i8 += 4) {
            unsigned long long mlo[4], mhi[4];
            if (cur < 16) {
#pragma unroll
                for (int k = 0; k < 4; ++k) { mlo[k] = (1ull << (cur + 1)) - 1ull; mhi[k] = 0ull; }
            } else {
                const int ja = lane, jb = lane + 64; const bool va = ja >= 1 && ja <= cur - 2, vb = jb <= cur - 2;
                unsigned ua[4], ub[4], thr[4];
#pragma unroll
                for (int k = 0; k < 4; ++k) { const int q = w * 8 + i8 + k; ua[k] = __float_as_uint(IMP[q * 128 + lane]); ub[k] = __float_as_uint(IMP[q * 128 + 64 + lane]); thr[k] = 0u; }
                bool fin[4] = {false, false, false, false};
                for (int bit = 30; bit >= 0; --bit) {
#pragma unroll
                    for (int k = 0; k < 4; ++k) { const unsigned trial = thr[k] | (1u << bit);
                        const int cnt = __popcll(__ballot(va && ua[k] >= trial)) + __popcll(__ballot(vb && ub[k] >= trial));
                        if (!fin[k] && cnt >= 13) thr[k] = trial; fin[k] = fin[k] || (cnt == 13); }
                    if (fin[0] && fin[1] && fin[2] && fin[3]) break; }
#pragma unroll
                for (int k = 0; k < 4; ++k) {
                    const bool ga = va && ua[k] > thr[k], gb = vb && ub[k] > thr[k], ea = va && ua[k] == thr[k], eb = vb && ub[k] == thr[k];
                    const int need = 13 - (__popcll(__ballot(ga)) + __popcll(__ballot(gb)));
                    const unsigned long long ma = __ballot(ea), mb = __ballot(eb);
                    const int ra = (int)__builtin_amdgcn_mbcnt_hi((unsigned)(ma >> 32), __builtin_amdgcn_mbcnt_lo((unsigned)ma, 0u));
                    const int rb = __popcll(ma) + (int)__builtin_amdgcn_mbcnt_hi((unsigned)(mb >> 32), __builtin_amdgcn_mbcnt_lo((unsigned)mb, 0u));
                    const bool sa = ga || (ea && ra < need) || ja == 0 || ja == cur || ja == cur - 1;
                    const bool sb = gb || (eb && rb < need) || jb == cur || jb == cur - 1;
                    mlo[k] = __ballot(sa); mhi[k] = __ballot(sb); }
            }
            if (lane == 0) {
#pragma unroll
                for (int k = 0; k < 4; ++k) { const int q = w * 8 + i8 + k; MSK[q * 4 + 0] = (unsigned)mlo[k]; MSK[q * 4 + 1] = (unsigned)(mlo[k] >> 32); MSK[q * 4 + 2] = (unsigned)mhi[k]; MSK[q * 4 + 3] = (unsigned)(mhi[k] >> 32); } }
        }
        __syncthreads();
    }
#pragma unroll
    for (int r = 0; r < 16; ++r) { PARK[r * 64] = ocmp[0][r]; PARK[(16 + r) * 64] = ocmp[1][r]; }
    {
        const char* Kg = (const char*)(WSP(bf16, WS_KS) + (size_t)bg * S * 64); const char* Vg = (const char*)(WSP(bf16, WS_VS) + (size_t)bg * S * 64);
        f32x16 o[2]; float ls = 0.f;
#pragma unroll
        for (int r = 0; r < 16; ++r) { o[0][r] = 0.f; o[1][r] = 0.f; }
        const int NT = cur + 1;
        auto slc_compute = [&](int j, const LAS char* Kb, const LAS char* Vb) {
            const unsigned mw = MSK[qi * 4 + (j >> 5)]; const bool sel = (mw >> (j & 31)) & 1u;
            if (__ballot(sel) != 0ull) {
                if (cur - j >= 9) {
                    const float ci = sel ? cfar : NEGB;
                    attn_tile<64, KSTR64, VSTR64>(Kb, Vb, qf, o, lane, [&](int) { return ci; },
                        [&](f32x16& p, int) {
#pragma unroll
                            for (int r = 0; r < 16; ++r) p[r] = __builtin_amdgcn_exp2f(p[r]);
                            ls += sum16(p); });
                } else {
                    const float ci = sel ? -bound : NEGB;
                    const LAS float* tp = tsl + (639 - (qpos - 64 * j - 4 * hi));
                    attn_tile<64, KSTR64, VSTR64>(Kb, Vb, qf, o, lane, [&](int) { return ci; },
                        [&](f32x16& p, int hf) {
#pragma unroll
                            for (int r = 0; r < 16; ++r) { const int c = (r & 3) + 8 * (r >> 2) + 32 * hf; p[r] = __builtin_amdgcn_exp2f(p[r] + tp[c]); }
                            ls += sum16(p); });
                }
            } };
        TileRegs<128> krB, vrB;
        tile_load<128>(kr, Kg, F.tid); tile_load<128>(vr, Vg, F.tid);
        if (NT > 1) { tile_load<128>(krB, Kg + (size_t)8192, F.tid); tile_load<128>(vrB, Vg + (size_t)8192, F.tid); }
        tile_store<128, KSTR64>(kr, KT[0], F.tid); tile_store<128, VSTR64>(vr, VT[0], F.tid);
        __syncthreads();
        for (int j = 0; j < NT; j += 2) {
            if (j + 2 < NT) { tile_load<128>(kr, Kg + (size_t)(j + 2) * 8192, F.tid); tile_load<128>(vr, Vg + (size_t)(j + 2) * 8192, F.tid); }
            slc_compute(j, KT[0], VT[0]);
            if (j + 1 < NT) { tile_store<128, KSTR64>(krB, KT[1], F.tid); tile_store<128, VSTR64>(vrB, VT[1], F.tid); }
            __syncthreads();
            if (j + 1 >= NT) break;
            if (j + 3 < NT) { tile_load<128>(krB, Kg + (size_t)(j + 3) * 8192, F.tid); tile_load<128>(vrB, Vg + (size_t)(j + 3) * 8192, F.tid); }
            slc_compute(j + 1, KT[1], VT[1]);
            if (j + 2 < NT) { tile_store<128, KSTR64>(kr, KT[0], F.tid); tile_store<128, VSTR64>(vr, VT[0], F.tid); }
            __syncthreads();
        }
        ls = sum32x(ls); const float fs = ls > 0.f ? GT[gto + 1] / ls : 0.f;
        float fr_[16]; bcast_rows(fs, F.lds, w, lane, fr_);
#pragma unroll
        for (int r = 0; r < 16; ++r) { const float f = fr_[r]; PARK[r * 64] += o[0][r] * f; PARK[(16 + r) * 64] += o[1][r] * f; }
    }
    {
        const char* Kg = (const char*)(WSP(bf16, WS_KW) + (size_t)bg * S * 64); const char* Vg = (const char*)(WSP(bf16, WS_VW) + (size_t)bg * S * 64);
        f32x16 o[2]; float ls = 0.f;
#pragma unroll
        for (int r = 0; r < 16; ++r) { o[0][r] = 0.f; o[1][r] = 0.f; }
        const int j0 = cur >= 8 ? cur - 8 : 0;
        tile_load<128>(kr, Kg + (size_t)j0 * 8192, F.tid); tile_load<128>(vr, Vg + (size_t)j0 * 8192, F.tid);
        tile_store<128, KSTR64>(kr, KT[0], F.tid); tile_store<128, VSTR64>(vr, VT[0], F.tid);
        __syncthreads();
        for (int j = j0; j <= cur; ++j) { const int bi = (j - j0) & 1;
            if (j < cur) { tile_load<128>(kr, Kg + (size_t)(j + 1) * 8192, F.tid); tile_load<128>(vr, Vg + (size_t)(j + 1) * 8192, F.tid); }
            const LAS float* tp = twl + (639 - (qpos - 64 * j - 4 * hi));
            attn_tile<64, KSTR64, VSTR64>(KT[bi], VT[bi], qf, o, lane, [&](int) { return -bound; },
                [&](f32x16& p, int hf) {
#pragma unroll
                    for (int r = 0; r < 16; ++r) { const int c = (r & 3) + 8 * (r >> 2) + 32 * hf; p[r] = __builtin_amdgcn_exp2f(p[r] + tp[c]); }
                    ls += sum16(p); });
            if (j < cur) { tile_store<128, KSTR64>(kr, KT[bi ^ 1], F.tid); tile_store<128, VSTR64>(vr, VT[bi ^ 1], F.tid); }
            __syncthreads();
        }
        ls = sum32x(ls); const float fs = ls > 0.f ? GT[gto + 2] / ls : 0.f;
        float fr_[16]; bcast_rows(fs, F.lds, w, lane, fr_);
#pragma unroll
        for (int r = 0; r < 16; ++r) { const float f = fr_[r]; PARK[r * 64] += o[0][r] * f; PARK[(16 + r) * 64] += o[1][r] * f; }
    }
    bf16* Y = WSP(bf16, WS_Y);
    LDS_WAIT(); asm volatile("" ::: "memory");
    store_rows64((const LAS float*)(F.lds + 66816) + w * 2048, Y + ((size_t)b * S + q0 + 32 * qs) * 1024 + 512 + h * 64, WSP(float, WS_VMEM) + ((size_t)b * S + q0 + 32 * qs) * 16 + 8 + h, lane);
}

__device__ __forceinline__ void mem_unit(Frame& F, int bh, int qb) {
    const int lane = F.lane, hi = lane >> 5, w = F.wave; const int b = bh >> 2, hm = bh & 3;
    const int tok = b * S + qb * 256 + 32 * w + (lane & 31);
    const float* CF = WSP(float, WS_CONST);
    const bf16* qp = WSP(bf16, WS_QMEM) + (size_t)tok * 256 + hm * 64; float qv[4][8]; float ss = 0.f;
#pragma unroll
    for (int s = 0; s < 4; ++s) { unpack8(*(const u32x4*)(qp + 16 * s + 8 * hi), qv[s]);
#pragma unroll
        for (int j = 0; j < 8; ++j) ss += qv[s][j] * qv[s][j]; }
    ss = sum32x(ss); const float rinv = 1.0f / sqrtf(ss * (1.0f / 64) + EPS) * (0.125f * LOG2E); float n2 = 0.f;
    bf16x8 qf[4];
#pragma unroll
    for (int s = 0; s < 4; ++s) {
#pragma unroll
        for (int j = 0; j < 8; ++j) { qv[s][j] *= rinv * F.in[26][16 * s + 8 * hi + j]; n2 += qv[s][j] * qv[s][j]; }
        qf[s] = __builtin_bit_cast(bf16x8, pack8f(qv[s])); }
    n2 = sum32x(n2); const float bound = sqrtf(n2) * CF[CF_KBMEM];
    LAS char* KT = (LAS char*)F.lds; LAS char* VT = (LAS char*)F.lds + 64 * KSTR64;
    const GAS char* Kg = uni_ptr((const char*)(WSP(bf16, WS_KVMR) + (size_t)b * 256 * 512 + hm * 64)); const GAS char* Vg = Kg + 512;
    const int trow = F.tid >> 3, tch = F.tid & 7; float gmk[8];
#pragma unroll
    for (int j = 0; j < 8; ++j) gmk[j] = F.in[27][8 * tch + j];
    f32x16 o[2]; float ls = 0.f;
#pragma unroll
    for (int r = 0; r < 16; ++r) { o[0][r] = 0.f; o[1][r] = 0.f; }
    TileRegs<128> kr, vr;
    for (int t = 0; t < 4; ++t) {
        __syncthreads();
        { const unsigned goff = (unsigned)(64 * t + trow) * 1024u + 16u * tch;
          kr.r[0] = *(const GAS u32x4*)(Kg + goff); vr.r[0] = *(const GAS u32x4*)(Vg + goff);
          float kv8[8]; unpack8(kr.r[0], kv8); float ssk = 0.f;
#pragma unroll
          for (int j = 0; j < 8; ++j) ssk += kv8[j] * kv8[j];
          ssk = grp8_sum(ssk); const float rk = 1.0f / sqrtf(ssk * (1.0f / 64) + EPS);
#pragma unroll
          for (int j = 0; j < 8; ++j) kv8[j] *= rk * gmk[j];
          kr.r[0] = pack8f(kv8); }
        tile_store<128, KSTR64>(kr, KT, F.tid); tile_store<128, VSTR64>(vr, VT, F.tid);
        __syncthreads();
        attn_tile<64, KSTR64, VSTR64>(KT, VT, qf, o, lane, [&](int) { return -bound; },
            [&](f32x16& p, int) {
#pragma unroll
                for (int r = 0; r < 16; ++r) p[r] = __builtin_amdgcn_exp2f(p[r]);
                ls += sum16(p); });
    }
    ls = sum32x(ls); const float linv = 1.0f / ls;
    bf16* O = WSP(bf16, WS_OMEM);
    float fr_[16]; bcast_rows(linv, F.lds, w, lane, fr_);
#pragma unroll
    for (int r = 0; r < 16; ++r) { const int row = crow(r, hi); const float f = fr_[r]; bf16* yp = O + ((size_t)b * S + qb * 256 + 32 * w + row) * 256 + hm * 64 + (lane & 31);
        yp[0] = (bf16)(cvtpk(o[0][r] * f, 0.f) & 0xffff); yp[32] = (bf16)(cvtpk(o[1][r] * f, 0.f) & 0xffff); }
}

template <int NBK, int KSTEPS>
__device__ __forceinline__ void mb_gemm(f32x16 (&acc)[2][NBK], const GAS char* wb, unsigned lo16, const LAS char* xb0, int xoff32) {
    bf16x8 wa[2][NBK], wbf[2][NBK];
#define ML_WLD(dst, bt_) do { _Pragma("unroll") for (int s = 0; s < 2; ++s) _Pragma("unroll") for (int nb = 0; nb < NBK; ++nb) dst[s][nb] = *(const GAS bf16x8*)(wb + (unsigned)((nb * KSTEPS + 2 * (bt_) + s) * 1024) + lo16); } while (0)
#define ML_MMA(src_, bt_) do { _Pragma("unroll") for (int s = 0; s < 2; ++s) { const bf16x8 x0 = *(const LAS bf16x8*)(xb0 + 32 * (2 * (bt_) + s)), x1 = *(const LAS bf16x8*)(xb0 + xoff32 + 32 * (2 * (bt_) + s)); \
        _Pragma("unroll") for (int nb = 0; nb < NBK; ++nb) { acc[0][nb] = __builtin_amdgcn_mfma_f32_32x32x16_bf16(src_[s][nb], x0, acc[0][nb], 0, 0, 0); acc[1][nb] = __builtin_amdgcn_mfma_f32_32x32x16_bf16(src_[s][nb], x1, acc[1][nb], 0, 0, 0); } } \
        __builtin_amdgcn_sched_barrier(0); } while (0)
    ML_WLD(wa, 0);
#pragma unroll
    for (int bt = 0; bt < KSTEPS / 2; bt += 2) { ML_WLD(wbf, bt + 1); ML_MMA(wa, bt); if (bt + 2 < KSTEPS / 2) ML_WLD(wa, bt + 2); ML_MMA(wbf, bt + 1); }
#undef ML_WLD
#undef ML_MMA
}
__device__ __forceinline__ void mlablk_unit(Frame& F, int r0) {
    const int lane = F.lane, hi = lane >> 5, w = F.wave, l31 = lane & 31;
    const float* CF = WSP(float, WS_CONST); const float kbm = CF[CF_KBM];
    constexpr int XSTR = 528, CSTR = 272, RSTR = 80, TSTR = 208, VTSTR = 144;
    LAS char* CQs = (LAS char*)F.lds;
    LAS char* CKs = (LAS char*)F.lds + 33792;
    LAS char* KRs = (LAS char*)F.lds + 51200;
    LAS float* rct = (LAS float*)(F.lds + 56320);
    LAS float* gt = (LAS float*)(F.lds + 56832);
    LAS char* T = (LAS char*)F.lds + 57856 + w * 6656;
    const bf16* PB = WSP(bf16, WS_PB);
    const int b = r0 >> 13, s0 = r0 & 8191;
    __syncthreads();
    unsigned warm = 0;
    { const char* wbase = (const char*)WSP(bf16, WS_WUQ) + (size_t)((F.bid >> 3) & 31) * 20480;
#pragma unroll
      for (int i = 0; i < 3; ++i) { const int off = (F.tid + 512 * i) * 16; if (off < 20480) { const u32x4 v = *(const u32x4*)(wbase + off); warm ^= v.x ^ v.w; } } }
#pragma unroll
    for (int i = 0; i < 4; ++i) { const int idx = F.tid + 512 * i, row = idx >> 5, ch = idx & 31; *(LAS u32x4*)(CQs + row * XSTR + 16 * ch) = *(const u32x4*)(PB + (size_t)(r0 + row) * NINP + C_CQ + 8 * ch); }
#pragma unroll
    for (int i = 0; i < 2; ++i) { const int idx = F.tid + 512 * i, row = idx >> 4, ch = idx & 15; *(LAS u32x4*)(CKs + row * CSTR + 16 * ch) = *(const u32x4*)(PB + (size_t)(r0 + row) * NINP + C_CKV + 8 * ch); }
    if (F.tid < 256) { const int row = F.tid >> 2, ch = F.tid & 3; *(LAS u32x4*)(KRs + row * RSTR + 16 * ch) = *(const u32x4*)(PB + (size_t)(r0 + row) * NINP + C_KR + 8 * ch); }
    else if (F.tid < 448) { const int j = F.tid - 256; gt[j] = j < 96 ? F.in[8][j] : F.in[9][j - 96]; }
    if (warm == 0x9e3779b9u) ((unsigned*)(F.ws + WS_CTL))[65536 + F.tid] = warm;
    __syncthreads();
    { const int row = F.tid >> 3, part = F.tid & 7; float sq = 0.f, sk = 0.f;
#pragma unroll
      for (int c = 0; c < 4; ++c) { float v[8]; unpack8(*(const LAS u32x4*)(CQs + row * XSTR + 16 * (part + 8 * c)), v);
#pragma unroll
          for (int j = 0; j < 8; ++j) sq += v[j] * v[j]; }
#pragma unroll
      for (int c = 0; c < 2; ++c) { float v[8]; unpack8(*(const LAS u32x4*)(CKs + row * CSTR + 16 * (part + 8 * c)), v);
#pragma unroll
          for (int j = 0; j < 8; ++j) sk += v[j] * v[j]; }
      sq = grp8_sum(sq); sk = grp8_sum(sk);
      if (part == 0) { rct[row] = 1.0f / sqrtf(sq * (1.0f / 256) + EPS); rct[64 + row] = 1.0f / sqrtf(sk * (1.0f / 128) + EPS); } }
    FSTAMP(F, 25);
    const unsigned lo16 = (unsigned)lane * 16u;
    const float cq = 0.10206207261596575f * LOG2E;
    { f32x16 acc[2][3];
#pragma unroll
      for (int mb = 0; mb < 2; ++mb)
#pragma unroll
          for (int nb = 0; nb < 3; ++nb)
#pragma unroll
              for (int r = 0; r < 16; ++r) acc[mb][nb][r] = 0.f;
      const GAS char* wq = uni_ptr((const char*)(WSP(bf16, WS_WUQ) + (size_t)(3 * w * 16) * 512));
      mb_gemm<3, 16>(acc, wq, lo16, CQs + l31 * XSTR + 16 * hi, 32 * XSTR);
      FSTAMP(F, 26);
      __syncthreads();
#pragma unroll
      for (int mb = 0; mb < 2; ++mb) { const int row = 32 * mb + l31, s = s0 + row; const float rcq = rct[row]; float ss = 0.f;
#pragma unroll
          for (int nb = 0; nb < 3; ++nb)
#pragma unroll
              for (int r = 0; r < 16; ++r) ss += acc[mb][nb][r] * acc[mb][nb][r];
          ss = sum32x(ss) * rcq * rcq; const float rinv = rcq / sqrtf(ss * (1.0f / 96) + EPS) * cq; float n2 = 0.f;
#pragma unroll
          for (int nb = 0; nb < 3; ++nb)
#pragma unroll
              for (int g = 0; g < 4; ++g) { const f32x4 gg = *(const LAS f32x4*)(gt + 32 * nb + 8 * g + 4 * hi);
#pragma unroll
                  for (int j = 0; j < 4; ++j) { const float v = acc[mb][nb][4 * g + j] * rinv * gg[j]; acc[mb][nb][4 * g + j] = v; n2 += v * v; } }
#pragma unroll
          for (int r = 0; r < 8; ++r) { const float ifr = exp2f(-(float)crow(r, hi) * (13.287712379549449f / 16.0f));
              const float rv = __builtin_amdgcn_fractf((float)s * ifr * 0.15915494309189535f), sn = __builtin_amdgcn_sinf(rv), cs = __builtin_amdgcn_cosf(rv);
              const float x1 = acc[mb][2][r], x2 = acc[mb][2][r + 8]; acc[mb][2][r] = x1 * cs - x2 * sn; acc[mb][2][r + 8] = x2 * cs + x1 * sn; }
          n2 = sum32x(n2);
          const size_t hrow0 = (size_t)(b * 8 + w) * S + s0 + 32 * mb;
          if (hi == 0) WSP(float, WS_QBM)[hrow0 + l31] = sqrtf(n2) * kbm;
#pragma unroll
          for (int nb = 0; nb < 3; ++nb)
#pragma unroll
              for (int g = 0; g < 4; ++g) { u32x2 v; v.x = cvtpk(acc[mb][nb][4 * g], acc[mb][nb][4 * g + 1]); v.y = cvtpk(acc[mb][nb][4 * g + 2], acc[mb][nb][4 * g + 3]);
                  *(LAS u32x2*)(T + l31 * TSTR + (32 * nb + 8 * g + 4 * hi) * 2) = v; }
          LDS_WAIT(); asm volatile("" ::: "memory");
          char* dst = (char*)(WSP(bf16, WS_QM) + hrow0 * 96);
#pragma unroll
          for (int i = 0; i < 6; ++i) { const unsigned idx = (unsigned)lane + 64u * i, rw = idx / 12u, c = idx - 12u * rw; *(u32x4*)(dst + 16u * idx) = *(const LAS u32x4*)(T + rw * TSTR + 16u * c); }
          LDS_WAIT(); asm volatile("" ::: "memory"); } }
    FSTAMP(F, 27);
    const GAS char* wk = uni_ptr((const char*)(WSP(bf16, WS_WUKV) + (size_t)(4 * w * 8) * 512));
    { f32x16 acc[2][2];
#pragma unroll
      for (int mb = 0; mb < 2; ++mb)
#pragma unroll
          for (int nb = 0; nb < 2; ++nb)
#pragma unroll
              for (int r = 0; r < 16; ++r) acc[mb][nb][r] = 0.f;
      mb_gemm<2, 8>(acc, wk, lo16, CKs + l31 * CSTR + 16 * hi, 32 * CSTR);
#pragma unroll
      for (int mb = 0; mb < 2; ++mb) { const int row = 32 * mb + l31, s = s0 + row; const float rckv = rct[64 + row]; float ss = 0.f; float kr[16];
#pragma unroll
          for (int g = 0; g < 4; ++g) { const u32x2 v = *(const LAS u32x2*)(KRs + row * RSTR + (8 * g + 4 * hi) * 2);
              kr[4 * g] = bf2f(v.x & 0xffff); kr[4 * g + 1] = bf2f(v.x >> 16); kr[4 * g + 2] = bf2f(v.y & 0xffff); kr[4 * g + 3] = bf2f(v.y >> 16); }
#pragma unroll
          for (int r = 0; r < 16; ++r) ss += kr[r] * kr[r];
#pragma unroll
          for (int nb = 0; nb < 2; ++nb)
#pragma unroll
              for (int r = 0; r < 16; ++r) { const float v = acc[mb][nb][r] * rckv; acc[mb][nb][r] = v; ss += v * v; }
          ss = sum32x(ss); const float rinv = 1.0f / sqrtf(ss * (1.0f / 96) + EPS);
#pragma unroll
          for (int g = 0; g < 4; ++g) { const f32x4 g0 = *(const LAS f32x4*)(gt + 96 + 8 * g + 4 * hi), g1 = *(const LAS f32x4*)(gt + 96 + 32 + 8 * g + 4 * hi), g2 = *(const LAS f32x4*)(gt + 96 + 64 + 8 * g + 4 * hi);
#pragma unroll
              for (int j = 0; j < 4; ++j) { acc[mb][0][4 * g + j] *= rinv * g0[j]; acc[mb][1][4 * g + j] *= rinv * g1[j]; kr[4 * g + j] *= rinv * g2[j]; } }
#pragma unroll
          for (int r = 0; r < 8; ++r) { const float ifr = exp2f(-(float)crow(r, hi) * (13.287712379549449f / 16.0f));
              const float rv = __builtin_amdgcn_fractf((float)s * ifr * 0.15915494309189535f), sn = __builtin_amdgcn_sinf(rv), cs = __builtin_amdgcn_cosf(rv);
              const float x1 = kr[r], x2 = kr[r + 8]; kr[r] = x1 * cs - x2 * sn; kr[r + 8] = x2 * cs + x1 * sn; }
          const size_t hrow0 = (size_t)(b * 8 + w) * S + s0 + 32 * mb;
#pragma unroll
          for (int g = 0; g < 4; ++g) {
#pragma unroll
              for (int nb = 0; nb < 2; ++nb) { u32x2 v; v.x = cvtpk(acc[mb][nb][4 * g], acc[mb][nb][4 * g + 1]); v.y = cvtpk(acc[mb][nb][4 * g + 2], acc[mb][nb][4 * g + 3]);
                  *(LAS u32x2*)(T + l31 * TSTR + (32 * nb + 8 * g + 4 * hi) * 2) = v; }
              u32x2 v; v.x = cvtpk(kr[4 * g], kr[4 * g + 1]); v.y = cvtpk(kr[4 * g + 2], kr[4 * g + 3]);
              *(LAS u32x2*)(T + l31 * TSTR + (64 + 8 * g + 4 * hi) * 2) = v; }
          LDS_WAIT(); asm volatile("" ::: "memory");
          char* dst = (char*)(WSP(bf16, WS_KM) + hrow0 * 96);
#pragma unroll
          for (int i = 0; i < 6; ++i) { const unsigned idx = (unsigned)lane + 64u * i, rw = idx / 12u, c = idx - 12u * rw; *(u32x4*)(dst + 16u * idx) = *(const LAS u32x4*)(T + rw * TSTR + 16u * c); }
          LDS_WAIT(); asm volatile("" ::: "memory"); } }
    FSTAMP(F, 28);
    { f32x16 acc[2][2];
#pragma unroll
      for (int mb = 0; mb < 2; ++mb)
#pragma unroll
          for (int nb = 0; nb < 2; ++nb)
#pragma unroll
              for (int r = 0; r < 16; ++r) acc[mb][nb][r] = 0.f;
      mb_gemm<2, 8>(acc, wk + 2 * 8 * 1024, lo16, CKs + l31 * CSTR + 16 * hi, 32 * CSTR);
#pragma unroll
      for (int mb = 0; mb < 2; ++mb) { const int row = 32 * mb + l31; const float rckv = rct[64 + row];
          const size_t hrow0 = (size_t)(b * 8 + w) * S + s0 + 32 * mb;
#pragma unroll
          for (int nb = 0; nb < 2; ++nb)
#pragma unroll
              for (int g = 0; g < 4; ++g) { u32x2 v; v.x = cvtpk(acc[mb][nb][4 * g] * rckv, acc[mb][nb][4 * g + 1] * rckv); v.y = cvtpk(acc[mb][nb][4 * g + 2] * rckv, acc[mb][nb][4 * g + 3] * rckv);
                  *(LAS u32x2*)(T + l31 * VTSTR + (32 * nb + 8 * g + 4 * hi) * 2) = v; }
          LDS_WAIT(); asm volatile("" ::: "memory");
          char* dst = (char*)(WSP(bf16, WS_VM) + hrow0 * 64);
#pragma unroll
          for (int i = 0; i < 4; ++i) { const unsigned idx = (unsigned)lane + 64u * i, rw = idx >> 3, c = idx & 7u; *(u32x4*)(dst + 16u * idx) = *(const LAS u32x4*)(T + rw * VTSTR + 16u * c); }
          LDS_WAIT(); asm volatile("" ::: "memory"); } }
}

__device__ __forceinline__ void memblk_unit(Frame& F, int r0) {
    const int lane = F.lane, hi = lane >> 5, w = F.wave, l31 = lane & 31;
    const float* CF = WSP(float, WS_CONST);
    constexpr int XSTR = 528;
    LAS char* XA = (LAS char*)F.lds;
    LAS char* QS = (LAS char*)F.lds + 2 * 64 * XSTR;
    LAS char* OS = (LAS char*)F.lds + 86016;
    LAS float* r2t = (LAS float*)(F.lds + 86016 + 64 * XSTR);
    const bf16* XB = WSP(bf16, WS_XB); const int b = r0 >> 13;
    __syncthreads();
    unsigned warm = 0;
    { const int sl = (F.bid >> 3) & 31; const char* wbase = (const char*)WSP(bf16, WS_WMQ) + (size_t)sl * 32768;
#pragma unroll
      for (int i = 0; i < 4; ++i) { const u32x4 v = *(const u32x4*)(wbase + (F.tid + 512 * i) * 16); warm ^= v.x ^ v.w; }
      const u32x4 v = *(const u32x4*)((const char*)(WSP(bf16, WS_KVMR) + (size_t)b * 256 * 512) + (size_t)sl * 8192 + F.tid * 16); warm ^= v.y; }
    if (F.tid < 64) { const f32x4* sp = (const f32x4*)(WSP(float, WS_KMEM) + (size_t)(r0 + F.tid) * 16); const f32x4 s0 = sp[0], s1 = sp[1], s2 = sp[2], s3 = sp[3];
        const float tot = ((s0[0] + s0[1]) + (s0[2] + s0[3])) + ((s1[0] + s1[1]) + (s1[2] + s1[3])) + ((s2[0] + s2[1]) + (s2[2] + s2[3])) + ((s3[0] + s3[1]) + (s3[2] + s3[3]));
        r2t[F.tid] = 1.0f / sqrtf(tot * (1.0f / 1024) + EPS); }
    f32x16 qa[2];
#pragma unroll
    for (int r = 0; r < 16; ++r) { qa[0][r] = 0.f; qa[1][r] = 0.f; }
    { u32x4 xr[4];
      auto xload = [&](int c) {
#pragma unroll
          for (int i = 0; i < 4; ++i) { const int idx = F.tid + 512 * i, row = idx >> 5, ch = idx & 31; xr[i] = *(const u32x4*)(XB + (size_t)(r0 + row) * D + 256 * c + 8 * ch); } };
      auto xstore = [&](int bufi) {
#pragma unroll
          for (int i = 0; i < 4; ++i) { const int idx = F.tid + 512 * i, row = idx >> 5, ch = idx & 31; *(LAS u32x4*)(XA + bufi * 64 * XSTR + row * XSTR + 16 * ch) = xr[i]; } };
      const GAS char* wq = uni_ptr((const char*)(WSP(bf16, WS_WMQ) + (size_t)(w * 64) * 512)); const unsigned lo16 = (unsigned)lane * 16u;
#define MB_WQ(s_) (*(const GAS bf16x8*)(wq + (unsigned)(1024 * (s_)) + lo16))
      bf16x8 wfA[8], wfB[8];
#pragma unroll
      for (int s = 0; s < 8; ++s) wfA[s] = MB_WQ(s);
      xload(0); xstore(0);
      if (warm == 0x9e3779b9u) ((unsigned*)(F.ws + WS_CTL))[65536 + F.tid] = warm;
      __syncthreads();
#pragma unroll 1
      for (int c = 0; c < 4; ++c) {
          if (c + 1 < 4) xload(c + 1);
          const LAS char* xb0 = XA + (c & 1) * 64 * XSTR + l31 * XSTR + 16 * hi;
#pragma unroll
          for (int s = 0; s < 8; ++s) wfB[s] = MB_WQ(16 * c + 8 + s);
#pragma unroll
          for (int s = 0; s < 8; ++s) { const bf16x8 x0 = *(const LAS bf16x8*)(xb0 + 32 * s), x1 = *(const LAS bf16x8*)(xb0 + 32 * XSTR + 32 * s);
              qa[0] = __builtin_amdgcn_mfma_f32_32x32x16_bf16(wfA[s], x0, qa[0], 0, 0, 0); qa[1] = __builtin_amdgcn_mfma_f32_32x32x16_bf16(wfA[s], x1, qa[1], 0, 0, 0); }
          __builtin_amdgcn_sched_barrier(0);
          if (c + 1 < 4) {
#pragma unroll
              for (int s = 0; s < 8; ++s) wfA[s] = MB_WQ(16 * (c + 1) + s); }
#pragma unroll
          for (int s = 0; s < 8; ++s) { const bf16x8 x0 = *(const LAS bf16x8*)(xb0 + 32 * (8 + s)), x1 = *(const LAS bf16x8*)(xb0 + 32 * XSTR + 32 * (8 + s));
              qa[0] = __builtin_amdgcn_mfma_f32_32x32x16_bf16(wfB[s], x0, qa[0], 0, 0, 0); qa[1] = __builtin_amdgcn_mfma_f32_32x32x16_bf16(wfB[s], x1, qa[1], 0, 0, 0); }
          __builtin_amdgcn_sched_barrier(0);
          if (c + 1 < 4) xstore((c + 1) & 1);
          __syncthreads(); }
#undef MB_WQ
    }
#pragma unroll
    for (int mb = 0; mb < 2; ++mb) { const float r2 = r2t[32 * mb + l31];
#pragma unroll
        for (int g = 0; g < 4; ++g) { u32x2 v; v.x = cvtpk(qa[mb][4 * g] * r2, qa[mb][4 * g + 1] * r2); v.y = cvtpk(qa[mb][4 * g + 2] * r2, qa[mb][4 * g + 3] * r2);
            *(LAS u32x2*)(QS + (32 * mb + l31) * XSTR + (32 * w + 8 * g + 4 * hi) * 2) = v; } }
    __syncthreads();
    const int hm = w & 3, qh = w >> 2;
    bf16x8 qf[4]; float bound;
    { float qv[4][8]; float ss = 0.f;
#pragma unroll
      for (int s = 0; s < 4; ++s) { unpack8(*(const LAS u32x4*)(QS + (32 * qh + l31) * XSTR + (hm * 64 + 16 * s + 8 * hi) * 2), qv[s]);
#pragma unroll
          for (int j = 0; j < 8; ++j) ss += qv[s][j] * qv[s][j]; }
      ss = sum32x(ss); const float rinv = 1.0f / sqrtf(ss * (1.0f / 64) + EPS) * (0.125f * LOG2E); float n2 = 0.f;
#pragma unroll
      for (int s = 0; s < 4; ++s) {
#pragma unroll
          for (int j = 0; j < 8; ++j) { qv[s][j] *= rinv * F.in[26][16 * s + 8 * hi + j]; n2 += qv[s][j] * qv[s][j]; }
          qf[s] = __builtin_bit_cast(bf16x8, pack8f(qv[s])); }
      n2 = sum32x(n2); bound = sqrtf(n2) * CF[CF_KBMEM]; }
    __syncthreads();
    f32x16 o[2]; float ls = 0.f;
#pragma unroll
    for (int r = 0; r < 16; ++r) { o[0][r] = 0.f; o[1][r] = 0.f; }
    { const GAS char* kvb = uni_ptr((const char*)(WSP(bf16, WS_KVMR) + (size_t)b * 256 * 512));
      const int trow = F.tid >> 3, tch = F.tid & 7; float gmk[8];
#pragma unroll
      for (int j = 0; j < 8; ++j) gmk[j] = F.in[27][8 * tch + j];
      for (int t = 0; t < 4; ++t) {
          if (t) __syncthreads();
#pragma unroll
          for (int hh = 0; hh < 4; ++hh) { const unsigned goff = (unsigned)(64 * t + trow) * 1024u + 128u * hh + 16u * tch;
              u32x4 kq = *(const GAS u32x4*)(kvb + goff); const u32x4 vq = *(const GAS u32x4*)(kvb + goff + 512);
              float kv8[8]; unpack8(kq, kv8); float ssk = 0.f;
#pragma unroll
              for (int j = 0; j < 8; ++j) ssk += kv8[j] * kv8[j];
              ssk = grp8_sum(ssk); const float rk = 1.0f / sqrtf(ssk * (1.0f / 64) + EPS);
#pragma unroll
              for (int j = 0; j < 8; ++j) kv8[j] *= rk * gmk[j];
              kq = pack8f(kv8);
              *(LAS u32x4*)((LAS char*)F.lds + hh * 21504 + trow * KSTR64 + 16 * tch) = kq; *(LAS u32x4*)((LAS char*)F.lds + hh * 21504 + 9216 + trow * VSTR64 + 16 * tch) = vq; }
          __syncthreads();
          attn_tile<64, KSTR64, VSTR64>((LAS char*)F.lds + hm * 21504, (LAS char*)F.lds + hm * 21504 + 9216, qf, o, lane, [&](int) { return -bound; },
              [&](f32x16& p, int) {
#pragma unroll
                  for (int r = 0; r < 16; ++r) p[r] = __builtin_amdgcn_exp2f(p[r]);
                  ls += sum16(p); });
      } }
    ls = sum32x(ls);
    { float fr_[16]; bcast_rows(1.0f / ls, F.lds, w, lane, fr_);
#pragma unroll
      for (int r = 0; r < 16; ++r) { LAS bf16* op = (LAS bf16*)(OS + (32 * qh + crow(r, hi)) * XSTR) + hm * 64 + l31;
          op[0] = (bf16)(cvtpk(o[0][r] * fr_[r], 0.f) & 0xffff); op[32] = (bf16)(cvtpk(o[1][r] * fr_[r], 0.f) & 0xffff); } }
    __syncthreads();
#pragma unroll 1
    for (int nh = 0; nh < 2; ++nh) {
      f32x16 acc[2][2];
#pragma unroll
      for (int mb = 0; mb < 2; ++mb)
#pragma unroll
          for (int nb = 0; nb < 2; ++nb)
#pragma unroll
              for (int r = 0; r < 16; ++r) acc[mb][nb][r] = 0.f;
      const GAS char* wo = uni_ptr((const char*)(WSP(bf16, WS_WMO) + (size_t)((4 * w + 2 * nh) * 16) * 512)); const unsigned lo16 = (unsigned)lane * 16u;
      const LAS char* ob0 = OS + l31 * XSTR + 16 * hi;
      bf16x8 wfA[4][2], wfB[4][2];
#define MB_WLD(dst, sb_) do { _Pragma("unroll") for (int s = 0; s < 4; ++s) _Pragma("unroll") for (int nb = 0; nb < 2; ++nb) dst[s][nb] = *(const GAS bf16x8*)(wo + (unsigned)((nb * 16 + 4 * (sb_) + s) * 1024) + lo16); } while (0)
#define MB_MMA(src_, sb_) do { _Pragma("unroll") for (int s = 0; s < 4; ++s) { const bf16x8 x0 = *(const LAS bf16x8*)(ob0 + 32 * (4 * (sb_) + s)), x1 = *(const LAS bf16x8*)(ob0 + 32 * XSTR + 32 * (4 * (sb_) + s)); \
          _Pragma("unroll") for (int nb = 0; nb < 2; ++nb) { acc[0][nb] = __builtin_amdgcn_mfma_f32_32x32x16_bf16(src_[s][nb], x0, acc[0][nb], 0, 0, 0); acc[1][nb] = __builtin_amdgcn_mfma_f32_32x32x16_bf16(src_[s][nb], x1, acc[1][nb], 0, 0, 0); } } \
          __builtin_amdgcn_sched_barrier(0); } while (0)
      MB_WLD(wfA, 0); MB_WLD(wfB, 1); MB_MMA(wfA, 0); MB_WLD(wfA, 2); MB_MMA(wfB, 1); MB_WLD(wfB, 3); MB_MMA(wfA, 2); MB_MMA(wfB, 3);
#undef MB_WLD
#undef MB_MMA
      LAS char* DS = (LAS char*)F.lds;
      __syncthreads();
#pragma unroll
      for (int mb = 0; mb < 2; ++mb)
#pragma unroll
          for (int nb = 0; nb < 2; ++nb)
#pragma unroll
              for (int g = 0; g < 4; ++g) { u32x2 v; v.x = cvtpk(acc[mb][nb][4 * g], acc[mb][nb][4 * g + 1]); v.y = cvtpk(acc[mb][nb][4 * g + 2], acc[mb][nb][4 * g + 3]);
                  *(LAS u32x2*)(DS + (32 * mb + l31) * 1040 + (64 * w + 32 * nb + 8 * g + 4 * hi) * 2) = v; }
      __syncthreads();
#pragma unroll
      for (int i = 0; i < 8; ++i) { const int idx = F.tid + 512 * i, row = idx >> 6, cc = idx & 63, wv = cc >> 3, c8 = (cc & 7) * 8;
          float dv[8], xv[8]; unpack8(*(const LAS u32x4*)(DS + row * 1040 + cc * 16), dv);
          u32x4* p = (u32x4*)(WSP(bf16, WS_XB) + (size_t)(r0 + row) * D + 128 * wv + 64 * nh + c8); unpack8(*p, xv);
#pragma unroll
          for (int j = 0; j < 8; ++j) xv[j] += dv[j];
          *p = pack8f(xv); } }
}

__device__ __forceinline__ void tp_d(Frame& F) {
    LAS char* XT = (LAS char*)F.lds;
    LAS float* part = (LAS float*)F.lds;
    LAS float* ssqp = part + 4 * 2 * 32 * 33;
    LAS float* rin = ssqp + 256;
    LAS float* LG = (LAS float*)(F.lds + LDSX_OFF);
    LAS unsigned* lcnt = (LAS unsigned*)(F.lds + LDSX_OFF + 64 * 33 * 4);
    LAS unsigned* lbase = lcnt + 32;
    const float* rb = F.in[31];
    const bf16* XB = WSP(bf16, WS_XB); const bf16* WH = WSP(bf16, WS_WRH); const bf16* WL = WSP(bf16, WS_WRL);
    unsigned* cnt = (unsigned*)(F.ws + WS_CTL) + CW_CNT; int* ASG = WSP(int, WS_ASG);
    const int l = F.lane, t = l & 31, hi = l >> 5, tg = F.wave & 1, kq = F.wave >> 1;
    for (int m0 = F.bid * 64; m0 < NTOK; m0 += F.G * 64) {
        __syncthreads();
        if (F.tid < 32) lcnt[F.tid] = 0u;
        u32x4 xr[16];
        const unsigned xo = (unsigned)((F.tid >> 7) * 2048 + (F.tid & 127) * 16);
        { const GAS char* xg = uni_ptr((const char*)(XB + (size_t)m0 * D));
#pragma unroll
          for (int q = 0; q < 16; ++q) xr[q] = *(const GAS u32x4*)(xg + xo + 8192u * q); }
#pragma unroll
        for (int q = 0; q < 16; ++q) { const int c = F.tid + 512 * q, row = c >> 7, ch = c & 127; *(LAS u32x4*)(XT + row * 2064 + 16 * ch) = xr[q]; }
        __syncthreads();
        f32x16 acc; float ss = 0.f;
        {
#pragma unroll
          for (int r = 0; r < 16; ++r) acc[r] = 0.f;
          const LAS char* xp = XT + (32 * tg + t) * 2064 + (256 * kq + 8 * hi) * 2; const GAS char* hp_ = uni_ptr((const char*)(WH + (16 * kq) * 512)); const GAS char* lp_ = uni_ptr((const char*)(WL + (16 * kq) * 512)); const unsigned lo16 = (unsigned)l * 16u;
#pragma unroll
          for (int sb = 0; sb < 4; ++sb) { bf16x8 ah[4], al[4];
#pragma unroll
              for (int s = 0; s < 4; ++s) { ah[s] = *(const GAS bf16x8*)(hp_ + (unsigned)(1024 * (4 * sb + s)) + lo16); al[s] = *(const GAS bf16x8*)(lp_ + (unsigned)(1024 * (4 * sb + s)) + lo16); }
              __builtin_amdgcn_sched_barrier(0);
#pragma unroll
              for (int s = 0; s < 4; ++s) { const u32x4 xw = *(const LAS u32x4*)(xp + 32 * (4 * sb + s)); const bf16x8 xb = __builtin_bit_cast(bf16x8, xw);
                  acc = __builtin_amdgcn_mfma_f32_32x32x16_bf16(ah[s], xb, acc, 0, 0, 0); acc = __builtin_amdgcn_mfma_f32_32x32x16_bf16(al[s], xb, acc, 0, 0, 0);
                  float xv[8]; unpack8(xw, xv);
#pragma unroll
                  for (int j = 0; j < 8; ++j) ss += xv[j] * xv[j]; }
              __builtin_amdgcn_sched_barrier(0); } }
        __syncthreads();
        {
#pragma unroll
          for (int r = 0; r < 16; ++r) part[((kq * 2 + tg) * 32 + crow(r, hi)) * 33 + t] = acc[r];
          ss = sum32x(ss); if (hi == 0) ssqp[kq * 64 + 32 * tg + t] = ss; }
        __syncthreads();
        if (F.tid < 64) rin[F.tid] = 1.0f / sqrtf(((ssqp[F.tid] + ssqp[64 + F.tid]) + (ssqp[128 + F.tid] + ssqp[192 + F.tid])) * (1.0f / D) + EPS);
        __syncthreads();
        { const int tt = F.tid & 63, e0 = (F.tid >> 6) * 4, g2 = tt >> 5, t2 = tt & 31; const float rv = rin[tt];
#pragma unroll
          for (int j = 0; j < 4; ++j) { const int e = e0 + j; const float a = (part[((0 * 2 + g2) * 32 + e) * 33 + t2] + part[((1 * 2 + g2) * 32 + e) * 33 + t2]) + (part[((2 * 2 + g2) * 32 + e) * 33 + t2] + part[((3 * 2 + g2) * 32 + e) * 33 + t2]);
              LG[tt * 33 + e] = a * rv + rb[e]; } }
        GAS char* yg = (GAS char*)uni_ptr((const char*)(WSP(bf16, WS_Y) + (size_t)m0 * D));
#pragma unroll
        for (int q = 0; q < 16; ++q) { const int row = (F.tid >> 7) + 4 * q; float xv[8]; unpack8(xr[q], xv); const float rv = rin[row];
#pragma unroll
            for (int j = 0; j < 8; ++j) xv[j] *= rv;
            *(GAS u32x4*)(yg + xo + 8192u * q) = pack8f(xv); __builtin_amdgcn_sched_barrier(0); }
        __syncthreads();
        if (F.wave == 0) {
            const int m = m0 + l; float lg[32];
#pragma unroll
            for (int e = 0; e < 32; ++e) lg[e] = LG[l * 33 + e];
            int idx[4]; float val[4];
#pragma unroll
            for (int k = 0; k < 4; ++k) { float bv = -3.0e38f; int bi = 0;
#pragma unroll
                for (int e = 0; e < 32; ++e) { const bool taken = (k > 0 && idx[0] == e) || (k > 1 && idx[1] == e) || (k > 2 && idx[2] == e); if (!taken && lg[e] > bv) { bv = lg[e]; bi = e; } }
                idx[k] = bi; val[k] = bv; }
            const float e1 = __expf(val[1] - val[0]), e2 = __expf(val[2] - val[0]), e3 = __expf(val[3] - val[0]); const float inv = 1.0f / (1.0f + e1 + e2 + e3);
            const float ge[4] = {inv, e1 * inv, e2 * inv, e3 * inv};
            unsigned lp[4];
#pragma unroll
            for (int k = 0; k < 4; ++k) lp[k] = atomicAdd((unsigned*)&lcnt[idx[k]], 1u);
            LDS_WAIT(); asm volatile("" ::: "memory");
            if (l < 32) { const unsigned c = lcnt[l]; lbase[l] = c ? atomicAdd(&cnt[l], c) : 0u; }
            LDS_WAIT(); asm volatile("" ::: "memory");
#pragma unroll
            for (int k = 0; k < 4; ++k) { ASG[(m * 4 + k) * 2 + 0] = idx[k] | ((int)(lbase[idx[k]] + lp[k]) << 8); ASG[(m * 4 + k) * 2 + 1] = __float_as_int(ge[k]); }
        }
    }
    __syncthreads();
}
__device__ __forceinline__ void moe_tables(Frame& F, LAS int* mt, LAS int* ro) {
    __syncthreads();
    if (F.tid == 0) { unsigned* cnt = (unsigned*)(F.ws + WS_CTL) + CW_CNT; int acc = 0;
        for (int e = 0; e < 32; ++e) { const int c = (int)__hip_atomic_load(cnt + e, __ATOMIC_RELAXED, __HIP_MEMORY_SCOPE_AGENT); const int t = (c + 255) >> 8; mt[e] = t; ro[e] = acc; acc += t * 256; } }
    __syncthreads();
}
__device__ __forceinline__ void moe_gather(Frame& F) {
    LAS int* mt = (LAS int*)(F.lds + LDSX_OFF + 1024); LAS int* ro = mt + 32;
    moe_tables(F, mt, ro);
    const int* ASG = WSP(int, WS_ASG); const bf16* XB = WSP(bf16, WS_Y); bf16* A1 = WSP(bf16, WS_A1);
    for (int m = F.gw; m < NTOK; m += F.ngw) {
        const u32x4* src = (const u32x4*)(XB + (size_t)m * D) + F.lane; const u32x4 a = src[0], b = src[64];
#pragma unroll
        for (int k = 0; k < 4; ++k) { const int pe = ASG[(m * 4 + k) * 2]; const int e = pe & 255, pos = pe >> 8; const size_t row = (size_t)ro[e] + pos;
            u32x4* dst = (u32x4*)(A1 + row * D) + F.lane; __builtin_nontemporal_store(a, dst); __builtin_nontemporal_store(b, dst + 64); }
    }
}
__device__ __forceinline__ void moe_combine(Frame& F) {
    LAS int* mt = (LAS int*)(F.lds + LDSX_OFF + 1024); LAS int* ro = mt + 32;
    moe_tables(F, mt, ro);
    const int* ASG = WSP(int, WS_ASG); const bf16* Yb = WSP(bf16, WS_A1);
    for (int m = F.gw; m < NTOK; m += F.ngw) {
        f32x4* op = (f32x4*)(F.out + (size_t)m * D) + 4 * F.lane; f32x4 o[4];
        { const u32x4* xp = (const u32x4*)(WSP(bf16, WS_XB) + (size_t)m * D + 16 * F.lane); float x0[8], x1[8]; unpack8(xp[0], x0); unpack8(xp[1], x1);
          o[0] = (f32x4){x0[0], x0[1], x0[2], x0[3]}; o[1] = (f32x4){x0[4], x0[5], x0[6], x0[7]}; o[2] = (f32x4){x1[0], x1[1], x1[2], x1[3]}; o[3] = (f32x4){x1[4], x1[5], x1[6], x1[7]}; }
#pragma unroll
        for (int k = 0; k < 4; ++k) { const int pe = ASG[(m * 4 + k) * 2]; const float gw = __int_as_float(ASG[(m * 4 + k) * 2 + 1]); const int e = pe & 255, pos = pe >> 8; const size_t row = (size_t)ro[e] + pos;
            const u32x4* yp = (const u32x4*)(Yb + row * D + 16 * F.lane); float y0[8], y1[8]; unpack8(yp[0], y0); unpack8(yp[1], y1);
            o[0] += gw * (f32x4){y0[0], y0[1], y0[2], y0[3]}; o[1] += gw * (f32x4){y0[4], y0[5], y0[6], y0[7]};
            o[2] += gw * (f32x4){y1[0], y1[1], y1[2], y1[3]}; o[3] += gw * (f32x4){y1[4], y1[5], y1[6], y1[7]}; }
#pragma unroll
        for (int j = 0; j < 4; ++j) op[j] = o[j];
    }
}

#ifndef LB
#define LB 512
#endif
__global__ void __launch_bounds__(LB) fwd_kernel(Args args) {
    extern __shared__ __attribute__((aligned(16))) unsigned char lds_raw[];
    Frame F;
    F.lds = (LAS unsigned char*)lds_raw; F.tid = threadIdx.x; F.lane = F.tid & 63; F.wave = __builtin_amdgcn_readfirstlane(F.tid >> 6);
    F.G = gridDim.x; F.bid = blockIdx.x; F.gw = F.bid * 8 + F.wave; F.ngw = F.G * 8;
    F.in = args.in; F.out = args.out; F.ws = args.ws;
    for (int u = F.tid; u < 128; u += 512) ((LAS unsigned*)(F.lds + LDSCTL_OFF))[u] = 0u;
    __syncthreads();
    unsigned* ctl = (unsigned*)(F.ws + WS_CTL);
    XcdBarrier bar = xcd_barrier_post(ctl + CW_BAR, (volatile LAS unsigned*)(F.lds + LDSCTL_OFF) + 8);
#ifndef PHM
#define PHM 0xFFFFFFFFu
#endif
#define RELAUNDER() do { int t_ = F.wave * 64 + (int)lane_id_opaque(); F.tid = t_; F.lane = t_ & 63; } while (0)
#define PH(n) RELAUNDER(); if (PHM & (1u << (n)))
#ifndef PRB_A
#define PRB_A -1
#endif
#ifndef PRB_B
#define PRB_B -1
#endif
    volatile LAS unsigned long long* TS = (volatile LAS unsigned long long*)(F.lds + LDSCTL_OFF + 128);
#define STAMP(k) do { if (PRB_A >= 0 && blockIdx.x == PRB_BLK && F.tid == 0) TS[k] = __builtin_amdgcn_s_memrealtime(); } while (0)
#define GRID_BAR() do { RELAUNDER(); xcd_barrier(bar, F.tid == 0); } while (0)
    float* RS = WSP(float, WS_RS);
    STAMP(0); PH(0) { FSTAMP(F, 30); FSTAMP(F, 31); PH(21) p0_prologue(F); FSTAMP(F, 34); } GRID_BAR(); STAMP(1); FSTAMP(F, 35);
#ifdef DUMMY_STREAM
    STAMP(30);
    { f32x4 acc4 = {0.f, 0.f, 0.f, 0.f}; const f32x4* p1 = (const f32x4*)F.in[32]; const f32x4* p2 = (const f32x4*)F.in[34];
      const size_t n1 = (size_t)32 * 1024 * 2048 / 4, n2 = (size_t)32 * 1024 * 1024 / 4; const size_t gt = (size_t)F.bid * 512 + F.tid, gs_ = (size_t)F.G * 512;
      for (size_t i = gt; i < n1; i += 4 * gs_) { acc4 += p1[i]; if (i + gs_ < n1) acc4 += p1[i + gs_]; if (i + 2 * gs_ < n1) acc4 += p1[i + 2 * gs_]; if (i + 3 * gs_ < n1) acc4 += p1[i + 3 * gs_]; }
      for (size_t i = gt; i < n2; i += 4 * gs_) { acc4 += p2[i]; if (i + gs_ < n2) acc4 += p2[i + gs_]; if (i + 2 * gs_ < n2) acc4 += p2[i + 2 * gs_]; if (i + 3 * gs_ < n2) acc4 += p2[i + 3 * gs_]; }
      WSP(float, WS_CONST)[4096 + (F.bid * 512 + F.tid) % 2048] = acc4.x + acc4.y + acc4.z + acc4.w; }
    GRID_BAR(); STAMP(31);
#endif
    PH(1) { pg8::Gemm g{WSP(bf16, WS_XB), WSP(bf16, WS_WIN), 1024, 1024, 1024}; pg8::StaticOrder So; So.init(NTOK, NINP, F.G, F.bid);
      pg8::EpiScaleBf16 E{WSP(bf16, WS_PB), NINP, RS + 0, 4}; pg8::gemm_phase(F.lds, g, So, E, F.tid); }
    PH(1) if (F.bid >= F.G - 4) { pg8::Gemm g{WSP(bf16, WS_MEMB), WSP(bf16, WS_WMKVT), 1024, 1024, 1024}; pg8::StaticOrder So; So.init(512, 512, 4, F.bid - (F.G - 4));
      pg8::EpiScaleBf16 E{WSP(bf16, WS_KVMR), 512, WSP(float, WS_RSM), 1}; pg8::gemm_phase(F.lds, g, So, E, F.tid); }
    GRID_BAR(); STAMP(2);
    STAMP(3);
    if (F.bid & 1) { PH(17) compress_phase(F); }
    FSTAMP(F, 24);
    PH(3) for (int u = F.bid; u < NTOK / 64; u += F.G) mlablk_unit(F, 64 * u);
    FSTAMP(F, 29);
    PH(2) tp_a(F);
    FSTAMP(F, 22);
    if (!(F.bid & 1)) { PH(17) compress_phase(F); }
    FSTAMP(F, 23);
    GRID_BAR(); STAMP(4); STAMP(5); STAMP(6);
    { const int vcu = (F.G % 8 == 0) ? (F.bid % 8) * (F.G / 8) + F.bid / 8 : F.bid;
      const int cgrp = (F.bid >> 3) & 3;
      PH(19) if (cgrp == 0) moe_convert(F);
      PH(5) for (int v = vcu; v < 256; v += F.G) { const int bh = v >> 4, sidx = v & 15; mla_unit(F, bh, 31 - sidx); if (cgrp == 1 && v == vcu) { PH(19) moe_convert(F); } mla_unit(F, bh, sidx); }
      STAMP(7);
      PH(19) if (cgrp == 2) moe_convert(F);
      PH(18) for (int v = vcu; v < 256; v += F.G) { const int bg = v >> 6, sidx = v & 63; nsa_unit(F, bg, 127 - sidx, true); nsa_unit(F, bg, sidx, false); }
      PH(19) if (cgrp == 3) moe_convert(F); }
    GRID_BAR(); STAMP(8);
    STAMP(9);
    PH(7) { pg8::Gemm g{WSP(bf16, WS_Y), WSP(bf16, WS_WOUT), 1024, 1024, 1024}; pg8::StaticOrder So; So.init(NTOK, 1024, F.G, F.bid);
      pg8::EpiOutProj E{WSP(bf16, WS_XB), 1024, WSP(float, WS_KMEM), WSP(float, WS_VMEM), (LAS float*)(F.lds + LDSX_OFF)}; pg8::gemm_phase_mid(F.lds, g, So, E, F.tid); }
    GRID_BAR(); STAMP(10); STAMP(11);
    STAMP(12); STAMP(13);
    PH(9) for (int u = F.bid; u < NTOK / 64; u += F.G) memblk_unit(F, 64 * u);
    __syncthreads(); STAMP(14);
    PH(12) tp_d(F); GRID_BAR(); STAMP(15);
    PH(13) moe_gather(F); GRID_BAR(); STAMP(16);
    { LAS int* mt = (LAS int*)(F.lds + LDSX_OFF + 1024); LAS int* ro = mt + 32;
      pg8::MoeOrder Mo; Mo.xl = F.bid & 7; Mo.cl = F.bid >> 3; Mo.nl = F.G >> 3;
#pragma unroll
      for (int s = 0; s < 4; ++s) { Mo.mt[s] = mt[Mo.xl + 8 * s]; Mo.tp[s] = ro[Mo.xl + 8 * s] >> 8; }
      PH(14) { Mo.ntn = 8; pg8::Gemm g{WSP(bf16, WS_A1), WSP(bf16, WS_WGU), 1024, 1024, 1024}; pg8::EpiSwiglu E{WSP(bf16, WS_ACT), F.in[33]}; pg8::gemm_phase_b(F.lds, g, Mo, E, F.tid); }
      PH(19) moe_pool(F);
      GRID_BAR(); STAMP(17);
      PH(15) { Mo.ntn = 4; pg8::Gemm g{WSP(bf16, WS_ACT), WSP(bf16, WS_WD), 1024, 1024, 1024}; pg8::EpiDown E{WSP(bf16, WS_A1), F.in[35]}; pg8::gemm_phase_b(F.lds, g, Mo, E, F.tid); }
      GRID_BAR(); STAMP(18); }
    PH(16) moe_combine(F);
    STAMP(19);
    if (PRB_A >= 0 && blockIdx.x == PRB_BLK && F.tid == 0) {
        unsigned long long ta = TS[PRB_E] - TS[PRB_A];
        if (ta > 100000ull) ta = 0;
        const unsigned long long extra = 8ull * ta;
        const unsigned long long t0 = __builtin_amdgcn_s_memrealtime();
        while (__builtin_amdgcn_s_memrealtime() - t0 < extra) __builtin_amdgcn_s_sleep(8);
    }
}

extern "C" void kernel_launch(void* const* d_in, const int* in_sizes, int n_in, void* d_out, int out_size, void* d_ws, size_t ws_size, hipStream_t stream) {
    static int grid = 0;
    if (grid == 0) {
        if (n_in != 36 || out_size != NTOK * D || ws_size < WS_END) { fprintf(stderr, "kernel_launch: unexpected shapes (n_in %d out %d ws %zu need %zu)\n", n_in, out_size, ws_size, (size_t)WS_END); grid = -1; return; }
        int dev = 0, cus = 0;
        if (hipGetDevice(&dev) != hipSuccess || hipDeviceGetAttribute(&cus, hipDeviceAttributeMultiprocessorCount, dev) != hipSuccess) { grid = -1; return; }
        if (hipFuncSetAttribute((const void*)fwd_kernel, hipFuncAttributeMaxDynamicSharedMemorySize, LDS_BYTES) != hipSuccess) { fprintf(stderr, "kernel_launch: hipFuncSetAttribute failed\n"); grid = -1; return; }
        (void)hipGetLastError();
        grid = cus >= 256 ? 256 : (cus / 8) * 8;
    }
    if (grid <= 0) return;
    (void)hipMemsetAsync((char*)d_ws + WS_CTL, 0, 128 * 1024, stream);
    Args a{};
    for (int i = 0; i < 36; ++i) a.in[i] = (const float*)d_in[i];
    a.out = (float*)d_out; a.ws = (unsigned char*)d_ws;
    hipLaunchKernelGGL(fwd_kernel, dim3(grid), dim3(512), LDS_BYTES, stream, a);
}
```
